# Optimizing an MI355X kernel written in HIP

```python
import jax
import jax.numpy as jnp
from jax import lax
import numpy as np

D_MODEL = 2048
BATCH = 4
SEQ = 8192
DEPTH = 1

EPS = 1e-6
NEG = -1e30
Q_BLOCK = 128

MLA_HEADS = 8
MLA_Q_LORA = 512
MLA_KV_LORA = 256
MLA_NOPE = 128
MLA_ROPE = 64
MLA_V = 128
ROPE_THETA = 10000.0

NSA_HEADS = 16
NSA_GROUPS = 2
NSA_HPG = NSA_HEADS // NSA_GROUPS
NSA_DK = 64
CMP_LEN = 32
CMP_STRIDE = 16
CMP_HIDDEN = 128
SLC_LEN = 64
SLC_TOPK = 16
WINDOW = 512
FORCE_SCORE = 1e4

MIX_WIDTH = MLA_HEADS * MLA_V + NSA_HEADS * NSA_DK
IN_SIZES = (MLA_Q_LORA, MLA_KV_LORA, MLA_ROPE, NSA_HEADS * NSA_DK) + (NSA_GROUPS * NSA_DK,) * 6 + (3 * NSA_HEADS,)
IN_COLS = sum(IN_SIZES)
D_FF = -(-8 * D_MODEL // (3 * 256)) * 256

kernel_name = 'hybrid_mla_nsa_parallel_heads'


def rmsnorm(x, g):
    xf = x.astype(jnp.float32)
    y = xf * lax.rsqrt(jnp.mean(xf * xf, axis=-1, keepdims=True) + EPS)
    return (y * g.astype(jnp.float32)).astype(x.dtype)


def apply_rope(x, pos):
    d = x.shape[-1]
    inv = ROPE_THETA ** (-jnp.arange(0, d, 2, dtype=jnp.float32) / d)
    ang = pos[:, None] * inv[None, :]
    cos = jnp.cos(ang)[None, :, None, :].astype(x.dtype)
    sin = jnp.sin(ang)[None, :, None, :].astype(x.dtype)
    x1, x2 = x[..., : d // 2], x[..., d // 2:]
    return jnp.concatenate([x1 * cos - x2 * sin, x1 * sin + x2 * cos], axis=-1)


def mla_group(c_q_raw, c_kv_raw, k_rope_raw, g_q, g_kv, w_uq, w_uk, w_uv):
    B, S, _ = c_q_raw.shape
    pos = jnp.arange(S, dtype=jnp.float32)
    c_q = rmsnorm(c_q_raw, g_q)
    c_kv = rmsnorm(c_kv_raw, g_kv)
    q = (c_q @ w_uq).reshape(B, S, MLA_HEADS, MLA_NOPE + MLA_ROPE)
    q_nope = q[..., :MLA_NOPE]
    q_rope = apply_rope(q[..., MLA_NOPE:], pos)
    k_rope = apply_rope(k_rope_raw[:, :, None, :], pos)[:, :, 0]
    k_nope = (c_kv @ w_uk).reshape(B, S, MLA_HEADS, MLA_NOPE)
    v = (c_kv @ w_uv).reshape(B, S, MLA_HEADS, MLA_V)
    scale = (MLA_NOPE + MLA_ROPE) ** -0.5
    key_pos = jnp.arange(S)

    def block(i):
        start = i * Q_BLOCK
        qn = lax.dynamic_slice_in_dim(q_nope, start, Q_BLOCK, axis=1)
        qr = lax.dynamic_slice_in_dim(q_rope, start, Q_BLOCK, axis=1)
        s = jnp.einsum('bqhd,bkhd->bhqk', qn, k_nope) + jnp.einsum('bqhd,bkd->bhqk', qr, k_rope)
        s = s.astype(jnp.float32) * scale
        qpos = start + jnp.arange(Q_BLOCK)
        s = jnp.where(key_pos[None, :] <= qpos[:, None], s, NEG)
        p = jax.nn.softmax(s, axis=-1).astype(v.dtype)
        return jnp.einsum('bhqk,bkhd->bqhd', p, v)

    o = lax.map(block, jnp.arange(S // Q_BLOCK))
    return o.transpose(1, 0, 2, 3, 4).reshape(B, S, MLA_HEADS * MLA_V)


def compress_blocks(k, idx, pos_emb, w1, w2):
    B = k.shape[0]
    n_cmp = idx.shape[0]
    blocks = k[:, idx] + pos_emb[None, None, :, None, :]
    blocks = blocks.transpose(0, 1, 3, 2, 4).reshape(B, n_cmp, NSA_GROUPS, CMP_LEN * NSA_DK)
    return jax.nn.silu(blocks @ w1) @ w2


def nsa_group(q_raw, k_c, v_c, k_s, v_s, k_w, v_w, g_raw, pos_k, pos_v, w_ck1, w_ck2, w_cv1, w_cv2):
    B, S, _ = q_raw.shape
    G, HPG, DK = NSA_GROUPS, NSA_HPG, NSA_DK
    q = q_raw.reshape(B, S, G, HPG, DK)
    gates = jax.nn.sigmoid(g_raw).reshape(B, S, G, HPG, 3)
    k_c = k_c.reshape(B, S, G, DK)
    v_c = v_c.reshape(B, S, G, DK)
    k_s_t = k_s.reshape(B, S, G, DK).transpose(0, 2, 1, 3)
    v_s_t = v_s.reshape(B, S, G, DK).transpose(0, 2, 1, 3)
    pad = ((0, 0), (WINDOW, 0), (0, 0), (0, 0))
    k_w_pad = jnp.pad(k_w.reshape(B, S, G, DK), pad)
    v_w_pad = jnp.pad(v_w.reshape(B, S, G, DK), pad)
    scale = DK ** -0.5

    n_cmp = (S - CMP_LEN) // CMP_STRIDE + 1
    cmp_start = CMP_STRIDE * jnp.arange(n_cmp)
    idx = cmp_start[:, None] + jnp.arange(CMP_LEN)[None, :]
    kc = compress_blocks(k_c, idx, pos_k, w_ck1, w_ck2)
    vc = compress_blocks(v_c, idx, pos_v, w_cv1, w_cv2)
    cmp_end = cmp_start + CMP_LEN - 1

    n_slc = S // SLC_LEN
    topk = min(SLC_TOPK, n_slc)
    slc_start = SLC_LEN * jnp.arange(n_slc)
    overlap = jnp.clip(
        jnp.minimum(cmp_start[:, None] + CMP_LEN, slc_start[None, :] + SLC_LEN)
        - jnp.maximum(cmp_start[:, None], slc_start[None, :]), 0, None
    ).astype(jnp.float32) / CMP_STRIDE
    blk_ids = jnp.arange(n_slc)
    in_blk = jnp.arange(SLC_LEN)

    slopes = (2.0 ** (-8.0 * jnp.arange(1, NSA_HEADS + 1, dtype=jnp.float32) / NSA_HEADS)).reshape(G, HPG)
    slopes5 = slopes[None, :, :, None, None]
    gather = jax.vmap(jax.vmap(lambda src, ix: src[ix]))

    def block(i):
        start = i * Q_BLOCK
        qb = lax.dynamic_slice_in_dim(q, start, Q_BLOCK, axis=1)
        t = start + jnp.arange(Q_BLOCK)

        dist_c = t[:, None] - cmp_end[None, :]
        valid_c = dist_c >= 0
        s = jnp.einsum('bqghd,bcgd->bghqc', qb, kc).astype(jnp.float32) * scale
        s = jnp.where(valid_c, s - slopes5 * dist_c.astype(jnp.float32), NEG)
        p_c = jax.nn.softmax(s, axis=-1) * valid_c
        o_c = jnp.einsum('bghqc,bcgd->bqghd', p_c.astype(vc.dtype), vc)

        imp = jnp.einsum('bghqc,cn->bgqn', p_c, overlap)
        blk_t = t // SLC_LEN
        valid_s = blk_ids[None, :] <= blk_t[:, None]
        forced = (blk_ids[None, :] == 0) | (blk_ids[None, :] == blk_t[:, None]) | (blk_ids[None, :] == blk_t[:, None] - 1)
        imp = jnp.where(forced, FORCE_SCORE, jnp.where(valid_s, imp, -1.0))
        _, sel = lax.top_k(imp, topk)
        tok = (sel[..., None] * SLC_LEN + in_blk).reshape(B, G, Q_BLOCK * topk * SLC_LEN)
        nk = topk * SLC_LEN
        ks_g = gather(k_s_t, tok).reshape(B, G, Q_BLOCK, nk, DK)
        vs_g = gather(v_s_t, tok).reshape(B, G, Q_BLOCK, nk, DK)
        dist_s = (t[None, None, :, None] - tok.reshape(B, G, Q_BLOCK, nk))[:, :, None]
        s = jnp.einsum('bqghd,bgqkd->bghqk', qb, ks_g).astype(jnp.float32) * scale
        s = jnp.where(dist_s >= 0, s - slopes5 * dist_s.astype(jnp.float32), NEG)
        p_s = jax.nn.softmax(s, axis=-1).astype(vs_g.dtype)
        o_s = jnp.einsum('bghqk,bgqkd->bqghd', p_s, vs_g)

        kwb = lax.dynamic_slice_in_dim(k_w_pad, start, Q_BLOCK + WINDOW, axis=1)
        vwb = lax.dynamic_slice_in_dim(v_w_pad, start, Q_BLOCK + WINDOW, axis=1)
        s_pos = start - WINDOW + jnp.arange(Q_BLOCK + WINDOW)
        dist_w = t[:, None] - s_pos[None, :]
        valid_w = (dist_w >= 0) & (dist_w < WINDOW) & (s_pos[None, :] >= 0)
        s = jnp.einsum('bqghd,bkgd->bghqk', qb, kwb).astype(jnp.float32) * scale
        s = jnp.where(valid_w, s - slopes5 * dist_w.astype(jnp.float32), NEG)
        p_w = jax.nn.softmax(s, axis=-1).astype(vwb.dtype)
        o_w = jnp.einsum('bghqk,bkgd->bqghd', p_w, vwb)

        gb = lax.dynamic_slice_in_dim(gates, start, Q_BLOCK, axis=1)
        return gb[..., 0:1] * o_c + gb[..., 1:2] * o_s + gb[..., 2:3] * o_w

    o = lax.map(block, jnp.arange(S // Q_BLOCK))
    return o.transpose(1, 0, 2, 3, 4, 5).reshape(B, S, NSA_HEADS * DK)


def setup_inputs(seed: int = 0) -> dict:
    key = jax.random.key(seed)
    ks = jax.random.split(key, 24)
    f32 = jnp.float32

    def nrm(k, shape, fan_in):
        return jax.random.normal(k, shape, f32) * (fan_in ** -0.5)

    def gain(k, shape):
        return 1.0 + 0.01 * jax.random.normal(k, shape, f32)

    L = DEPTH
    return {
        'x': jax.random.normal(ks[0], (BATCH, SEQ, D_MODEL), f32),
        'attn_norm_g': gain(ks[1], (L, D_MODEL)),
        'w_in': nrm(ks[2], (L, D_MODEL, IN_COLS), D_MODEL),
        'mla_q_norm_g': gain(ks[3], (L, MLA_Q_LORA)),
        'mla_kv_norm_g': gain(ks[4], (L, MLA_KV_LORA)),
        'w_uq': nrm(ks[5], (L, MLA_Q_LORA, MLA_HEADS * (MLA_NOPE + MLA_ROPE)), MLA_Q_LORA),
        'w_uk': nrm(ks[6], (L, MLA_KV_LORA, MLA_HEADS * MLA_NOPE), MLA_KV_LORA),
        'w_uv': nrm(ks[7], (L, MLA_KV_LORA, MLA_HEADS * MLA_V), MLA_KV_LORA),
        'cmp_pos_k': 0.1 * jax.random.normal(ks[8], (L, CMP_LEN, NSA_DK), f32),
        'cmp_pos_v': 0.1 * jax.random.normal(ks[9], (L, CMP_LEN, NSA_DK), f32),
        'w_cmp_k1': nrm(ks[10], (L, CMP_LEN * NSA_DK, CMP_HIDDEN), CMP_LEN * NSA_DK),
        'w_cmp_k2': nrm(ks[11], (L, CMP_HIDDEN, NSA_DK), CMP_HIDDEN),
        'w_cmp_v1': nrm(ks[12], (L, CMP_LEN * NSA_DK, CMP_HIDDEN), CMP_LEN * NSA_DK),
        'w_cmp_v2': nrm(ks[13], (L, CMP_HIDDEN, NSA_DK), CMP_HIDDEN),
        'w_o': nrm(ks[14], (L, MIX_WIDTH, D_MODEL), MIX_WIDTH),
        'ffn_norm_g': gain(ks[15], (L, D_MODEL)),
        'w_gate': nrm(ks[16], (L, D_MODEL, D_FF), D_MODEL),
        'w_up': nrm(ks[17], (L, D_MODEL, D_FF), D_MODEL),
        'w_down': nrm(ks[18], (L, D_FF, D_MODEL), D_FF),
        'final_norm_g': gain(ks[19], (D_MODEL,)),
    }


def reference(x, attn_norm_g, w_in, mla_q_norm_g, mla_kv_norm_g, w_uq, w_uk, w_uv,
              cmp_pos_k, cmp_pos_v, w_cmp_k1, w_cmp_k2, w_cmp_v1, w_cmp_v2,
              w_o, ffn_norm_g, w_gate, w_up, w_down, final_norm_g):
    offsets = np.cumsum(IN_SIZES)[:-1].tolist()
    for l in range(DEPTH):
        h = rmsnorm(x, attn_norm_g[l])
        proj = h @ w_in[l]
        (c_q, c_kv, k_rope, nsa_q, k_c, v_c, k_s, v_s, k_w, v_w, g_raw) = jnp.split(proj, offsets, axis=-1)
        o_mla = mla_group(c_q, c_kv, k_rope, mla_q_norm_g[l], mla_kv_norm_g[l], w_uq[l], w_uk[l], w_uv[l])
        o_nsa = nsa_group(nsa_q, k_c, v_c, k_s, v_s, k_w, v_w, g_raw, cmp_pos_k[l], cmp_pos_v[l],
                          w_cmp_k1[l], w_cmp_k2[l], w_cmp_v1[l], w_cmp_v2[l])
        x = x + jnp.concatenate([o_mla, o_nsa], axis=-1) @ w_o[l]
        h = rmsnorm(x, ffn_norm_g[l])
        x = x + (jax.nn.silu(h @ w_gate[l]) * (h @ w_up[l])) @ w_down[l]
    return rmsnorm(x, final_norm_g)
```

```cpp
#include <hip/hip_runtime.h>
#include <hip/hip_cooperative_groups.h>
#include <cstdio>
#include <cstdint>
namespace cg = cooperative_groups;

#define LAS __attribute__((address_space(3)))
#define DI __device__ __forceinline__
typedef unsigned short bf16_t;
typedef short bf16x8 __attribute__((ext_vector_type(8)));
typedef short bf16x4 __attribute__((ext_vector_type(4)));
typedef float f32x4 __attribute__((ext_vector_type(4)));
typedef float f32x16 __attribute__((ext_vector_type(16)));
typedef unsigned u32x4 __attribute__((ext_vector_type(4)));
typedef unsigned u32x2 __attribute__((ext_vector_type(2)));

constexpr int T_ = 32768, S_ = 8192, DM = 2048, NPROJ = 2816, FF = 5632;
constexpr float LOG2E = 1.4426950408889634f;
constexpr int NTHREADS = 512;
constexpr int LDS_BYTES = 158720;
constexpr int REP_P0 = 1, REP_P1 = 1, REP_MLA = 1, REP_NSA = 1, REP_P8 = 1;

constexpr size_t MiB = 1048576;
constexpr size_t OFF_HN = 0;
constexpr size_t OFF_PROJ = 128 * MiB;
constexpr size_t OFF_QMLA = 304 * MiB;
constexpr size_t OFF_KNOPE = 400 * MiB;
constexpr size_t OFF_VT = 464 * MiB;
constexpr size_t OFF_ACT = 128 * MiB;
constexpr size_t OFF_MIX = 528 * MiB;
constexpr size_t OFF_W = 656 * MiB;
constexpr size_t OFF_WIN = OFF_W;
constexpr size_t OFF_WUQ = OFF_WIN + 2816ull * 2048 * 2;
constexpr size_t OFF_WK = OFF_WUQ + 1536ull * 512 * 2;
constexpr size_t OFF_WV = OFF_WK + 1024ull * 256 * 2;
constexpr size_t OFF_WO = OFF_WV + 1024ull * 256 * 2;
constexpr size_t OFF_WGU = OFF_WO + 2048ull * 2048 * 2;
constexpr size_t OFF_WD = OFF_WGU + 11264ull * 2048 * 2;
constexpr size_t OFF_WC1K = OFF_WD + 2048ull * 5632 * 2;
constexpr size_t OFF_WC1V = OFF_WC1K + 256ull * 2048 * 2;
constexpr size_t OFF_WC2K = OFF_WC1V + 256ull * 2048 * 2;
constexpr size_t OFF_WC2V = OFF_WC2K + 256ull * 256 * 2;
constexpr size_t OFF_MISC = 752 * MiB;
constexpr size_t OFF_KROPE = OFF_MISC;
constexpr size_t OFF_KCG = OFF_KROPE + 4 * MiB;
constexpr size_t OFF_VCG = OFF_KCG + 8 * MiB + 65536;
constexpr size_t OFF_VST = OFF_VCG + 8 * MiB + 65536;
constexpr size_t OFF_VWT = OFF_VST + 8 * MiB;
constexpr size_t OFF_HIDK = OFF_VWT + 8 * MiB;
constexpr size_t OFF_HIDV = OFF_HIDK + 2 * MiB;
constexpr size_t OFF_KC = OFF_HIDV + 2 * MiB;
constexpr size_t OFF_VCT = OFF_KC + MiB / 2;
constexpr size_t OFF_RSQ = OFF_VCT + MiB / 2;
constexpr size_t OFF_RSKV = OFF_RSQ + 131072;
constexpr size_t OFF_COS = OFF_RSKV + 131072;
constexpr size_t OFF_SIN = OFF_COS + MiB;
constexpr size_t OFF_BIAS = OFF_SIN + MiB;
constexpr size_t OFF_CTL = OFF_BIAS + 4096;
constexpr size_t OFF_ROWSQ = OFF_CTL + 4096;
constexpr size_t OFF_XBAR = OFF_ROWSQ + 131072;
constexpr size_t WS_END = OFF_XBAR + 16384;

DI unsigned f2bf(float f) { unsigned u = __builtin_bit_cast(unsigned, f); return (u + 0x7fffu + ((u >> 16) & 1u)) >> 16; }
typedef __bf16 hwbf16x2 __attribute__((ext_vector_type(2)));
typedef float f32x2 __attribute__((ext_vector_type(2)));
DI unsigned pk2(float lo, float hi) { const f32x2 v = {lo, hi}; const hwbf16x2 b = __builtin_convertvector(v, hwbf16x2); return __builtin_bit_cast(unsigned, b); }
DI float bf2f(unsigned b) { return __builtin_bit_cast(float, b << 16); }
DI float bflo(unsigned w) { return __builtin_bit_cast(float, w << 16); }
DI float bfhi(unsigned w) { return __builtin_bit_cast(float, w & 0xffff0000u); }
DI float wave_sum(float v) {
#pragma unroll
    for (int o = 1; o < 64; o <<= 1) v += __shfl_xor(v, o);
    return v;
}
DI void swap32(unsigned& a, unsigned& b) { asm volatile("s_nop 1\n\tv_permlane32_swap_b32 %0, %1" : "+v"(a), "+v"(b)); }
DI float xhalf_max(float v) { unsigned a = __builtin_bit_cast(unsigned, v), b = a; swap32(a, b); return fmaxf(__builtin_bit_cast(float, a), __builtin_bit_cast(float, b)); }
DI float xhalf_sum(float v) { unsigned a = __builtin_bit_cast(unsigned, v), b = a; swap32(a, b); return __builtin_bit_cast(float, a) + __builtin_bit_cast(float, b); }
DI float xhalf_partner(float v, int hi) { unsigned a = __builtin_bit_cast(unsigned, v), b = a; swap32(a, b); return __builtin_bit_cast(float, hi ? a : b); }
DI float sum8(float v) {
    v += __builtin_bit_cast(float, __builtin_amdgcn_mov_dpp(__builtin_bit_cast(int, v), 0xB1, 0xF, 0xF, true));
    v += __builtin_bit_cast(float, __builtin_amdgcn_mov_dpp(__builtin_bit_cast(int, v), 0x4E, 0xF, 0xF, true));
    v += __builtin_bit_cast(float, __builtin_amdgcn_mov_dpp(__builtin_bit_cast(int, v), 0x141, 0xF, 0xF, true));
    return v;
}
DI void swap16(unsigned& a, unsigned& b) { asm volatile("s_nop 1\n\tv_permlane16_swap_b32 %0, %1" : "+v"(a), "+v"(b)); }
DI float xrow16_sum(float v) { unsigned a = __builtin_bit_cast(unsigned, v), b = a; swap16(a, b); return __builtin_bit_cast(float, a) + __builtin_bit_cast(float, b); }
DI float wave_sum_fast(float v) {
    v = sum8(v);
    v += __builtin_bit_cast(float, __builtin_amdgcn_mov_dpp(__builtin_bit_cast(int, v), 0x140, 0xF, 0xF, true));
    v = xrow16_sum(v);
    return xhalf_sum(v);
}
DI float fexp2(float x) { return __builtin_amdgcn_exp2f(x); }
DI float fsilu(float v) { return v / (1.f + __expf(-v)); }
DI float fsigmoid(float v) { return 1.f / (1.f + __expf(-v)); }
#define LDS_WAIT() asm volatile("s_waitcnt lgkmcnt(0)" ::: "memory")
#define MFMA32(a, b, c) __builtin_amdgcn_mfma_f32_32x32x16_bf16((a), (b), (c), 0, 0, 0)
DI int crow(int r, int hi) { return (r & 3) + 8 * (r >> 2) + 4 * hi; }
DI int fresh_tid() { int t = threadIdx.x; asm volatile("" : "+v"(t)); return t; }

struct Params { const float* in[20]; float* out; unsigned char* ws; };

namespace pg8 {
constexpr int BM = 256, BK = 64, HALF = 128, HTB = HALF * BK * 2, STAGE_BYTES = 8 * HTB, NXCD = 8, WGM = 4;
DI int lds_byte(int r, int c) { const int st = (r >> 4) * 2 + (c >> 5), rr = r & 15, cc = c & 31, ob = rr * 64 + cc * 2; return st * 1024 + (ob ^ (((ob >> 9) & 1) << 5)); }
DI void stage_rc(int b, int& R, int& C) { const int st = b / 1024, sb = b % 1024, swz = sb ^ (((sb >> 9) & 1) << 5); R = (st >> 1) * 16 + swz / 64; C = (st & 1) * 32 + (swz % 64) / 2; }
DI int perm32(int rho) { const int n = rho >> 4, i = rho & 15; return 8 * (i >> 2) + 4 * n + (i & 3); }
struct Unit { int pm, pn; };
struct Gemm { const bf16_t* A; const bf16_t* Bt; int M, N, K, lda, ldb; };
struct StaticOrder {
    int nM, nN, nwg, G, c;
    DI void init(int M, int N, int G_, int c_) { nM = M / BM; nN = N / BM; nwg = nM * nN; G = G_; c = c_; }
    DI bool next(int i, Unit& u) const {
        const long L = (long)i * G + c; if (L >= nwg) return false;
        int wgid = (int)L; { const int q = nwg / NXCD, r = nwg % NXCD, xcd = wgid % NXCD, off = wgid / NXCD; wgid = (xcd < r ? xcd * (q + 1) : r * (q + 1) + (xcd - r) * q) + off; }
        const int nig = WGM * nN, gid = wgid / nig, fm = gid * WGM, gsz = (nM - fm) < WGM ? (nM - fm) : WGM;
        u.pm = fm + ((wgid % nig) % gsz); u.pn = (wgid % nig) / gsz; return true;
    }
};

enum { EPI_STORE = 0, EPI_Q = 1, EPI_VT = 2, EPI_SILU = 3, EPI_VCT = 4, EPI_RESID = 5, EPI_SWIGLU = 6, EPI_RESID_NORM = 7 };
struct Epi {
    int mode; bf16_t* O; int ldc; int ncols; const float* rscale; float qscale; const float* cosT; const float* sinT; const float* bias; const float* resid; float* outf; float* rowsq;
    DI void operator()(const f32x4 (&acc)[2][2][4][2], const Unit& u, int wr, int wc, int fr, int fq) const {
        const int row0 = u.pm * BM + wr * 64 + fr, col0 = u.pn * BM + wc * 32 + 8 * fq;
#pragma unroll
        for (int ai = 0; ai < 2; ++ai)
#pragma unroll
            for (int m = 0; m < 4; ++m) {
                const int row = row0 + ai * HALF + m * 16;
                float rs = 1.f, rowacc = 0.f;
                if (mode == EPI_STORE || mode == EPI_Q) { if (rscale) rs = rscale[row]; }
                if (mode == EPI_SWIGLU) rs = 1.0f / sqrtf(rowsq[row] * (1.0f / DM) + 1e-6f);
#pragma unroll
                for (int bj = 0; bj < 2; ++bj) {
                    const int col = col0 + bj * HALF;
                    f32x4 v0 = acc[ai][bj][m][0], v1 = acc[ai][bj][m][1];
                    if (mode == EPI_STORE) {
                        if (col < ncols) { v0 = v0 * rs; v1 = v1 * rs; u32x4 w; w.x = pk2(v0[0], v0[1]); w.y = pk2(v0[2], v0[3]); w.z = pk2(v1[0], v1[1]); w.w = pk2(v1[2], v1[3]);
                            *(u32x4*)(O + (size_t)row * ldc + col) = w; }
                    } else if (mode == EPI_Q) {
                        const float sc = rs * qscale; v0 = v0 * sc; v1 = v1 * sc;
                        const int c192 = col % 192;
                        if (c192 >= 128) {
                            const int i0 = (c192 - 128) >> 1, pos = row & (S_ - 1);
                            const f32x4 cs = *(const f32x4*)(cosT + pos * 32 + i0), sn = *(const f32x4*)(sinT + pos * 32 + i0);
                            float a, b;
                            a = v0[0]; b = v0[1]; v0[0] = a * cs[0] - b * sn[0]; v0[1] = a * sn[0] + b * cs[0];
                            a = v0[2]; b = v0[3]; v0[2] = a * cs[1] - b * sn[1]; v0[3] = a * sn[1] + b * cs[1];
                            a = v1[0]; b = v1[1]; v1[0] = a * cs[2] - b * sn[2]; v1[1] = a * sn[2] + b * cs[2];
                            a = v1[2]; b = v1[3]; v1[2] = a * cs[3] - b * sn[3]; v1[3] = a * sn[3] + b * cs[3];
                        }
                        u32x4 w; w.x = pk2(v0[0], v0[1]); w.y = pk2(v0[2], v0[3]); w.z = pk2(v1[0], v1[1]); w.w = pk2(v1[2], v1[3]);
                        *(u32x4*)(O + (size_t)row * ldc + col) = w;
                    } else if (mode == EPI_VT) {
                        const f32x4 s0 = *(const f32x4*)(rscale + col), s1 = *(const f32x4*)(rscale + col + 4);
                        v0 = v0 * s0; v1 = v1 * s1;
                        u32x4 w; w.x = pk2(v0[0], v0[1]); w.y = pk2(v0[2], v0[3]); w.z = pk2(v1[0], v1[1]); w.w = pk2(v1[2], v1[3]);
                        *(u32x4*)(O + (size_t)row * ldc + col) = w;
                    } else if (mode == EPI_SILU) {
                        const f32x4 b0 = *(const f32x4*)(bias + col), b1 = *(const f32x4*)(bias + col + 4);
                        v0 = v0 + b0; v1 = v1 + b1;
                        u32x4 w; w.x = pk2(fsilu(v0[0]), fsilu(v0[1])); w.y = pk2(fsilu(v0[2]), fsilu(v0[3])); w.z = pk2(fsilu(v1[0]), fsilu(v1[1])); w.w = pk2(fsilu(v1[2]), fsilu(v1[3]));
                        *(u32x4*)(O + (size_t)row * ldc + col) = w;
                    } else if (mode == EPI_VCT) {
                        if (row < 64) { u32x4 w; w.x = pk2(v0[0], v0[1]); w.y = pk2(v0[2], v0[3]); w.z = pk2(v1[0], v1[1]); w.w = pk2(v1[2], v1[3]);
                            *(u32x4*)(O + ((size_t)((col >> 9) * 64 + row)) * 512 + (col & 511)) = w; }
                    } else if (mode == EPI_RESID) {
                        const size_t ix = (size_t)row * DM + col;
                        const f32x4 r0 = *(const f32x4*)(resid + ix), r1 = *(const f32x4*)(resid + ix + 4);
                        *(f32x4*)(outf + ix) = v0 + r0; *(f32x4*)(outf + ix + 4) = v1 + r1;
                    } else if (mode == EPI_RESID_NORM) {
                        const size_t ix = (size_t)row * DM + col;
                        const f32x4 r0 = *(const f32x4*)(resid + ix), r1 = *(const f32x4*)(resid + ix + 4);
                        v0 = v0 + r0; v1 = v1 + r1;
                        *(f32x4*)(outf + ix) = v0; *(f32x4*)(outf + ix + 4) = v1;
                        u32x4 w; w.x = pk2(v0[0], v0[1]); w.y = pk2(v0[2], v0[3]); w.z = pk2(v1[0], v1[1]); w.w = pk2(v1[2], v1[3]);
                        *(u32x4*)(O + ix) = w;
                        rowacc += (v0[0] * v0[0] + v0[1] * v0[1]) + (v0[2] * v0[2] + v0[3] * v0[3]) + (v1[0] * v1[0] + v1[1] * v1[1]) + (v1[2] * v1[2] + v1[3] * v1[3]);
                    } else {
                        v0 = v0 * rs; v1 = v1 * rs;
                        u32x2 w; w.x = pk2(fsilu(v0[0]) * v1[0], fsilu(v0[1]) * v1[1]); w.y = pk2(fsilu(v0[2]) * v1[2], fsilu(v0[3]) * v1[3]);
                        *(u32x2*)(O + (size_t)row * ldc + (col >> 1)) = w;
                    }
                }
                if (mode == EPI_RESID_NORM) {
                    rowacc += __shfl_xor(rowacc, 16); rowacc += __shfl_xor(rowacc, 32);
                    if (fq == 0) atomicAdd(rowsq + row, rowacc);
                }
            }
    }
};

DI void gemm_phase(LAS unsigned char* lds, const Gemm g, const StaticOrder& S, const Epi& E) {
    const int tid = fresh_tid(), wid = __builtin_amdgcn_readfirstlane(tid >> 6), lane = tid & 63, wr = wid >> 2, wc = wid & 3, fr = lane & 15, fq = lane >> 4;
    const int K = g.K, nt = K / BK;
    unsigned voffA[2], voffB[2];
#pragma unroll
    for (int i = 0; i < 2; ++i) { int R, C; stage_rc(tid * 16 + i * 8192, R, C); const int Rb = (R & ~31) + perm32(R & 31);
        voffA[i] = (unsigned)(R * g.lda + C) * 2u; voffB[i] = (unsigned)(Rb * g.ldb + C) * 2u; }
    const size_t kstep = (size_t)(BK * 2);
    const size_t hsA = (size_t)HALF * g.lda * 2, hsB = (size_t)HALF * g.ldb * 2;
    const size_t tsA = 2 * hsA, tsB = 2 * hsB;
    const unsigned ldsw = (unsigned)wid * 1024u;
    const int aoff = lds_byte(wr * 64 + fr, fq * 8), boff = lds_byte(wc * 32 + fr, fq * 8);
#define PG8_SA(b, h) (((b) * 2 + (h)) * HTB)
#define PG8_SB(b, h) ((4 + (b) * 2 + (h)) * HTB)
#define PG8_STAGE(bufoff, gbase, voff) do { _Pragma("unroll") for (int _i = 0; _i < 2; ++_i) \
        __builtin_amdgcn_global_load_lds((const unsigned*)((const char*)(gbase) + (voff)[_i]), (LAS unsigned*)(lds + (bufoff) + ldsw + _i * 8192), 16, 0, 0); } while (0)
#define PG8_LDA(dst, b, h) do { _Pragma("unroll") for (int m = 0; m < 4; ++m) _Pragma("unroll") for (int k = 0; k < 2; ++k) dst[m][k] = *(const LAS bf16x8*)(lds + PG8_SA(b, h) + aoff + m * 2048 + k * 1024); } while (0)
#define PG8_LDB(dst, b, h) do { _Pragma("unroll") for (int n = 0; n < 2; ++n) _Pragma("unroll") for (int k = 0; k < 2; ++k) dst[n][k] = *(const LAS bf16x8*)(lds + PG8_SB(b, h) + boff + n * 2048 + k * 1024); } while (0)
#define PG8_MMA(ai, bj, At, Bt) do { __builtin_amdgcn_s_setprio(1); _Pragma("unroll") for (int m = 0; m < 4; ++m) _Pragma("unroll") for (int n = 0; n < 2; ++n) _Pragma("unroll") for (int k = 0; k < 2; ++k) \
        acc[ai][bj][m][n] = __builtin_amdgcn_mfma_f32_16x16x32_bf16(Bt[n][k], At[m][k], acc[ai][bj][m][n], 0, 0, 0); __builtin_amdgcn_s_setprio(0); } while (0)
#define PG8_WAIT_V(n) asm volatile("s_waitcnt vmcnt(" #n ")" ::: "memory")
#define PG8_WAIT_L(n) asm volatile("s_waitcnt lgkmcnt(" #n ")" ::: "memory")
#define PG8_BAR __builtin_amdgcn_s_barrier()
#define PG8_SCHED __builtin_amdgcn_sched_barrier(0)
    Unit cur, nxt; int ui = 0;
    if (!S.next(0, cur)) return;
    f32x4 acc[2][2][4][2];
#pragma unroll
    for (int a = 0; a < 2; ++a)
#pragma unroll
        for (int b = 0; b < 2; ++b)
#pragma unroll
            for (int m = 0; m < 4; ++m)
#pragma unroll
                for (int n = 0; n < 2; ++n) acc[a][b][m][n] = (f32x4){0.f, 0.f, 0.f, 0.f};
    bf16x8 At[4][2], B0[2][2], B1[2][2];
    const char* cA = (const char*)g.A + (size_t)cur.pm * tsA; const char* cB = (const char*)g.Bt + (size_t)cur.pn * tsB;
    PG8_STAGE(PG8_SB(0, 0), cB, voffB); PG8_STAGE(PG8_SB(0, 1), cB + hsB, voffB); PG8_STAGE(PG8_SA(0, 0), cA, voffA); PG8_STAGE(PG8_SA(0, 1), cA + hsA, voffA);
    if (wr == 1) PG8_BAR;
    PG8_WAIT_V(2); PG8_BAR;
    PG8_STAGE(PG8_SB(1, 0), cB + kstep, voffB); PG8_STAGE(PG8_SA(1, 0), cA + kstep, voffA); PG8_STAGE(PG8_SB(1, 1), cB + hsB + kstep, voffB);
    PG8_WAIT_V(6); PG8_BAR;
    for (;;) {
        const bool has_next = S.next(ui + 1, nxt);
        const char* nA = has_next ? (const char*)g.A + (size_t)nxt.pm * tsA : cA; const char* nB = has_next ? (const char*)g.Bt + (size_t)nxt.pn * tsB : cB;
        for (int t = 0; t < nt; t += 2) {
            const bool last = (t == nt - 2);
            const char* a1 = cA + (size_t)(t + 1) * kstep;
            const char* a2 = last ? nA : cA + (size_t)(t + 2) * kstep; const char* b2 = last ? nB : cB + (size_t)(t + 2) * kstep;
            const char* a3 = a2 + kstep; const char* b3 = b2 + kstep;
            PG8_LDB(B0, 0, 0); PG8_LDB(B1, 0, 1); PG8_SCHED; PG8_LDA(At, 0, 0); PG8_STAGE(PG8_SA(1, 1), a1 + hsA, voffA);
            PG8_WAIT_V(8); PG8_WAIT_L(0); PG8_BAR; PG8_MMA(0, 0, At, B0); PG8_MMA(0, 1, At, B1); PG8_BAR; PG8_SCHED;
            PG8_LDA(At, 0, 1); PG8_STAGE(PG8_SB(0, 0), b2, voffB); PG8_STAGE(PG8_SB(0, 1), b2 + hsB, voffB); PG8_STAGE(PG8_SA(0, 0), a2, voffA);
            PG8_WAIT_V(8); PG8_WAIT_L(0); PG8_BAR; PG8_MMA(1, 0, At, B0); PG8_MMA(1, 1, At, B1); PG8_BAR; PG8_SCHED;
            PG8_LDB(B0, 1, 0); PG8_LDB(B1, 1, 1); PG8_SCHED; PG8_LDA(At, 1, 0); PG8_STAGE(PG8_SA(0, 1), a2 + hsA, voffA);
            PG8_WAIT_V(8); PG8_WAIT_L(0); PG8_BAR; PG8_MMA(0, 0, At, B0); PG8_MMA(0, 1, At, B1); PG8_BAR; PG8_SCHED;
            PG8_LDA(At, 1, 1); PG8_STAGE(PG8_SB(1, 0), b3, voffB); PG8_STAGE(PG8_SB(1, 1), b3 + hsB, voffB); PG8_STAGE(PG8_SA(1, 0), a3, voffA);
            PG8_WAIT_V(8); PG8_WAIT_L(0); PG8_BAR; PG8_MMA(1, 0, At, B0); PG8_MMA(1, 1, At, B1); PG8_BAR; PG8_SCHED;
        }
        if (wr == 0) PG8_BAR;
        E(acc, cur, wr, wc, fr, fq);
        if (!has_next) break;
#pragma unroll
        for (int a = 0; a < 2; ++a)
#pragma unroll
            for (int b = 0; b < 2; ++b)
#pragma unroll
                for (int m = 0; m < 4; ++m)
#pragma unroll
                    for (int n = 0; n < 2; ++n) acc[a][b][m][n] = (f32x4){0.f, 0.f, 0.f, 0.f};
        cur = nxt; cA = nA; cB = nB; ++ui;
        if (wr == 1) PG8_BAR;
    }
    PG8_WAIT_V(0);
    PG8_BAR;
#undef PG8_SA
#undef PG8_SB
#undef PG8_STAGE
#undef PG8_LDA
#undef PG8_LDB
#undef PG8_MMA
#undef PG8_WAIT_V
#undef PG8_WAIT_L
#undef PG8_BAR
#undef PG8_SCHED
}
}

DI int map_row(int map, int n) {
    if (map == 1) { const int hd = n / 192, c = n - hd * 192; if (c >= 160) return hd * 192 + 128 + 2 * (c - 160) + 1; if (c >= 128) return hd * 192 + 128 + 2 * (c - 128); return n; }
    if (map == 2) return (n >> 2) * 8 + (n & 3);
    if (map == 3) return (n >> 2) * 8 + 4 + (n & 3);
    return n;
}
DI void transpose_item(const float* dW, const float* dks, bf16_t* dWT, int dK, int dN, int dNpad, int dldt, int dmap, LAS float* scr, int item, int lane) {
    const int nblk = dNpad / 32, kb = item / nblk, nb = item - kb * nblk, k0 = 64 * kb, n0 = 32 * nb;
    f32x4 ld[8];
#pragma unroll
    for (int i = 0; i < 8; ++i) {
        const int kk = 8 * i + (lane >> 3), k = k0 + kk, n = n0 + 4 * (lane & 7);
        ld[i] = (f32x4){0.f, 0.f, 0.f, 0.f};
        if (k < dK && n < dN) { ld[i] = *(const f32x4*)(dW + (size_t)k * dN + n); if (dks) ld[i] = ld[i] * dks[k]; }
    }
#pragma unroll
    for (int i = 0; i < 8; ++i) {
        const int kk = 8 * i + (lane >> 3); LAS float* d = scr + kk * 33 + 4 * (lane & 7);
        d[0] = ld[i].x; d[1] = ld[i].y; d[2] = ld[i].z; d[3] = ld[i].w;
    }
    LDS_WAIT();
    const int c = lane & 7;
#pragma unroll
    for (int j = 0; j < 4; ++j) {
        const int n = (lane >> 3) + 8 * j; const LAS float* s = scr + (8 * c) * 33 + n;
        u32x4 o; o.x = pk2(s[0 * 33], s[1 * 33]); o.y = pk2(s[2 * 33], s[3 * 33]); o.z = pk2(s[4 * 33], s[5 * 33]); o.w = pk2(s[6 * 33], s[7 * 33]);
        *(u32x4*)(dWT + (size_t)map_row(dmap, n0 + n) * dldt + k0 + 8 * c) = o;
    }
    LDS_WAIT();
}
DI void norm_row_bf16(const float* xrow, const float* g, bf16_t* orow, int lane) {
    const f32x4* xr = (const f32x4*)xrow + lane; f32x4 v[8]; float s = 0.f;
#pragma unroll
    for (int j = 0; j < 8; ++j) { v[j] = xr[64 * j]; s += (v[j].x * v[j].x + v[j].y * v[j].y) + (v[j].z * v[j].z + v[j].w * v[j].w); }
    s = wave_sum(s);
    const float rs = 1.0f / sqrtf(s * (1.0f / DM) + 1e-6f);
    const f32x4* gr = (const f32x4*)g + lane;
    u32x2* o8 = (u32x2*)orow + lane;
#pragma unroll
    for (int j = 0; j < 8; ++j) { const f32x4 gg = gr[64 * j]; u32x2 o; o.x = pk2(v[j].x * rs * gg.x, v[j].y * rs * gg.y); o.y = pk2(v[j].z * rs * gg.z, v[j].w * rs * gg.w); o8[64 * j] = o; }
}
DI void norm_row_f32_inplace(float* xrow, const float* g, int lane) {
    f32x4* xr = (f32x4*)xrow + lane; f32x4 v[8]; float s = 0.f;
#pragma unroll
    for (int j = 0; j < 8; ++j) { v[j] = xr[64 * j]; s += (v[j].x * v[j].x + v[j].y * v[j].y) + (v[j].z * v[j].z + v[j].w * v[j].w); }
    s = wave_sum(s);
    const float rs = 1.0f / sqrtf(s * (1.0f / DM) + 1e-6f);
    const f32x4* gr = (const f32x4*)g + lane;
#pragma unroll
    for (int j = 0; j < 8; ++j) { const f32x4 gg = gr[64 * j]; xr[64 * j] = v[j] * rs * gg; }
}
DI void sincos_acc(float angf, float& sn, float& cs) {
    const double x = (double)angf;
    const double n = rint(x * 0.15915494309189535);
    double r = fma(-n, 6.283185307179586, x); r = fma(-n, 2.4492935982947064e-16, r);
    const double r2 = r * r;
    double ts = r, ss = r, tc = 1.0, cc = 1.0;
    for (int k = 1; k <= 13; ++k) {
        ts *= -r2 / (double)((2 * k) * (2 * k + 1)); ss += ts;
        tc *= -r2 / (double)((2 * k - 1) * (2 * k)); cc += tc;
    }
    sn = (float)ss; cs = (float)cc;
}

DI void prologue(const Params& p, LAS unsigned char* lds, int tid, int lane, int wave) {
    unsigned char* ws = p.ws;
    const int gw = blockIdx.x * 8 + wave, NGW = gridDim.x * 8;
    LAS float* scr = (LAS float*)(lds + wave * 16384);
    constexpr int I0 = 32 * 88, I1 = I0 + 8 * 48, I2 = I1 + 4 * 32, I3 = I2 + 4 * 32, I4 = I3 + 32 * 64, I5 = I4 + 32 * 176, I6 = I5 + 32 * 176, I7 = I6 + 88 * 64,
                  I8 = I7 + 32 * 8, I9 = I8 + 32 * 8, I10 = I9 + 4 * 8, I11 = I10 + 4 * 8;
    typedef const float* cfp;
    LAS cfp* PTg = (LAS cfp*)(lds + 158208);
    if (tid == 0) { PTg[2] = p.in[2]; PTg[3] = p.in[3]; PTg[4] = p.in[4]; PTg[5] = p.in[5]; PTg[6] = p.in[6]; PTg[7] = p.in[7]; PTg[10] = p.in[10]; PTg[11] = p.in[11];
                    PTg[12] = p.in[12]; PTg[13] = p.in[13]; PTg[14] = p.in[14]; PTg[15] = p.in[15]; PTg[16] = p.in[16]; PTg[17] = p.in[17]; PTg[18] = p.in[18]; PTg[0] = nullptr; }
    __syncthreads();
    for (int it = gw; it < I11; it += NGW) {
        int ii, ksi, dK, dN, dNpad, dldt, dmap, i0; size_t off;
        if (it < I0)       { ii = 2;  ksi = 0;  off = OFF_WIN;  dK = 2048; dN = 2672; dNpad = 2816; dldt = 2048; dmap = 0; i0 = 0; }
        else if (it < I1)  { ii = 5;  ksi = 3;  off = OFF_WUQ;  dK = 512;  dN = 1536; dNpad = 1536; dldt = 512;  dmap = 1; i0 = I0; }
        else if (it < I2)  { ii = 6;  ksi = 4;  off = OFF_WK;   dK = 256;  dN = 1024; dNpad = 1024; dldt = 256;  dmap = 0; i0 = I1; }
        else if (it < I3)  { ii = 7;  ksi = 4;  off = OFF_WV;   dK = 256;  dN = 1024; dNpad = 1024; dldt = 256;  dmap = 0; i0 = I2; }
        else if (it < I4)  { ii = 14; ksi = 0;  off = OFF_WO;   dK = 2048; dN = 2048; dNpad = 2048; dldt = 2048; dmap = 0; i0 = I3; }
        else if (it < I5)  { ii = 16; ksi = 15; off = OFF_WGU;  dK = 2048; dN = 5632; dNpad = 5632; dldt = 2048; dmap = 2; i0 = I4; }
        else if (it < I6)  { ii = 17; ksi = 15; off = OFF_WGU;  dK = 2048; dN = 5632; dNpad = 5632; dldt = 2048; dmap = 3; i0 = I5; }
        else if (it < I7)  { ii = 18; ksi = 0;  off = OFF_WD;   dK = 5632; dN = 2048; dNpad = 2048; dldt = 5632; dmap = 0; i0 = I6; }
        else if (it < I8)  { ii = 10; ksi = 0;  off = OFF_WC1K; dK = 2048; dN = 128;  dNpad = 256;  dldt = 2048; dmap = 0; i0 = I7; }
        else if (it < I9)  { ii = 12; ksi = 0;  off = OFF_WC1V; dK = 2048; dN = 128;  dNpad = 256;  dldt = 2048; dmap = 0; i0 = I8; }
        else if (it < I10) { ii = 11; ksi = 0;  off = OFF_WC2K; dK = 128;  dN = 64;   dNpad = 256;  dldt = 256;  dmap = 0; i0 = I9; }
        else               { ii = 13; ksi = 0;  off = OFF_WC2V; dK = 128;  dN = 64;   dNpad = 256;  dldt = 256;  dmap = 0; i0 = I10; }
        transpose_item(PTg[ii], PTg[ksi], (bf16_t*)(ws + off), dK, dN, dNpad, dldt, dmap, scr, it - i0, lane);
    }
    bf16_t* HN = (bf16_t*)(ws + OFF_HN);
    for (int m = gw; m < T_; m += NGW) norm_row_bf16(p.in[0] + (size_t)m * DM, p.in[1], HN + (size_t)m * DM, lane);
    float* COS = (float*)(ws + OFF_COS); float* SIN = (float*)(ws + OFF_SIN);
    for (int idx = blockIdx.x * NTHREADS + tid; idx < S_ * 32; idx += gridDim.x * NTHREADS) {
        const int pos = idx >> 5, i = idx & 31;
        const float inv = exp2f(-(float)i * (13.287712379549449f / 32.0f));
        const float ang = (float)pos * inv;
        float sn, cs; sincos_acc(ang, sn, cs);
        COS[idx] = cs; SIN[idx] = sn;
    }
    float* BIAS = (float*)(ws + OFF_BIAS);
    if (gw < 256) {
        const int which = gw >> 7, j = gw & 127;
        const float* W = which ? p.in[12] : p.in[10]; const float* pe = which ? p.in[9] : p.in[8];
        float s = 0.f;
        for (int k = lane; k < 2048; k += 64) s += pe[k] * W[(size_t)k * 128 + j];
        s = wave_sum(s);
        if (lane == 0) { BIAS[which * 256 + j] = s; BIAS[which * 256 + 128 + j] = 0.f; }
    }
    { unsigned* ctl = (unsigned*)(ws + OFF_CTL); float* rowsq = (float*)(ws + OFF_ROWSQ);
      for (int i = blockIdx.x * NTHREADS + tid; i < T_; i += gridDim.x * NTHREADS) { rowsq[i] = 0.f; if (i < 1024) ctl[i] = 0u; } }
    if (blockIdx.x == 1 % gridDim.x) { unsigned* xb = (unsigned*)(ws + OFF_XBAR); for (int i = tid; i < 4096; i += NTHREADS) xb[i] = 0u; }
    if (blockIdx.x == 0) {
        bf16_t* KCg = (bf16_t*)(ws + OFF_KCG) + (size_t)8 * S_ * 64; bf16_t* VCg = (bf16_t*)(ws + OFF_VCG) + (size_t)8 * S_ * 64;
        for (int i = tid; i < 4096; i += NTHREADS) { KCg[i] = 0; VCg[i] = 0; }
    }
}

DI void postproj_tile(const Params& p, LAS unsigned char* lds, int tile, int tid, int lane, int wave) {
    unsigned char* ws = p.ws;
    const bf16_t* PROJ = (const bf16_t*)(ws + OFF_PROJ);
    const int tok0 = tile * 64, b = tok0 >> 13, s0 = tok0 & (S_ - 1);
    LAS bf16_t* tl = (LAS bf16_t*)lds;
    float* RSQ = (float*)(ws + OFF_RSQ); float* RSKV = (float*)(ws + OFF_RSKV);
    const float* COS = (const float*)(ws + OFF_COS); const float* SIN = (const float*)(ws + OFF_SIN);
    bf16_t* KROPE = (bf16_t*)(ws + OFF_KROPE); bf16_t* KCg = (bf16_t*)(ws + OFF_KCG); bf16_t* VCg = (bf16_t*)(ws + OFF_VCG);
    bf16_t* VST = (bf16_t*)(ws + OFF_VST); bf16_t* VWT = (bf16_t*)(ws + OFF_VWT);
    u32x4 tv[4];
#pragma unroll
    for (int i = 0; i < 4; ++i) {
        const int q = tid + 512 * i, mat = q >> 10, r = (q >> 4) & 63, ch = q & 15;
        tv[i] = *(const u32x4*)(PROJ + (size_t)(tok0 + r) * NPROJ + (mat ? 2496 : 2240) + 8 * ch);
    }
    u32x4 ra[8]; u32x2 rc[8]; unsigned rx1[8], rx2[8], rkc[8], rvc[8]; float rcs[8], rsn[8];
#pragma unroll
    for (int rr = 0; rr < 8; ++rr) {
        const int r = wave * 8 + rr, tok = tok0 + r, sp = s0 + r;
        const bf16_t* pr = PROJ + (size_t)tok * NPROJ;
        ra[rr] = *(const u32x4*)(pr + 8 * lane);
        rc[rr] = *(const u32x2*)(pr + 512 + 4 * lane);
        rx1[rr] = pr[768 + (lane & 31)]; rx2[rr] = pr[800 + (lane & 31)];
        rcs[rr] = COS[sp * 32 + (lane & 31)]; rsn[rr] = SIN[sp * 32 + (lane & 31)];
        rkc[rr] = *(const unsigned*)(pr + 1856 + 2 * lane);
        rvc[rr] = *(const unsigned*)(pr + 1984 + 2 * lane);
    }
#pragma unroll
    for (int i = 0; i < 4; ++i) {
        const int q = tid + 512 * i, mat = q >> 10, r = (q >> 4) & 63, ch = q & 15;
        *(LAS u32x4*)(tl + (mat * 64 + r) * 136 + 8 * ch) = tv[i];
    }
    __syncthreads();
#pragma unroll
    for (int i = 0; i < 4; ++i) {
        const int q = tid + 512 * i, mat = q >> 10, c = (q >> 3) & 127, j8 = q & 7;
        unsigned e[8];
#pragma unroll
        for (int k = 0; k < 8; ++k) e[k] = tl[(mat * 64 + 8 * j8 + k) * 136 + c];
        u32x4 o; o.x = e[0] | (e[1] << 16); o.y = e[2] | (e[3] << 16); o.z = e[4] | (e[5] << 16); o.w = e[6] | (e[7] << 16);
        const int g = c >> 6, d = c & 63;
        bf16_t* dst = (mat ? VWT : VST) + ((size_t)((b * 2 + g) * 64 + d)) * S_ + s0 + 8 * j8;
        *(u32x4*)dst = o;
    }
#pragma unroll
    for (int rr = 0; rr < 8; ++rr) {
        const int r = wave * 8 + rr, tok = tok0 + r, sp = s0 + r;
        const u32x4 a = ra[rr];
        float sq = 0.f;
        { float f; f = bflo(a.x); sq += f * f; f = bfhi(a.x); sq += f * f; f = bflo(a.y); sq += f * f; f = bfhi(a.y); sq += f * f;
          f = bflo(a.z); sq += f * f; f = bfhi(a.z); sq += f * f; f = bflo(a.w); sq += f * f; f = bfhi(a.w); sq += f * f; }
        sq = wave_sum_fast(sq);
        const u32x2 c2 = rc[rr];
        float sk = 0.f;
        { float f; f = bflo(c2.x); sk += f * f; f = bfhi(c2.x); sk += f * f; f = bflo(c2.y); sk += f * f; f = bfhi(c2.y); sk += f * f; }
        sk = wave_sum_fast(sk);
        if (lane == 0) { RSQ[tok] = 1.0f / sqrtf(sq * (1.0f / 512.0f) + 1e-6f); RSKV[tok] = 1.0f / sqrtf(sk * (1.0f / 256.0f) + 1e-6f); }
        if (lane < 32) {
            const float x1 = bf2f(rx1[rr]), x2 = bf2f(rx2[rr]);
            const float cs = rcs[rr], sn = rsn[rr];
            *(unsigned*)(KROPE + (size_t)tok * 64 + 2 * lane) = pk2(x1 * cs - x2 * sn, x1 * sn + x2 * cs);
        }
        const int g = lane >> 5, d = (2 * lane) & 63;
        *(unsigned*)(KCg + ((size_t)((b * 2 + g) * S_ + sp)) * 64 + d) = rkc[rr];
        *(unsigned*)(VCg + ((size_t)((b * 2 + g) * S_ + sp)) * 64 + d) = rvc[rr];
    }
    __syncthreads();
}

constexpr int MLA_BUF = 43008;
DI void mla_load(const bf16_t* KNOPE, const bf16_t* KROPE, const bf16_t* VT, int h, size_t tokb, int kt, u32x4 (&r)[5], int tid) {
#pragma unroll
    for (int i = 0; i < 2; ++i) { const int q = tid + 512 * i, key = q >> 4, ch = q & 15;
        r[i] = *(const u32x4*)(KNOPE + (tokb + kt * 64 + key) * 1024 + h * 128 + 8 * ch); }
    { const int key = tid >> 3, ch = tid & 7; r[2] = *(const u32x4*)(KROPE + (tokb + kt * 64 + key) * 64 + 8 * ch); }
#pragma unroll
    for (int i = 0; i < 2; ++i) { const int q = tid + 512 * i, d = q >> 3, ch = q & 7;
        r[3 + i] = *(const u32x4*)(VT + (size_t)(h * 128 + d) * T_ + tokb + kt * 64 + 8 * ch); }
}
DI void mla_store(LAS unsigned char* buf, const u32x4 (&r)[5], int tid) {
#pragma unroll
    for (int i = 0; i < 2; ++i) { const int q = tid + 512 * i, key = q >> 4, ch = q & 15; *(LAS u32x4*)(buf + key * 400 + ch * 16) = r[i]; }
    { const int key = tid >> 3, ch = tid & 7; *(LAS u32x4*)(buf + key * 400 + 256 + ch * 16) = r[2]; }
#pragma unroll
    for (int i = 0; i < 2; ++i) { const int q = tid + 512 * i, d = q >> 3, ch = q & 7; LAS unsigned char* vp = buf + 25600 + d * 136 + ch * 16;
        *(LAS u32x2*)vp = (u32x2){r[3 + i].x, r[3 + i].y}; *(LAS u32x2*)(vp + 8) = (u32x2){r[3 + i].z, r[3 + i].w}; }
}
DI bf16x8 cat4(bf16x4 lo, bf16x4 hi) { bf16x8 r; r[0] = lo[0]; r[1] = lo[1]; r[2] = lo[2]; r[3] = lo[3]; r[4] = hi[0]; r[5] = hi[1]; r[6] = hi[2]; r[7] = hi[3]; return r; }
DI bf16x8 packp(const f32x16& s, int t) {
    u32x4 w;
    if (t == 0) { w.x = pk2(s[0], s[1]); w.y = pk2(s[2], s[3]); w.z = pk2(s[4], s[5]); w.w = pk2(s[6], s[7]); }
    else { w.x = pk2(s[8], s[9]); w.y = pk2(s[10], s[11]); w.z = pk2(s[12], s[13]); w.w = pk2(s[14], s[15]); }
    return __builtin_bit_cast(bf16x8, w);
}

DI float vmax3(float a, float b, float c) { float r; asm("v_max3_f32 %0, %1, %2, %3" : "=v"(r) : "v"(a), "v"(b), "v"(c)); return r; }
DI float max16(const f32x16& s) {
    float a = vmax3(s[0], s[1], s[2]), b = vmax3(s[3], s[4], s[5]), c = vmax3(s[6], s[7], s[8]), d = vmax3(s[9], s[10], s[11]);
    a = vmax3(a, s[12], s[13]); b = vmax3(b, s[14], s[15]);
    return vmax3(vmax3(a, b, c), d, d);
}
DI void mla_unit(const Params& p, LAS unsigned char* lds, int b, int h, int qb, int tid) {
    unsigned char* ws = p.ws;
    const bf16_t* QMLA = (const bf16_t*)(ws + OFF_QMLA); const bf16_t* KNOPE = (const bf16_t*)(ws + OFF_KNOPE);
    const bf16_t* KROPE = (const bf16_t*)(ws + OFF_KROPE); const bf16_t* VT = (const bf16_t*)(ws + OFF_VT);
    bf16_t* MIX = (bf16_t*)(ws + OFF_MIX);
    const int lane = tid & 63, w = __builtin_amdgcn_readfirstlane(tid >> 6), c = lane & 31, hi = lane >> 5;
    const int q0 = qb * 256, qw0 = q0 + 32 * w, qpos = qw0 + c;
    const size_t tokb = (size_t)b * S_;
    bf16x8 qf[12];
    { const bf16_t* qp = QMLA + (tokb + qpos) * 1536 + h * 192 + 8 * hi;
#pragma unroll
      for (int st = 0; st < 12; ++st) qf[st] = *(const bf16x8*)(qp + 16 * st); }
    f32x16 o[4];
#pragma unroll
    for (int db = 0; db < 4; ++db)
#pragma unroll
        for (int i = 0; i < 16; ++i) o[db][i] = 0.f;
    float m = -1e20f, l = 0.f;
    const int nkt = 4 * qb + 4;
    u32x4 r[5];
    __syncthreads();
    mla_load(KNOPE, KROPE, VT, h, tokb, 0, r, tid); mla_store(lds, r, tid);
    __syncthreads();
    for (int kt = 0; kt < nkt; ++kt) {
        const bool more = kt + 1 < nkt;
        if (more) mla_load(KNOPE, KROPE, VT, h, tokb, kt + 1, r, tid);
        LAS const unsigned char* buf = lds + (kt & 1) * MLA_BUF;
        if (kt * 64 <= qw0 + 31) {
#pragma unroll
            for (int sub = 0; sub < 2; ++sub) {
                const int kbase = kt * 64 + 32 * sub;
                f32x16 s;
#pragma unroll
                for (int i = 0; i < 16; ++i) s[i] = 0.f;
#pragma unroll
                for (int st = 0; st < 12; ++st) {
                    const bf16x8 a = *(LAS const bf16x8*)(buf + (32 * sub + c) * 400 + st * 32 + hi * 16);
                    s = MFMA32(a, qf[st], s);
                }
                if (kbase + 31 > qw0) {
                    int dbase = qpos - kbase - 4 * hi;
                    asm volatile("" : "+v"(dbase));
#pragma unroll
                    for (int i = 0; i < 16; ++i) if ((dbase - ((i & 3) + 8 * (i >> 2))) < 0) s[i] = -1e30f;
                }
                float mx = max16(s);
                mx = xhalf_max(mx);
                const float mn = (mx > m + 8.f) ? mx : m, alpha = fexp2(m - mn); m = mn; l *= alpha;
                if (__any(alpha != 1.f)) {
#pragma unroll
                    for (int db = 0; db < 4; ++db) o[db] = o[db] * alpha;
                }
                float ps = 0.f;
#pragma unroll
                for (int i = 0; i < 16; ++i) { const float pv = fexp2(s[i] - m); s[i] = pv; ps += pv; }
                l += ps;
                const bf16x8 pb0 = packp(s, 0), pb1 = packp(s, 1);
#pragma unroll
                for (int db = 0; db < 4; ++db) {
                    LAS const unsigned char* ap = buf + 25600 + (32 * db + c) * 136 + (32 * sub + 4 * hi) * 2;
                    const bf16x8 v0 = cat4(*(LAS const bf16x4*)(ap), *(LAS const bf16x4*)(ap + 16));
                    const bf16x8 v1 = cat4(*(LAS const bf16x4*)(ap + 32), *(LAS const bf16x4*)(ap + 48));
                    o[db] = MFMA32(v0, pb0, o[db]); o[db] = MFMA32(v1, pb1, o[db]);
                }
            }
        }
        if (more) mla_store(lds + ((kt + 1) & 1) * MLA_BUF, r, tid);
        __syncthreads();
    }
    const float lt = xhalf_sum(l), inv = 1.0f / lt;
    bf16_t* op = MIX + (tokb + qpos) * 2048 + h * 128 + 4 * hi;
#pragma unroll
    for (int db = 0; db < 4; ++db)
#pragma unroll
        for (int g4 = 0; g4 < 4; ++g4) {
            u32x2 wv; wv.x = pk2(o[db][4 * g4] * inv, o[db][4 * g4 + 1] * inv); wv.y = pk2(o[db][4 * g4 + 2] * inv, o[db][4 * g4 + 3] * inv);
            *(u32x2*)(op + 32 * db + 8 * g4) = wv;
        }
}

constexpr int NSA_KC = 0, NSA_VCT = 73728, NSA_IMP = 140288, NSA_SEL = 156672, NSA_UNI = 157184, NSA_NL = 157200, NSA_LIST = 157216;
constexpr int NSA_TBUF = 17920;

template <int MODE>
DI void nsa_tile(LAS const unsigned char* buf, const bf16x8 (&qf)[4], f32x16 (&o)[2], float& m, float& l, int kbase0, int t, bool lanesel, float slope2, int c, int hi) {
#pragma unroll
    for (int sub = 0; sub < 2; ++sub) {
        const int klo = kbase0 + 32 * sub;
        bool full, none;
        if (MODE == 0) { full = lanesel && (klo + 31 <= t); none = !lanesel || (klo > t); }
        else { full = (klo + 31 <= t) && (klo >= t - 511); none = (klo > t) || (klo + 31 < t - 511); }
        if (__all(none)) continue;
        int dbase = t - klo - 4 * hi;
        asm volatile("" : "+v"(dbase));
        const float b0 = none ? -1e30f : -slope2 * (float)dbase;
        f32x16 s;
#pragma unroll
        for (int i = 0; i < 16; ++i) s[i] = fmaf(slope2, (float)((i & 3) + 8 * (i >> 2)), b0);
#pragma unroll
        for (int st = 0; st < 4; ++st) {
            const bf16x8 a = *(LAS const bf16x8*)(buf + (32 * sub + c) * 144 + st * 32 + hi * 16);
            s = MFMA32(a, qf[st], s);
        }
        if (__any(!full && !none)) {
#pragma unroll
            for (int i = 0; i < 16; ++i) {
                const int dist = dbase - ((i & 3) + 8 * (i >> 2));
                const bool valid = (MODE == 0) ? (lanesel && dist >= 0) : ((unsigned)dist < 512u);
                if (!valid) s[i] = -1e30f;
            }
        }
        float mx = max16(s);
        mx = xhalf_max(mx);
        if (__any(mx > m + 8.f)) {
            const float mn = fmaxf(m, mx), alpha = fexp2(m - mn); m = mn; l *= alpha;
            o[0] = o[0] * alpha; o[1] = o[1] * alpha;
        }
        float ps = 0.f;
#pragma unroll
        for (int i = 0; i < 16; ++i) { const float pv = fexp2(s[i] - m); s[i] = pv; ps += pv; }
        l += ps;
        const bf16x8 pb0 = packp(s, 0), pb1 = packp(s, 1);
#pragma unroll
        for (int db = 0; db < 2; ++db)
#pragma unroll
            for (int tt = 0; tt < 2; ++tt) {
                LAS const unsigned char* ap = buf + 9216 + (32 * db + c) * 136 + (32 * sub + 16 * tt + 4 * hi) * 2;
                const bf16x8 a = cat4(*(LAS const bf16x4*)ap, *(LAS const bf16x4*)(ap + 16));
                o[db] = MFMA32(a, tt == 0 ? pb0 : pb1, o[db]);
            }
    }
}

DI void nsa_unit(const Params& p, LAS unsigned char* lds, unsigned char* ldsg, int bg, int qt, int tid) {
    unsigned char* ws = p.ws;
    const bf16_t* PROJ = (const bf16_t*)(ws + OFF_PROJ);
    const bf16_t* KC = (const bf16_t*)(ws + OFF_KC); const bf16_t* VCT = (const bf16_t*)(ws + OFF_VCT);
    const bf16_t* VST = (const bf16_t*)(ws + OFF_VST); const bf16_t* VWT = (const bf16_t*)(ws + OFF_VWT);
    bf16_t* MIX = (bf16_t*)(ws + OFF_MIX);
    const int lane = tid & 63, w = __builtin_amdgcn_readfirstlane(tid >> 6), c = lane & 31, hi = lane >> 5;
    const int b = bg >> 1, g = bg & 1, q0 = qt * 32;
    const int head = c & 7, qi = c >> 3, tw0 = q0 + 4 * w, t = tw0 + qi, hh = g * 8 + head;
    const size_t tokb = (size_t)b * S_, tok = tokb + t;
    const float sc2 = 0.125f * LOG2E, slope2 = exp2f(-0.5f * (float)(hh + 1)) * LOG2E;

    LAS unsigned* SEL = (LAS unsigned*)(lds + NSA_SEL);
    LAS unsigned* UNI = (LAS unsigned*)(lds + NSA_UNI);
    LAS int* NL = (LAS int*)(lds + NSA_NL);
    LAS int* LIST = (LAS int*)(lds + NSA_LIST);
    LAS float* IMPw = (LAS float*)(lds + NSA_IMP + w * 2048);

    __syncthreads();
    const int nct = (q0 / 16 + 1 + 31) >> 5;
    for (int q0_ = tid; q0_ < nct * 256; q0_ += 4 * NTHREADS) {
        u32x4 v[4];
#pragma unroll
        for (int j = 0; j < 4; ++j) { const int q = q0_ + j * NTHREADS; if (q < nct * 256) v[j] = *(const u32x4*)(KC + ((size_t)(bg * 512 + (q >> 3))) * 64 + 8 * (q & 7)); }
#pragma unroll
        for (int j = 0; j < 4; ++j) { const int q = q0_ + j * NTHREADS; if (q < nct * 256) *(LAS u32x4*)(lds + NSA_KC + (q >> 3) * 144 + (q & 7) * 16) = v[j]; }
    }
    { const int cpr = nct * 4;
      for (int q0_ = tid; q0_ < 64 * cpr; q0_ += 4 * NTHREADS) {
          u32x4 v[4];
#pragma unroll
          for (int j = 0; j < 4; ++j) { const int q = q0_ + j * NTHREADS; if (q < 64 * cpr) { const int d = q / cpr, ch = q - d * cpr; v[j] = *(const u32x4*)(VCT + ((size_t)(bg * 64 + d)) * 512 + 8 * ch); } }
#pragma unroll
          for (int j = 0; j < 4; ++j) { const int q = q0_ + j * NTHREADS; if (q < 64 * cpr) { const int d = q / cpr, ch = q - d * cpr; LAS unsigned char* vp_ = lds + NSA_VCT + d * 1032 + ch * 16; *(LAS u32x2*)vp_ = (u32x2){v[j].x, v[j].y}; *(LAS u32x2*)(vp_ + 8) = (u32x2){v[j].z, v[j].w}; } }
      } }
    if (tid < 4) UNI[tid] = 0u;

    bf16x8 qf[4];
    { const bf16_t* qp = PROJ + tok * NPROJ + 832 + hh * 64 + 8 * hi;
#pragma unroll
      for (int st = 0; st < 4; ++st) {
          const u32x4 raw = *(const u32x4*)(qp + 16 * st); u32x4 sc;
          sc.x = pk2(bflo(raw.x) * sc2, bfhi(raw.x) * sc2); sc.y = pk2(bflo(raw.y) * sc2, bfhi(raw.y) * sc2);
          sc.z = pk2(bflo(raw.z) * sc2, bfhi(raw.z) * sc2); sc.w = pk2(bflo(raw.w) * sc2, bfhi(raw.w) * sc2);
          qf[st] = __builtin_bit_cast(bf16x8, sc); } }
    const bf16_t* gp = PROJ + tok * NPROJ + 2624 + hh * 3;
    const float gate_c = fsigmoid(bf2f(gp[0])), gate_s = fsigmoid(bf2f(gp[1])), gate_w = fsigmoid(bf2f(gp[2]));
    __syncthreads();

    f32x16 out[2];
    {
        const int cwm = (tw0 + 3 >= 31) ? ((tw0 + 3 - 31) >> 4) : -1;
        const int ntw = (cwm >= 0) ? (cwm >> 5) + 1 : 0;
        const float slope16 = 16.f * slope2;
        float m1 = -1e20f, l1 = 0.f;
        for (int tile = 0; tile < ntw; ++tile) {
            int dbase = t - 31 - 512 * tile - 64 * hi;
            asm volatile("" : "+v"(dbase));
            const float b0 = -slope2 * (float)dbase;
            f32x16 s;
#pragma unroll
            for (int i = 0; i < 16; ++i) s[i] = fmaf(slope16, (float)((i & 3) + 8 * (i >> 2)), b0);
#pragma unroll
            for (int st = 0; st < 4; ++st) {
                const bf16x8 a = *(LAS const bf16x8*)(lds + NSA_KC + (32 * tile + c) * 144 + st * 32 + hi * 16);
                s = MFMA32(a, qf[st], s);
            }
            if (512 * tile + 496 + 31 > tw0) {
#pragma unroll
                for (int i = 0; i < 16; ++i) if ((dbase - 16 * ((i & 3) + 8 * (i >> 2))) < 0) s[i] = -1e30f;
            }
            const float mn = fmaxf(m1, max16(s));
            float ps = 0.f;
#pragma unroll
            for (int i = 0; i < 16; ++i) ps += fexp2(s[i] - mn);
            l1 = l1 * fexp2(m1 - mn) + ps; m1 = mn;
        }
        const float mo = xhalf_partner(m1, hi), lo = xhalf_partner(l1, hi);
        const float M = fmaxf(m1, mo), L = l1 * fexp2(m1 - M) + lo * fexp2(mo - M);
        const float Moff = (L > 0.f) ? (M + __log2f(L)) : 1e30f;
#pragma unroll
        for (int i = 0; i < 8; ++i) IMPw[lane + 64 * i] = 0.f;
        LDS_WAIT();
        f32x16 oc[2];
#pragma unroll
        for (int db = 0; db < 2; ++db)
#pragma unroll
            for (int i = 0; i < 16; ++i) oc[db][i] = 0.f;
        float prev3 = 0.f;
        for (int tile = 0; tile < ntw; ++tile) {
            int dbase = t - 31 - 512 * tile - 64 * hi;
            asm volatile("" : "+v"(dbase));
            const float b0 = -slope2 * (float)dbase;
            f32x16 s;
#pragma unroll
            for (int i = 0; i < 16; ++i) s[i] = fmaf(slope16, (float)((i & 3) + 8 * (i >> 2)), b0);
#pragma unroll
            for (int st = 0; st < 4; ++st) {
                const bf16x8 a = *(LAS const bf16x8*)(lds + NSA_KC + (32 * tile + c) * 144 + st * 32 + hi * 16);
                s = MFMA32(a, qf[st], s);
            }
            if (512 * tile + 496 + 31 > tw0) {
#pragma unroll
                for (int i = 0; i < 16; ++i) if ((dbase - 16 * ((i & 3) + 8 * (i >> 2))) < 0) s[i] = -1e30f;
            }
#pragma unroll
            for (int i = 0; i < 16; ++i) s[i] = fexp2(s[i] - Moff);
            float pp[4];
#pragma unroll
            for (int r = 0; r < 4; ++r) pp[r] = xhalf_partner(s[4 * r + 3], hi);
#pragma unroll
            for (int r = 0; r < 4; ++r) {
                const float a = 2.f * (s[4 * r] + s[4 * r + 1] + s[4 * r + 2]) + s[4 * r + 3];
                const float cin = hi ? pp[r] : (r > 0 ? pp[r > 0 ? r - 1 : 0] : prev3);
                float v = a + cin;
                v = sum8(v);
                if (head == 0) IMPw[qi * 128 + 8 * tile + 2 * r + hi] = v;
            }
            prev3 = pp[3];
            const bf16x8 pb0 = packp(s, 0), pb1 = packp(s, 1);
#pragma unroll
            for (int db = 0; db < 2; ++db)
#pragma unroll
                for (int tt = 0; tt < 2; ++tt) {
                    LAS const unsigned char* ap = lds + NSA_VCT + (32 * db + c) * 1032 + (32 * tile + 16 * tt + 4 * hi) * 2;
                    const bf16x8 a = cat4(*(LAS const bf16x4*)ap, *(LAS const bf16x4*)(ap + 16));
                    oc[db] = MFMA32(a, tt == 0 ? pb0 : pb1, oc[db]);
                }
        }
        out[0] = oc[0] * gate_c; out[1] = oc[1] * gate_c;
        LDS_WAIT();
        for (int qi2 = 0; qi2 < 4; ++qi2) {
            const int t2 = tw0 + qi2, blk = t2 >> 6;
            LAS unsigned* kp = (LAS unsigned*)(IMPw + qi2 * 128);
            const int n0 = lane, n1 = lane + 64;
            const unsigned b0 = kp[n0], b1 = kp[n1];
            const bool f0 = (n0 == 0) || (n0 == blk) || (n0 == blk - 1), f1 = (n1 == blk) || (n1 == blk - 1);
            const unsigned k0 = (n0 <= blk) ? ((((f0 ? 0x461C4000u : b0)) & 0xFFFFFF80u) | (unsigned)(127 - n0)) : 0u;
            const unsigned k1 = (n1 <= blk) ? ((((f1 ? 0x461C4000u : b1)) & 0xFFFFFF80u) | (unsigned)(127 - n1)) : 0u;
            unsigned T = 0u;
#pragma unroll 1
            for (int bit = 30; bit >= 0; --bit) {
                const unsigned cand = T | (1u << bit);
                const int cnt = __popcll(__ballot(k0 >= cand)) + __popcll(__ballot(k1 >= cand));
                if (cnt >= 16) T = cand;
            }
            const bool s0 = (k0 != 0u) && (k0 >= T), s1 = (k1 != 0u) && (k1 >= T);
            const unsigned long long m0 = __ballot(s0), m1b = __ballot(s1);
            if (lane == 0) {
                const unsigned w0 = (unsigned)m0, w1 = (unsigned)(m0 >> 32), w2 = (unsigned)m1b, w3 = (unsigned)(m1b >> 32);
                LAS unsigned* sp = SEL + (4 * w + qi2) * 4;
                sp[0] = w0; sp[1] = w1; sp[2] = w2; sp[3] = w3;
                unsigned* ug = (unsigned*)(ldsg + NSA_UNI);
                atomicOr(ug + 0, w0); atomicOr(ug + 1, w1); atomicOr(ug + 2, w2); atomicOr(ug + 3, w3);
            }
        }
    }
    __syncthreads();
    if (tid == 0) {
        int cnt = 0;
        for (int wd = 0; wd < 4; ++wd) { unsigned bits = UNI[wd]; while (bits) { const int nb = 32 * wd + __builtin_ctz(bits); bits &= bits - 1; LIST[cnt++] = nb; } }
        NL[0] = cnt;
    }
    __syncthreads();
    const int kq = tid >> 3, kch = tid & 7;
    const int toff = kq * 144 + kch * 16, voff = 9216 + kq * 136 + kch * 16;
#define ST_V(base, v) do { LAS unsigned char* vp_ = (base) + voff; *(LAS u32x2*)vp_ = (u32x2){(v).x, (v).y}; *(LAS u32x2*)(vp_ + 8) = (u32x2){(v).z, (v).w}; } while (0)
    {
        const int nl = NL[0];
        const bf16_t* Ksrc = PROJ + (tokb + kq) * NPROJ + 2112 + g * 64 + 8 * kch;
        const bf16_t* Vsrc = VST + ((size_t)(bg * 64 + kq)) * S_ + 8 * kch;
        f32x16 o[2];
#pragma unroll
        for (int db = 0; db < 2; ++db)
#pragma unroll
            for (int i = 0; i < 16; ++i) o[db][i] = 0.f;
        float m = -1e20f, l = 0.f;
        u32x4 rk1, rv1, rk2, rv2;
        { const int nb = LIST[0]; rk1 = *(const u32x4*)(Ksrc + (size_t)(64 * nb) * NPROJ); rv1 = *(const u32x4*)(Vsrc + 64 * nb); }
        *(LAS u32x4*)(lds + toff) = rk1; ST_V(lds, rv1);
        if (nl > 1) { const int nb = LIST[1]; rk1 = *(const u32x4*)(Ksrc + (size_t)(64 * nb) * NPROJ); rv1 = *(const u32x4*)(Vsrc + 64 * nb); }
        __syncthreads();
        int cb = 0;
        for (int i = 0; i < nl; ++i) {
            const int nb = LIST[i];
            if (i + 2 < nl) { const int nb2 = LIST[i + 2]; rk2 = *(const u32x4*)(Ksrc + (size_t)(64 * nb2) * NPROJ); rv2 = *(const u32x4*)(Vsrc + 64 * nb2); }
            const bool lanesel = (SEL[(4 * w + qi) * 4 + (nb >> 5)] >> (nb & 31)) & 1u;
            if (__any(lanesel))
                nsa_tile<0>(lds + cb * NSA_TBUF, qf, o, m, l, 64 * nb, t, lanesel, slope2, c, hi);
            const int nbuf = (cb == 2) ? 0 : cb + 1;
            if (i + 1 < nl) { *(LAS u32x4*)(lds + nbuf * NSA_TBUF + toff) = rk1; ST_V(lds + nbuf * NSA_TBUF, rv1); }
            rk1 = rk2; rv1 = rv2; cb = nbuf;
            __syncthreads();
        }
        const float lt = xhalf_sum(l), sc = gate_s / lt;
        out[0] = out[0] + o[0] * sc; out[1] = out[1] + o[1] * sc;
    }
    {
        const int lo_key = (q0 - 511 > 0) ? (q0 - 511) : 0;
        const int kt_lo = lo_key >> 6, kt_hi = (q0 + 31) >> 6;
        const bf16_t* Ksrc = PROJ + (tokb + kq) * NPROJ + 2368 + g * 64 + 8 * kch;
        const bf16_t* Vsrc = VWT + ((size_t)(bg * 64 + kq)) * S_ + 8 * kch;
        f32x16 o[2];
#pragma unroll
        for (int db = 0; db < 2; ++db)
#pragma unroll
            for (int i = 0; i < 16; ++i) o[db][i] = 0.f;
        float m = -1e20f, l = 0.f;
        u32x4 rk1, rv1, rk2, rv2;
        rk1 = *(const u32x4*)(Ksrc + (size_t)(64 * kt_lo) * NPROJ); rv1 = *(const u32x4*)(Vsrc + 64 * kt_lo);
        *(LAS u32x4*)(lds + toff) = rk1; ST_V(lds, rv1);
        if (kt_lo < kt_hi) { rk1 = *(const u32x4*)(Ksrc + (size_t)(64 * (kt_lo + 1)) * NPROJ); rv1 = *(const u32x4*)(Vsrc + 64 * (kt_lo + 1)); }
        __syncthreads();
        int cb = 0;
        for (int kt = kt_lo; kt <= kt_hi; ++kt) {
            if (kt + 2 <= kt_hi) { rk2 = *(const u32x4*)(Ksrc + (size_t)(64 * (kt + 2)) * NPROJ); rv2 = *(const u32x4*)(Vsrc + 64 * (kt + 2)); }
            if (!(64 * kt + 63 < tw0 - 511 || 64 * kt > tw0 + 3))
                nsa_tile<1>(lds + cb * NSA_TBUF, qf, o, m, l, 64 * kt, t, true, slope2, c, hi);
            const int nbuf = (cb == 2) ? 0 : cb + 1;
            if (kt < kt_hi) { *(LAS u32x4*)(lds + nbuf * NSA_TBUF + toff) = rk1; ST_V(lds + nbuf * NSA_TBUF, rv1); }
            rk1 = rk2; rv1 = rv2; cb = nbuf;
            __syncthreads();
        }
        const float lt = xhalf_sum(l), sc = gate_w / lt;
        out[0] = out[0] + o[0] * sc; out[1] = out[1] + o[1] * sc;
    }
    bf16_t* op = MIX + tok * 2048 + 1024 + hh * 64 + 4 * hi;
#pragma unroll
    for (int db = 0; db < 2; ++db)
#pragma unroll
        for (int g4 = 0; g4 < 4; ++g4) {
            u32x2 wv; wv.x = pk2(out[db][4 * g4], out[db][4 * g4 + 1]); wv.y = pk2(out[db][4 * g4 + 2], out[db][4 * g4 + 3]);
            *(u32x2*)(op + 32 * db + 8 * g4) = wv;
        }
}

#define XB_TMO      128
#define XB_XCNT(j)  (256  + 64 * (j))
#define XB_XSUB(j)  (1280 + 64 * (j))
#define XB_XGEN(j)  (2304 + 64 * (j))
#define XB_TOP      3328
#define XB_TOPGEN   3392
#define XB_SPIN_CAP (1u << 18)
DI unsigned xb_ld(unsigned* p)              { return __hip_atomic_load(p, __ATOMIC_RELAXED, __HIP_MEMORY_SCOPE_AGENT); }
DI unsigned xb_add(unsigned* p, unsigned v) { return __hip_atomic_fetch_add(p, v, __ATOMIC_RELAXED, __HIP_MEMORY_SCOPE_AGENT); }
DI unsigned xb_xcc_id() { return (unsigned)__builtin_amdgcn_s_getreg((3 << 11) | 20) & 0xFu; }
#define XB_SPIN(cond, bar) do { unsigned _sp = 0; while (cond) { __builtin_amdgcn_s_sleep(1); \
    if ((++_sp & 255u) == 0u) { if (xb_ld(&(bar)[XB_TMO])) break; if (_sp > XB_SPIN_CAP) { atomicAdd(&(bar)[XB_TMO], 1u); break; } } } } while (0)
DI void xcd_barrier_complete(unsigned* bar, unsigned x, unsigned& nloc, unsigned& nx) {
    const unsigned G = gridDim.x * gridDim.y * gridDim.z;
    unsigned sum, cnt, mine, sp = 0u;
    for (;;) {
        sum = 0u; cnt = 0u; mine = 0u;
#pragma unroll
        for (unsigned j = 0; j < 16; ++j) { const unsigned c = xb_ld(&bar[XB_XCNT(j)]); sum += c; cnt += (c > 0u) ? 1u : 0u; mine = (j == x) ? c : mine; }
        if (sum == G) break;
        __builtin_amdgcn_s_sleep(1);
        if ((++sp & 255u) == 0u) { if (xb_ld(&bar[XB_TMO])) break; if (sp > XB_SPIN_CAP) { atomicAdd(&bar[XB_TMO], 1u); break; } }
    }
    nloc = mine > 0u ? mine : 1u; nx = cnt > 0u ? cnt : 1u;
}
DI void xcd_barrier(unsigned* bar, unsigned x, volatile LAS unsigned* st) {
    asm volatile("s_waitcnt vmcnt(0)" ::: "memory");
    __syncthreads();
    if (threadIdx.x == 0) {
        __builtin_amdgcn_s_waitcnt(0);
        unsigned nloc = st[0], nx = st[1];
        if (nloc == 0u) { xcd_barrier_complete(bar, x, nloc, nx); st[0] = nloc; st[1] = nx; }
        const unsigned old = xb_add(&bar[XB_XSUB(x)], 1u);
        const unsigned gen = old / nloc;
        if (old + 1u == (gen + 1u) * nloc) {
            __builtin_amdgcn_fence(__ATOMIC_RELEASE, "agent");
            asm volatile("s_waitcnt vmcnt(0)" ::: "memory");
            const unsigned og = xb_add(&bar[XB_TOP], 1u);
            const unsigned tg = og / nx;
            if (og + 1u == (tg + 1u) * nx) xb_add(&bar[XB_TOPGEN], 1u);
            else XB_SPIN(xb_ld(&bar[XB_TOPGEN]) == tg, bar);
            __builtin_amdgcn_fence(__ATOMIC_ACQUIRE, "agent");
            xb_add(&bar[XB_XGEN(x)], 1u);
            asm volatile("s_waitcnt vmcnt(0)" ::: "memory");
        } else {
            XB_SPIN(xb_ld(&bar[XB_XGEN(x)]) == gen, bar);
            __builtin_amdgcn_fence(__ATOMIC_ACQUIRE, "agent");
            asm volatile("s_waitcnt vmcnt(0)" ::: "memory");
        }
    }
    __syncthreads();
}
__global__ void __launch_bounds__(NTHREADS, 2) fwd_megakernel(Params p) {
    extern __shared__ __attribute__((aligned(16))) unsigned char dyn_lds[];
    cg::grid_group grid = cg::this_grid();
    LAS unsigned char* lds = (LAS unsigned char*)dyn_lds;
    const int G = gridDim.x, bid = blockIdx.x;
    volatile LAS unsigned* xst = (volatile LAS unsigned*)(lds + 158688);
    if (threadIdx.x < 2) xst[threadIdx.x] = 0u;
    __syncthreads();
    unsigned* xbar = (unsigned*)(p.ws + OFF_XBAR);
    const unsigned xcc = xb_xcc_id();
#define PHASE_IDS const int tid = fresh_tid(), lane = tid & 63, wave = __builtin_amdgcn_readfirstlane(tid >> 6); (void)lane; (void)wave
    unsigned char* ws = p.ws;
    bf16_t* HN = (bf16_t*)(ws + OFF_HN); bf16_t* PROJ = (bf16_t*)(ws + OFF_PROJ);
    const float* RSQ = (const float*)(ws + OFF_RSQ); const float* RSKV = (const float*)(ws + OFF_RSKV);
    const float* BIAS = (const float*)(ws + OFF_BIAS);
    using pg8::Gemm; using pg8::Epi; using pg8::StaticOrder;

    for (int rep = 0; rep < REP_P0; ++rep) { PHASE_IDS; prologue(p, lds, tid, lane, wave); }
    grid.sync();
    if (threadIdx.x == 0) (void)xb_add(&xbar[XB_XCNT(xcc)], 1u);
    {
        Gemm g{HN, (const bf16_t*)(ws + OFF_WIN), T_, NPROJ, DM, DM, DM}; StaticOrder S; S.init(T_, NPROJ, G, bid);
        Epi E{pg8::EPI_STORE, PROJ, NPROJ, NPROJ, nullptr, 1.f, nullptr, nullptr, nullptr, nullptr, nullptr, nullptr};
        for (int rep = 0; rep < REP_P1; ++rep) pg8::gemm_phase(lds, g, S, E);
    }
    xcd_barrier(xbar, xcc, xst);
    { PHASE_IDS; for (int tile = bid; tile < T_ / 64; tile += G) postproj_tile(p, lds, tile, tid, lane, wave); }
    xcd_barrier(xbar, xcc, xst);
    {
        { Gemm g{PROJ, (const bf16_t*)(ws + OFF_WUQ), T_, 1536, 512, NPROJ, 512}; StaticOrder S; S.init(T_, 1536, G, bid);
          Epi E{pg8::EPI_Q, (bf16_t*)(ws + OFF_QMLA), 1536, 1536, RSQ, 0.07216878364870322f * LOG2E, (const float*)(ws + OFF_COS), (const float*)(ws + OFF_SIN), nullptr, nullptr, nullptr, nullptr};
          pg8::gemm_phase(lds, g, S, E); }
        { Gemm g{PROJ + 512, (const bf16_t*)(ws + OFF_WK), T_, 1024, 256, NPROJ, 256}; StaticOrder S; S.init(T_, 1024, G, bid);
          Epi E{pg8::EPI_STORE, (bf16_t*)(ws + OFF_KNOPE), 1024, 1024, RSKV, 1.f, nullptr, nullptr, nullptr, nullptr, nullptr, nullptr};
          pg8::gemm_phase(lds, g, S, E); }
        { Gemm g{(const bf16_t*)(ws + OFF_WV), PROJ + 512, 1024, T_, 256, 256, NPROJ}; StaticOrder S; S.init(1024, T_, G, bid);
          Epi E{pg8::EPI_VT, (bf16_t*)(ws + OFF_VT), T_, T_, RSKV, 1.f, nullptr, nullptr, nullptr, nullptr, nullptr, nullptr};
          pg8::gemm_phase(lds, g, S, E); }
    }
    xcd_barrier(xbar, xcc, xst);
    if (bid < 16) {
        StaticOrder S; S.init(4096, 256, 16, bid);
        { Gemm g{(const bf16_t*)(ws + OFF_KCG), (const bf16_t*)(ws + OFF_WC1K), 4096, 256, 2048, 1024, 2048};
          Epi E{pg8::EPI_SILU, (bf16_t*)(ws + OFF_HIDK), 256, 256, nullptr, 1.f, nullptr, nullptr, BIAS, nullptr, nullptr, nullptr};
          pg8::gemm_phase(lds, g, S, E); }
        __threadfence(); __syncthreads();
        { Gemm g{(const bf16_t*)(ws + OFF_HIDK), (const bf16_t*)(ws + OFF_WC2K), 4096, 256, 256, 256, 256};
          Epi E{pg8::EPI_STORE, (bf16_t*)(ws + OFF_KC), 64, 64, nullptr, 1.f, nullptr, nullptr, nullptr, nullptr, nullptr, nullptr};
          pg8::gemm_phase(lds, g, S, E); }
    } else if (bid < 32) {
        { StaticOrder S; S.init(4096, 256, 16, bid - 16);
          Gemm g{(const bf16_t*)(ws + OFF_VCG), (const bf16_t*)(ws + OFF_WC1V), 4096, 256, 2048, 1024, 2048};
          Epi E{pg8::EPI_SILU, (bf16_t*)(ws + OFF_HIDV), 256, 256, nullptr, 1.f, nullptr, nullptr, BIAS + 256, nullptr, nullptr, nullptr};
          pg8::gemm_phase(lds, g, S, E); }
        __threadfence(); __syncthreads();
        { StaticOrder S; S.init(256, 4096, 16, bid - 16);
          Gemm g{(const bf16_t*)(ws + OFF_WC2V), (const bf16_t*)(ws + OFF_HIDV), 256, 4096, 256, 256, 256};
          Epi E{pg8::EPI_VCT, (bf16_t*)(ws + OFF_VCT), 512, 4096, nullptr, 1.f, nullptr, nullptr, nullptr, nullptr, nullptr, nullptr};
          pg8::gemm_phase(lds, g, S, E); }
    }
    for (int rep = 0; rep < REP_MLA; ++rep) {
        unsigned* ctl = (unsigned*)(ws + OFF_CTL) + rep * 256;
        LAS int* QU = (LAS int*)(lds + 158208);
        for (int k = 0; k < 8; ++k) {
            const int qq = (bid + k) & 7;
            for (;;) {
                PHASE_IDS;
                __syncthreads();
                if (tid == 0) QU[0] = (int)atomicAdd(ctl + qq * 16, 1u);
                __syncthreads();
                const int qi_ = QU[0];
                if (qi_ >= 128) break;
                const int pr_ = qi_ >> 6, r_ = qi_ & 63;
                const int qb = 31 - (r_ >> 1), bh = qq + 8 * (2 * pr_ + (r_ & 1));
                mla_unit(p, lds, bh >> 3, bh & 7, qb, tid);
            }
        }
    }
    xcd_barrier(xbar, xcc, xst);
    for (int rep = 0; rep < REP_NSA; ++rep)
    for (int u = bid, rnd = 0; u < 2048; u += G, ++rnd) {
        PHASE_IDS;
        const int bg = (u + rnd) & 7, qt = 255 - (u >> 3);
        nsa_unit(p, lds, dyn_lds, bg, qt, tid);
    }
    xcd_barrier(xbar, xcc, xst);
    {
        Gemm g{(const bf16_t*)(ws + OFF_MIX), (const bf16_t*)(ws + OFF_WO), T_, DM, DM, DM, DM}; StaticOrder S; S.init(T_, DM, G, bid);
        Epi E{pg8::EPI_RESID_NORM, HN, DM, DM, nullptr, 1.f, nullptr, nullptr, nullptr, p.in[0], p.out, (float*)(ws + OFF_ROWSQ)};
        pg8::gemm_phase(lds, g, S, E);
    }
    xcd_barrier(xbar, xcc, xst);
    {
        Gemm g{HN, (const bf16_t*)(ws + OFF_WGU), T_, 2 * FF, DM, DM, DM}; StaticOrder S; S.init(T_, 2 * FF, G, bid);
        Epi E{pg8::EPI_SWIGLU, (bf16_t*)(ws + OFF_ACT), FF, 2 * FF, nullptr, 1.f, nullptr, nullptr, nullptr, nullptr, nullptr, (float*)(ws + OFF_ROWSQ)};
        for (int rep = 0; rep < REP_P8; ++rep) pg8::gemm_phase(lds, g, S, E);
    }
    xcd_barrier(xbar, xcc, xst);
    {
        Gemm g{(const bf16_t*)(ws + OFF_ACT), (const bf16_t*)(ws + OFF_WD), T_, DM, FF, FF, FF}; StaticOrder S; S.init(T_, DM, G, bid);
        Epi E{pg8::EPI_RESID, nullptr, DM, DM, nullptr, 1.f, nullptr, nullptr, nullptr, p.out, p.out, nullptr};
        pg8::gemm_phase(lds, g, S, E);
    }
    xcd_barrier(xbar, xcc, xst);
    {
        PHASE_IDS;
        const int gw = bid * 8 + wave, NGW = G * 8;
        for (int m = gw; m < T_; m += NGW) norm_row_f32_inplace(p.out + (size_t)m * DM, p.in[19], lane);
    }
}

extern "C" void kernel_launch(void* const* d_in, const int* in_sizes, int n_in, void* d_out, int out_size, void* d_ws, size_t ws_size, hipStream_t stream) {
    static int grid_blocks = 0;
    if (grid_blocks == 0) {
        if (n_in != 20 || ws_size < WS_END) { fprintf(stderr, "kernel_launch: unexpected n_in %d or ws_size %zu (< %zu)\n", n_in, ws_size, (size_t)WS_END); grid_blocks = -1; return; }
        int dev = 0, cus = 0, per_cu = 0;
        hipGetDevice(&dev);
        hipDeviceGetAttribute(&cus, hipDeviceAttributeMultiprocessorCount, dev);
        if (hipFuncSetAttribute((const void*)fwd_megakernel, hipFuncAttributeMaxDynamicSharedMemorySize, LDS_BYTES) != hipSuccess) fprintf(stderr, "kernel_launch: hipFuncSetAttribute failed\n");
        if (hipOccupancyMaxActiveBlocksPerMultiprocessor(&per_cu, (const void*)fwd_megakernel, NTHREADS, LDS_BYTES) != hipSuccess || per_cu < 1) { fprintf(stderr, "kernel_launch: occupancy query gave %d\n", per_cu); per_cu = 1; }
        (void)hipGetLastError();
        grid_blocks = cus * per_cu;
    }
    if (grid_blocks < 0) return;
    unsigned char* ws = (unsigned char*)d_ws;
    Params p{};
    for (int i = 0; i < 20; ++i) p.in[i] = (const float*)d_in[i];
    p.out = (float*)d_out; p.ws = ws;
    void* args[] = {&p};
    hipError_t e = hipLaunchCooperativeKernel((const void*)fwd_megakernel, dim3(grid_blocks), dim3(NTHREADS), args, LDS_BYTES, stream);
    if (e != hipSuccess) fprintf(stderr, "kernel_launch: cooperative launch failed: %s (grid %d)\n", hipGetErrorString(e), grid_blocks);
}
```

```cpp
#include <hip/hip_runtime.h>
#include <hip/hip_cooperative_groups.h>
#include <cstdio>
#include <cstdint>
namespace cg = cooperative_groups;

#define LAS __attribute__((address_space(3)))
#define DI __device__ __forceinline__
typedef unsigned short bf16_t;
typedef short bf16x8 __attribute__((ext_vector_type(8)));
typedef short bf16x4 __attribute__((ext_vector_type(4)));
typedef float f32x4 __attribute__((ext_vector_type(4)));
typedef float f32x16 __attribute__((ext_vector_type(16)));
typedef unsigned u32x4 __attribute__((ext_vector_type(4)));
typedef unsigned u32x2 __attribute__((ext_vector_type(2)));

constexpr int T_ = 32768, S_ = 8192, DM = 2048, NPROJ = 2816, FF = 5632;
constexpr float LOG2E = 1.4426950408889634f;
constexpr int NTHREADS = 512;
constexpr int LDS_BYTES = 158720;
constexpr int REP_P0 = 1, REP_P1 = 1, REP_MLA = 1, REP_NSA = 1, REP_P8 = 1;

constexpr size_t MiB = 1048576;
constexpr size_t OFF_HN = 0;
constexpr size_t OFF_PROJ = 128 * MiB;
constexpr size_t OFF_QMLA = 304 * MiB;
constexpr size_t OFF_KNOPE = 400 * MiB;
constexpr size_t OFF_VT = 464 * MiB;
constexpr size_t OFF_ACT = 128 * MiB;
constexpr size_t OFF_MIX = 528 * MiB;
constexpr size_t OFF_W = 656 * MiB;
constexpr size_t OFF_WIN = OFF_W;
constexpr size_t OFF_WUQ = OFF_WIN + 2816ull * 2048 * 2;
constexpr size_t OFF_WK = OFF_WUQ + 1536ull * 512 * 2;
constexpr size_t OFF_WV = OFF_WK + 1024ull * 256 * 2;
constexpr size_t OFF_WO = OFF_WV + 1024ull * 256 * 2;
constexpr size_t OFF_WGU = OFF_WO + 2048ull * 2048 * 2;
constexpr size_t OFF_WD = OFF_WGU + 11264ull * 2048 * 2;
constexpr size_t OFF_WC1K = OFF_WD + 2048ull * 5632 * 2;
constexpr size_t OFF_WC1V = OFF_WC1K + 256ull * 2048 * 2;
constexpr size_t OFF_WC2K = OFF_WC1V + 256ull * 2048 * 2;
constexpr size_t OFF_WC2V = OFF_WC2K + 256ull * 256 * 2;
constexpr size_t OFF_MISC = 752 * MiB;
constexpr size_t OFF_KROPE = OFF_MISC;
constexpr size_t OFF_KCG = OFF_KROPE + 4 * MiB;
constexpr size_t OFF_VCG = OFF_KCG + 8 * MiB + 65536;
constexpr size_t OFF_VST = OFF_VCG + 8 * MiB + 65536;
constexpr size_t OFF_VWT = OFF_VST + 8 * MiB;
constexpr size_t OFF_HIDK = OFF_VWT + 8 * MiB;
constexpr size_t OFF_HIDV = OFF_HIDK + 2 * MiB;
constexpr size_t OFF_KC = OFF_HIDV + 2 * MiB;
constexpr size_t OFF_VCT = OFF_KC + MiB / 2;
constexpr size_t OFF_RSQ = OFF_VCT + MiB / 2;
constexpr size_t OFF_RSKV = OFF_RSQ + 131072;
constexpr size_t OFF_COS = OFF_RSKV + 131072;
constexpr size_t OFF_SIN = OFF_COS + MiB;
constexpr size_t OFF_BIAS = OFF_SIN + MiB;
constexpr size_t OFF_CTL = OFF_BIAS + 4096;
constexpr size_t OFF_ROWSQ = OFF_CTL + 4096;
constexpr size_t OFF_XBAR = OFF_ROWSQ + 131072;
constexpr size_t WS_END = OFF_XBAR + 16384;

DI unsigned f2bf(float f) { unsigned u = __builtin_bit_cast(unsigned, f); return (u + 0x7fffu + ((u >> 16) & 1u)) >> 16; }
typedef __bf16 hwbf16x2 __attribute__((ext_vector_type(2)));
typedef float f32x2 __attribute__((ext_vector_type(2)));
DI unsigned pk2(float lo, float hi) { const f32x2 v = {lo, hi}; const hwbf16x2 b = __builtin_convertvector(v, hwbf16x2); return __builtin_bit_cast(unsigned, b); }
DI float bf2f(unsigned b) { return __builtin_bit_cast(float, b << 16); }
DI float bflo(unsigned w) { return __builtin_bit_cast(float, w << 16); }
DI float bfhi(unsigned w) { return __builtin_bit_cast(float, w & 0xffff0000u); }
DI float wave_sum(float v) {
#pragma unroll
    for (int o = 1; o < 64; o <<= 1) v += __shfl_xor(v, o);
    return v;
}
DI void swap32(unsigned& a, unsigned& b) { asm volatile("s_nop 1\n\tv_permlane32_swap_b32 %0, %1" : "+v"(a), "+v"(b)); }
DI float xhalf_max(float v) { unsigned a = __builtin_bit_cast(unsigned, v), b = a; swap32(a, b); return fmaxf(__builtin_bit_cast(float, a), __builtin_bit_cast(float, b)); }
DI float xhalf_sum(float v) { unsigned a = __builtin_bit_cast(unsigned, v), b = a; swap32(a, b); return __builtin_bit_cast(float, a) + __builtin_bit_cast(float, b); }
DI float xhalf_partner(float v, int hi) { unsigned a = __builtin_bit_cast(unsigned, v), b = a; swap32(a, b); return __builtin_bit_cast(float, hi ? a : b); }
DI float sum8(float v) {
    v += __builtin_bit_cast(float, __builtin_amdgcn_mov_dpp(__builtin_bit_cast(int, v), 0xB1, 0xF, 0xF, true));
    v += __builtin_bit_cast(float, __builtin_amdgcn_mov_dpp(__builtin_bit_cast(int, v), 0x4E, 0xF, 0xF, true));
    v += __builtin_bit_cast(float, __builtin_amdgcn_mov_dpp(__builtin_bit_cast(int, v), 0x141, 0xF, 0xF, true));
    return v;
}
DI float fexp2(float x) { return __builtin_amdgcn_exp2f(x); }
DI float frcp(float x) { return __builtin_amdgcn_rcpf(x); }
DI float frsq(float x) { return __builtin_amdgcn_rsqf(x); }
DI float fsilu(float v) { return v * frcp(1.f + __expf(-v)); }
DI float fsigmoid(float v) { return frcp(1.f + __expf(-v)); }
#define LDS_WAIT() asm volatile("s_waitcnt lgkmcnt(0)" ::: "memory")
#define MFMA32(a, b, c) __builtin_amdgcn_mfma_f32_32x32x16_bf16((a), (b), (c), 0, 0, 0)
DI int crow(int r, int hi) { return (r & 3) + 8 * (r >> 2) + 4 * hi; }
DI int fresh_tid() { int t = threadIdx.x; asm volatile("" : "+v"(t)); return t; }

struct Params { const float* in[20]; float* out; unsigned char* ws; };

namespace pg8 {
constexpr int BM = 256, BK = 64, HALF = 128, HTB = HALF * BK * 2, STAGE_BYTES = 8 * HTB, NXCD = 8, WGM = 4;
DI int lds_byte(int r, int c) { const int st = (r >> 4) * 2 + (c >> 5), rr = r & 15, cc = c & 31, ob = rr * 64 + cc * 2; return st * 1024 + (ob ^ (((ob >> 9) & 1) << 5)); }
DI void stage_rc(int b, int& R, int& C) { const int st = b / 1024, sb = b % 1024, swz = sb ^ (((sb >> 9) & 1) << 5); R = (st >> 1) * 16 + swz / 64; C = (st & 1) * 32 + (swz % 64) / 2; }
DI int perm32(int rho) { const int n = rho >> 4, i = rho & 15; return 8 * (i >> 2) + 4 * n + (i & 3); }
struct Unit { int pm, pn; };
struct Gemm { const bf16_t* A; const bf16_t* Bt; int M, N, K, lda, ldb; };
struct StaticOrder {
    int nM, nN, nwg, G, c;
    DI void init(int M, int N, int G_, int c_) { nM = M / BM; nN = N / BM; nwg = nM * nN; G = G_; c = c_; }
    DI bool next(int i, Unit& u) const {
        const long L = (long)i * G + c; if (L >= nwg) return false;
        int wgid = (int)L; { const int q = nwg / NXCD, r = nwg % NXCD, xcd = wgid % NXCD, off = wgid / NXCD; wgid = (xcd < r ? xcd * (q + 1) : r * (q + 1) + (xcd - r) * q) + off; }
        const int nig = WGM * nN, gid = wgid / nig, fm = gid * WGM, gsz = (nM - fm) < WGM ? (nM - fm) : WGM;
        u.pm = fm + ((wgid % nig) % gsz); u.pn = (wgid % nig) / gsz; return true;
    }
};

enum { EPI_STORE = 0, EPI_Q = 1, EPI_VT = 2, EPI_SILU = 3, EPI_VCT = 4, EPI_RESID = 5, EPI_SWIGLU = 6, EPI_RESID_NORM = 7 };
struct Epi {
    int mode; bf16_t* O; int ldc; int ncols; const float* rscale; float qscale; const float* cosT; const float* sinT; const float* bias; const float* resid; float* outf; float* rowsq;
    DI void operator()(const f32x4 (&acc)[2][2][4][2], const Unit& u, int wr, int wc, int fr, int fq) const {
        const int row0 = u.pm * BM + wr * 64 + fr, col0 = u.pn * BM + wc * 32 + 8 * fq;
#pragma unroll
        for (int ai = 0; ai < 2; ++ai)
#pragma unroll
            for (int m = 0; m < 4; ++m) {
                const int row = row0 + ai * HALF + m * 16;
                float rs = 1.f, rowacc = 0.f;
                if (mode == EPI_STORE || mode == EPI_Q) { if (rscale) rs = rscale[row]; }
                if (mode == EPI_SWIGLU) rs = frsq(rowsq[row] * (1.0f / DM) + 1e-6f);
#pragma unroll
                for (int bj = 0; bj < 2; ++bj) {
                    const int col = col0 + bj * HALF;
                    f32x4 v0 = acc[ai][bj][m][0], v1 = acc[ai][bj][m][1];
                    if (mode == EPI_STORE) {
                        if (col < ncols) { v0 = v0 * rs; v1 = v1 * rs; u32x4 w; w.x = pk2(v0[0], v0[1]); w.y = pk2(v0[2], v0[3]); w.z = pk2(v1[0], v1[1]); w.w = pk2(v1[2], v1[3]);
                            *(u32x4*)(O + (size_t)row * ldc + col) = w; }
                    } else if (mode == EPI_Q) {
                        const float sc = rs * qscale; v0 = v0 * sc; v1 = v1 * sc;
                        const int c192 = col % 192;
                        if (c192 >= 128) {
                            const int i0 = (c192 - 128) >> 1, pos = row & (S_ - 1);
                            const f32x4 cs = *(const f32x4*)(cosT + pos * 32 + i0), sn = *(const f32x4*)(sinT + pos * 32 + i0);
                            float a, b;
                            a = v0[0]; b = v0[1]; v0[0] = a * cs[0] - b * sn[0]; v0[1] = a * sn[0] + b * cs[0];
                            a = v0[2]; b = v0[3]; v0[2] = a * cs[1] - b * sn[1]; v0[3] = a * sn[1] + b * cs[1];
                            a = v1[0]; b = v1[1]; v1[0] = a * cs[2] - b * sn[2]; v1[1] = a * sn[2] + b * cs[2];
                            a = v1[2]; b = v1[3]; v1[2] = a * cs[3] - b * sn[3]; v1[3] = a * sn[3] + b * cs[3];
                        }
                        u32x4 w; w.x = pk2(v0[0], v0[1]); w.y = pk2(v0[2], v0[3]); w.z = pk2(v1[0], v1[1]); w.w = pk2(v1[2], v1[3]);
                        *(u32x4*)(O + (size_t)row * ldc + col) = w;
                    } else if (mode == EPI_VT) {
                        const f32x4 s0 = *(const f32x4*)(rscale + col), s1 = *(const f32x4*)(rscale + col + 4);
                        v0 = v0 * s0; v1 = v1 * s1;
                        u32x4 w; w.x = pk2(v0[0], v0[1]); w.y = pk2(v0[2], v0[3]); w.z = pk2(v1[0], v1[1]); w.w = pk2(v1[2], v1[3]);
                        *(u32x4*)(O + (size_t)row * ldc + col) = w;
                    } else if (mode == EPI_SILU) {
                        const f32x4 b0 = *(const f32x4*)(bias + col), b1 = *(const f32x4*)(bias + col + 4);
                        v0 = v0 + b0; v1 = v1 + b1;
                        u32x4 w; w.x = pk2(fsilu(v0[0]), fsilu(v0[1])); w.y = pk2(fsilu(v0[2]), fsilu(v0[3])); w.z = pk2(fsilu(v1[0]), fsilu(v1[1])); w.w = pk2(fsilu(v1[2]), fsilu(v1[3]));
                        *(u32x4*)(O + (size_t)row * ldc + col) = w;
                    } else if (mode == EPI_VCT) {
                        if (row < 64) { u32x4 w; w.x = pk2(v0[0], v0[1]); w.y = pk2(v0[2], v0[3]); w.z = pk2(v1[0], v1[1]); w.w = pk2(v1[2], v1[3]);
                            *(u32x4*)(O + ((size_t)((col >> 9) * 64 + row)) * 512 + (col & 511)) = w; }
                    } else if (mode == EPI_RESID) {
                        const size_t ix = (size_t)row * DM + col;
                        const f32x4 r0 = *(const f32x4*)(resid + ix), r1 = *(const f32x4*)(resid + ix + 4);
                        *(f32x4*)(outf + ix) = v0 + r0; *(f32x4*)(outf + ix + 4) = v1 + r1;
                    } else if (mode == EPI_RESID_NORM) {
                        const size_t ix = (size_t)row * DM + col;
                        const f32x4 r0 = *(const f32x4*)(resid + ix), r1 = *(const f32x4*)(resid + ix + 4);
                        v0 = v0 + r0; v1 = v1 + r1;
                        *(f32x4*)(outf + ix) = v0; *(f32x4*)(outf + ix + 4) = v1;
                        u32x4 w; w.x = pk2(v0[0], v0[1]); w.y = pk2(v0[2], v0[3]); w.z = pk2(v1[0], v1[1]); w.w = pk2(v1[2], v1[3]);
                        *(u32x4*)(O + ix) = w;
                        rowacc += (v0[0] * v0[0] + v0[1] * v0[1]) + (v0[2] * v0[2] + v0[3] * v0[3]) + (v1[0] * v1[0] + v1[1] * v1[1]) + (v1[2] * v1[2] + v1[3] * v1[3]);
                    } else {
                        v0 = v0 * rs; v1 = v1 * rs;
                        u32x2 w; w.x = pk2(fsilu(v0[0]) * v1[0], fsilu(v0[1]) * v1[1]); w.y = pk2(fsilu(v0[2]) * v1[2], fsilu(v0[3]) * v1[3]);
                        *(u32x2*)(O + (size_t)row * ldc + (col >> 1)) = w;
                    }
                }
                if (mode == EPI_RESID_NORM) {
                    rowacc += __shfl_xor(rowacc, 16); rowacc += __shfl_xor(rowacc, 32);
                    if (fq == 0) atomicAdd(rowsq + row, rowacc);
                }
            }
    }
};

DI void gemm_phase(LAS unsigned char* lds, const Gemm g, const StaticOrder& S, const Epi& E) {
    const int tid = fresh_tid(), wid = __builtin_amdgcn_readfirstlane(tid >> 6), lane = tid & 63, wr = wid >> 2, wc = wid & 3, fr = lane & 15, fq = lane >> 4;
    const int K = g.K, nt = K / BK;
    unsigned voffA[2], voffB[2];
#pragma unroll
    for (int i = 0; i < 2; ++i) { int R, C; stage_rc(tid * 16 + i * 8192, R, C); const int Rb = (R & ~31) + perm32(R & 31);
        voffA[i] = (unsigned)(R * g.lda + C) * 2u; voffB[i] = (unsigned)(Rb * g.ldb + C) * 2u; }
    const size_t kstep = (size_t)(BK * 2);
    const size_t hsA = (size_t)HALF * g.lda * 2, hsB = (size_t)HALF * g.ldb * 2;
    const size_t tsA = 2 * hsA, tsB = 2 * hsB;
    const unsigned ldsw = (unsigned)wid * 1024u;
    const int aoff = lds_byte(wr * 64 + fr, fq * 8), boff = lds_byte(wc * 32 + fr, fq * 8);
#define PG8_SA(b, h) (((b) * 2 + (h)) * HTB)
#define PG8_SB(b, h) ((4 + (b) * 2 + (h)) * HTB)
#define PG8_STAGE(bufoff, gbase, voff) do { _Pragma("unroll") for (int _i = 0; _i < 2; ++_i) \
        __builtin_amdgcn_global_load_lds((const unsigned*)((const char*)(gbase) + (voff)[_i]), (LAS unsigned*)(lds + (bufoff) + ldsw + _i * 8192), 16, 0, 0); } while (0)
#define PG8_LDA(dst, b, h) do { _Pragma("unroll") for (int m = 0; m < 4; ++m) _Pragma("unroll") for (int k = 0; k < 2; ++k) dst[m][k] = *(const LAS bf16x8*)(lds + PG8_SA(b, h) + aoff + m * 2048 + k * 1024); } while (0)
#define PG8_LDB(dst, b, h) do { _Pragma("unroll") for (int n = 0; n < 2; ++n) _Pragma("unroll") for (int k = 0; k < 2; ++k) dst[n][k] = *(const LAS bf16x8*)(lds + PG8_SB(b, h) + boff + n * 2048 + k * 1024); } while (0)
#define PG8_MMA(ai, bj, At, Bt) do { __builtin_amdgcn_s_setprio(1); _Pragma("unroll") for (int m = 0; m < 4; ++m) _Pragma("unroll") for (int n = 0; n < 2; ++n) _Pragma("unroll") for (int k = 0; k < 2; ++k) \
        acc[ai][bj][m][n] = __builtin_amdgcn_mfma_f32_16x16x32_bf16(Bt[n][k], At[m][k], acc[ai][bj][m][n], 0, 0, 0); __builtin_amdgcn_s_setprio(0); } while (0)
#define PG8_WAIT_V(n) asm volatile("s_waitcnt vmcnt(" #n ")" ::: "memory")
#define PG8_WAIT_L(n) asm volatile("s_waitcnt lgkmcnt(" #n ")" ::: "memory")
#define PG8_BAR __builtin_amdgcn_s_barrier()
#define PG8_SCHED __builtin_amdgcn_sched_barrier(0)
    Unit cur, nxt; int ui = 0;
    if (!S.next(0, cur)) return;
    f32x4 acc[2][2][4][2];
#pragma unroll
    for (int a = 0; a < 2; ++a)
#pragma unroll
        for (int b = 0; b < 2; ++b)
#pragma unroll
            for (int m = 0; m < 4; ++m)
#pragma unroll
                for (int n = 0; n < 2; ++n) acc[a][b][m][n] = (f32x4){0.f, 0.f, 0.f, 0.f};
    bf16x8 At[4][2], B0[2][2], B1[2][2];
    const char* cA = (const char*)g.A + (size_t)cur.pm * tsA; const char* cB = (const char*)g.Bt + (size_t)cur.pn * tsB;
    PG8_STAGE(PG8_SB(0, 0), cB, voffB); PG8_STAGE(PG8_SB(0, 1), cB + hsB, voffB); PG8_STAGE(PG8_SA(0, 0), cA, voffA); PG8_STAGE(PG8_SA(0, 1), cA + hsA, voffA);
    if (wr == 1) PG8_BAR;
    PG8_WAIT_V(2); PG8_BAR;
    PG8_STAGE(PG8_SB(1, 0), cB + kstep, voffB); PG8_STAGE(PG8_SA(1, 0), cA + kstep, voffA); PG8_STAGE(PG8_SB(1, 1), cB + hsB + kstep, voffB);
    PG8_WAIT_V(6); PG8_BAR;
    for (;;) {
        const bool has_next = S.next(ui + 1, nxt);
        const char* nA = has_next ? (const char*)g.A + (size_t)nxt.pm * tsA : cA; const char* nB = has_next ? (const char*)g.Bt + (size_t)nxt.pn * tsB : cB;
        for (int t = 0; t < nt; t += 2) {
            const bool last = (t == nt - 2);
            const char* a1 = cA + (size_t)(t + 1) * kstep;
            const char* a2 = last ? nA : cA + (size_t)(t + 2) * kstep; const char* b2 = last ? nB : cB + (size_t)(t + 2) * kstep;
            const char* a3 = a2 + kstep; const char* b3 = b2 + kstep;
            PG8_LDB(B0, 0, 0); PG8_LDB(B1, 0, 1); PG8_SCHED; PG8_LDA(At, 0, 0); PG8_STAGE(PG8_SA(1, 1), a1 + hsA, voffA);
            PG8_WAIT_V(8); PG8_WAIT_L(0); PG8_BAR; PG8_MMA(0, 0, At, B0); PG8_MMA(0, 1, At, B1); PG8_BAR; PG8_SCHED;
            PG8_LDA(At, 0, 1); PG8_STAGE(PG8_SB(0, 0), b2, voffB); PG8_STAGE(PG8_SB(0, 1), b2 + hsB, voffB); PG8_STAGE(PG8_SA(0, 0), a2, voffA);
            PG8_WAIT_V(8); PG8_WAIT_L(0); PG8_BAR; PG8_MMA(1, 0, At, B0); PG8_MMA(1, 1, At, B1); PG8_BAR; PG8_SCHED;
            PG8_LDB(B0, 1, 0); PG8_LDB(B1, 1, 1); PG8_SCHED; PG8_LDA(At, 1, 0); PG8_STAGE(PG8_SA(0, 1), a2 + hsA, voffA);
            PG8_WAIT_V(8); PG8_WAIT_L(0); PG8_BAR; PG8_MMA(0, 0, At, B0); PG8_MMA(0, 1, At, B1); PG8_BAR; PG8_SCHED;
            PG8_LDA(At, 1, 1); PG8_STAGE(PG8_SB(1, 0), b3, voffB); PG8_STAGE(PG8_SB(1, 1), b3 + hsB, voffB); PG8_STAGE(PG8_SA(1, 0), a3, voffA);
            PG8_WAIT_V(8); PG8_WAIT_L(0); PG8_BAR; PG8_MMA(1, 0, At, B0); PG8_MMA(1, 1, At, B1); PG8_BAR; PG8_SCHED;
        }
        if (wr == 0) PG8_BAR;
        E(acc, cur, wr, wc, fr, fq);
        if (!has_next) break;
#pragma unroll
        for (int a = 0; a < 2; ++a)
#pragma unroll
            for (int b = 0; b < 2; ++b)
#pragma unroll
                for (int m = 0; m < 4; ++m)
#pragma unroll
                    for (int n = 0; n < 2; ++n) acc[a][b][m][n] = (f32x4){0.f, 0.f, 0.f, 0.f};
        cur = nxt; cA = nA; cB = nB; ++ui;
        if (wr == 1) PG8_BAR;
    }
    PG8_WAIT_V(0);
    PG8_BAR;
#undef PG8_SA
#undef PG8_SB
#undef PG8_STAGE
#undef PG8_LDA
#undef PG8_LDB
#undef PG8_MMA
#undef PG8_WAIT_V
#undef PG8_WAIT_L
#undef PG8_BAR
#undef PG8_SCHED
}
}

DI int map_row(int map, int n) {
    if (map == 1) { const int hd = n / 192, c = n - hd * 192; if (c >= 160) return hd * 192 + 128 + 2 * (c - 160) + 1; if (c >= 128) return hd * 192 + 128 + 2 * (c - 128); return n; }
    if (map == 2) return (n >> 2) * 8 + (n & 3);
    if (map == 3) return (n >> 2) * 8 + 4 + (n & 3);
    return n;
}
DI void transpose_item(const float* dW, const float* dks, bf16_t* dWT, int dK, int dN, int dNpad, int dldt, int dmap, LAS float* scr, int item, int lane) {
    const int nblk = dNpad / 32, kb = item / nblk, nb = item - kb * nblk, k0 = 64 * kb, n0 = 32 * nb;
    f32x4 ld[8];
#pragma unroll
    for (int i = 0; i < 8; ++i) {
        const int kk = 8 * i + (lane >> 3), k = k0 + kk, n = n0 + 4 * (lane & 7);
        ld[i] = (f32x4){0.f, 0.f, 0.f, 0.f};
        if (k < dK && n < dN) { ld[i] = *(const f32x4*)(dW + (size_t)k * dN + n); if (dks) ld[i] = ld[i] * dks[k]; }
    }
#pragma unroll
    for (int i = 0; i < 8; ++i) {
        const int kk = 8 * i + (lane >> 3); LAS float* d = scr + kk * 33 + 4 * (lane & 7);
        d[0] = ld[i].x; d[1] = ld[i].y; d[2] = ld[i].z; d[3] = ld[i].w;
    }
    LDS_WAIT();
    const int c = lane & 7;
#pragma unroll
    for (int j = 0; j < 4; ++j) {
        const int n = (lane >> 3) + 8 * j; const LAS float* s = scr + (8 * c) * 33 + n;
        u32x4 o; o.x = pk2(s[0 * 33], s[1 * 33]); o.y = pk2(s[2 * 33], s[3 * 33]); o.z = pk2(s[4 * 33], s[5 * 33]); o.w = pk2(s[6 * 33], s[7 * 33]);
        *(u32x4*)(dWT + (size_t)map_row(dmap, n0 + n) * dldt + k0 + 8 * c) = o;
    }
    LDS_WAIT();
}
DI void norm_row_bf16(const float* xrow, const float* g, bf16_t* orow, int lane) {
    const f32x4* xr = (const f32x4*)xrow + lane; f32x4 v[8]; float s = 0.f;
#pragma unroll
    for (int j = 0; j < 8; ++j) { v[j] = xr[64 * j]; s += (v[j].x * v[j].x + v[j].y * v[j].y) + (v[j].z * v[j].z + v[j].w * v[j].w); }
    s = wave_sum(s);
    const float rs = frsq(s * (1.0f / DM) + 1e-6f);
    const f32x4* gr = (const f32x4*)g + lane;
    u32x2* o8 = (u32x2*)orow + lane;
#pragma unroll
    for (int j = 0; j < 8; ++j) { const f32x4 gg = gr[64 * j]; u32x2 o; o.x = pk2(v[j].x * rs * gg.x, v[j].y * rs * gg.y); o.y = pk2(v[j].z * rs * gg.z, v[j].w * rs * gg.w); o8[64 * j] = o; }
}
DI void norm_row_f32_inplace(float* xrow, const float* g, int lane) {
    f32x4* xr = (f32x4*)xrow + lane; f32x4 v[8]; float s = 0.f;
#pragma unroll
    for (int j = 0; j < 8; ++j) { v[j] = xr[64 * j]; s += (v[j].x * v[j].x + v[j].y * v[j].y) + (v[j].z * v[j].z + v[j].w * v[j].w); }
    s = wave_sum(s);
    const float rs = frsq(s * (1.0f / DM) + 1e-6f);
    const f32x4* gr = (const f32x4*)g + lane;
#pragma unroll
    for (int j = 0; j < 8; ++j) { const f32x4 gg = gr[64 * j]; xr[64 * j] = v[j] * rs * gg; }
}
DI void sincos_acc(float angf, float& sn, float& cs) {
    const double x = (double)angf;
    const double n = rint(x * 0.15915494309189535);
    double r = fma(-n, 6.283185307179586, x); r = fma(-n, 2.4492935982947064e-16, r);
    const double r2 = r * r;
    double ts = r, ss = r, tc = 1.0, cc = 1.0;
    for (int k = 1; k <= 13; ++k) {
        ts *= -r2 / (double)((2 * k) * (2 * k + 1)); ss += ts;
        tc *= -r2 / (double)((2 * k - 1) * (2 * k)); cc += tc;
    }
    sn = (float)ss; cs = (float)cc;
}

DI void prologue(const Params& p, LAS unsigned char* lds, int tid, int lane, int wave) {
    unsigned char* ws = p.ws;
    const int gw = blockIdx.x * 8 + wave, NGW = gridDim.x * 8;
    LAS float* scr = (LAS float*)(lds + wave * 16384);
    constexpr int I0 = 32 * 88, I1 = I0 + 8 * 48, I2 = I1 + 4 * 32, I3 = I2 + 4 * 32, I4 = I3 + 32 * 64, I5 = I4 + 32 * 176, I6 = I5 + 32 * 176, I7 = I6 + 88 * 64,
                  I8 = I7 + 32 * 8, I9 = I8 + 32 * 8, I10 = I9 + 4 * 8, I11 = I10 + 4 * 8;
    typedef const float* cfp;
    LAS cfp* PTg = (LAS cfp*)(lds + 158208);
    if (tid == 0) { PTg[2] = p.in[2]; PTg[3] = p.in[3]; PTg[4] = p.in[4]; PTg[5] = p.in[5]; PTg[6] = p.in[6]; PTg[7] = p.in[7]; PTg[10] = p.in[10]; PTg[11] = p.in[11];
                    PTg[12] = p.in[12]; PTg[13] = p.in[13]; PTg[14] = p.in[14]; PTg[15] = p.in[15]; PTg[16] = p.in[16]; PTg[17] = p.in[17]; PTg[18] = p.in[18]; PTg[0] = nullptr; }
    __syncthreads();
    for (int it = gw; it < I11; it += NGW) {
        int ii, ksi, dK, dN, dNpad, dldt, dmap, i0; size_t off;
        if (it < I0)       { ii = 2;  ksi = 0;  off = OFF_WIN;  dK = 2048; dN = 2672; dNpad = 2816; dldt = 2048; dmap = 0; i0 = 0; }
        else if (it < I1)  { ii = 5;  ksi = 3;  off = OFF_WUQ;  dK = 512;  dN = 1536; dNpad = 1536; dldt = 512;  dmap = 1; i0 = I0; }
        else if (it < I2)  { ii = 6;  ksi = 4;  off = OFF_WK;   dK = 256;  dN = 1024; dNpad = 1024; dldt = 256;  dmap = 0; i0 = I1; }
        else if (it < I3)  { ii = 7;  ksi = 4;  off = OFF_WV;   dK = 256;  dN = 1024; dNpad = 1024; dldt = 256;  dmap = 0; i0 = I2; }
        else if (it < I4)  { ii = 14; ksi = 0;  off = OFF_WO;   dK = 2048; dN = 2048; dNpad = 2048; dldt = 2048; dmap = 0; i0 = I3; }
        else if (it < I5)  { ii = 16; ksi = 15; off = OFF_WGU;  dK = 2048; dN = 5632; dNpad = 5632; dldt = 2048; dmap = 2; i0 = I4; }
        else if (it < I6)  { ii = 17; ksi = 15; off = OFF_WGU;  dK = 2048; dN = 5632; dNpad = 5632; dldt = 2048; dmap = 3; i0 = I5; }
        else if (it < I7)  { ii = 18; ksi = 0;  off = OFF_WD;   dK = 5632; dN = 2048; dNpad = 2048; dldt = 5632; dmap = 0; i0 = I6; }
        else if (it < I8)  { ii = 10; ksi = 0;  off = OFF_WC1K; dK = 2048; dN = 128;  dNpad = 256;  dldt = 2048; dmap = 0; i0 = I7; }
        else if (it < I9)  { ii = 12; ksi = 0;  off = OFF_WC1V; dK = 2048; dN = 128;  dNpad = 256;  dldt = 2048; dmap = 0; i0 = I8; }
        else if (it < I10) { ii = 11; ksi = 0;  off = OFF_WC2K; dK = 128;  dN = 64;   dNpad = 256;  dldt = 256;  dmap = 0; i0 = I9; }
        else               { ii = 13; ksi = 0;  off = OFF_WC2V; dK = 128;  dN = 64;   dNpad = 256;  dldt = 256;  dmap = 0; i0 = I10; }
        transpose_item(PTg[ii], PTg[ksi], (bf16_t*)(ws + off), dK, dN, dNpad, dldt, dmap, scr, it - i0, lane);
    }
    bf16_t* HN = (bf16_t*)(ws + OFF_HN);
    for (int m = gw; m < T_; m += NGW) norm_row_bf16(p.in[0] + (size_t)m * DM, p.in[1], HN + (size_t)m * DM, lane);
    float* COS = (float*)(ws + OFF_COS); float* SIN = (float*)(ws + OFF_SIN);
    for (int idx = blockIdx.x * NTHREADS + tid; idx < S_ * 32; idx += gridDim.x * NTHREADS) {
        const int pos = idx >> 5, i = idx & 31;
        const float inv = exp2f(-(float)i * (13.287712379549449f / 32.0f));
        const float ang = (float)pos * inv;
        float sn, cs; sincos_acc(ang, sn, cs);
        COS[idx] = cs; SIN[idx] = sn;
    }
    float* BIAS = (float*)(ws + OFF_BIAS);
    if (gw < 256) {
        const int which = gw >> 7, j = gw & 127;
        const float* W = which ? p.in[12] : p.in[10]; const float* pe = which ? p.in[9] : p.in[8];
        float s = 0.f;
        for (int k = lane; k < 2048; k += 64) s += pe[k] * W[(size_t)k * 128 + j];
        s = wave_sum(s);
        if (lane == 0) { BIAS[which * 256 + j] = s; BIAS[which * 256 + 128 + j] = 0.f; }
    }
    { unsigned* ctl = (unsigned*)(ws + OFF_CTL); float* rowsq = (float*)(ws + OFF_ROWSQ);
      for (int i = blockIdx.x * NTHREADS + tid; i < T_; i += gridDim.x * NTHREADS) { rowsq[i] = 0.f; if (i < 1024) ctl[i] = 0u; } }
    if (blockIdx.x == 1 % gridDim.x) { unsigned* xb = (unsigned*)(ws + OFF_XBAR); for (int i = tid; i < 4096; i += NTHREADS) xb[i] = 0u; }
    if (blockIdx.x == 0) {
        bf16_t* KCg = (bf16_t*)(ws + OFF_KCG) + (size_t)8 * S_ * 64; bf16_t* VCg = (bf16_t*)(ws + OFF_VCG) + (size_t)8 * S_ * 64;
        for (int i = tid; i < 4096; i += NTHREADS) { KCg[i] = 0; VCg[i] = 0; }
    }
}

DI void postproj_tile(const Params& p, LAS unsigned char* lds, int tile, int tid, int lane, int wave) {
    unsigned char* ws = p.ws;
    const bf16_t* PROJ = (const bf16_t*)(ws + OFF_PROJ);
    const int tok0 = tile * 64, b = tok0 >> 13, s0 = tok0 & (S_ - 1);
    LAS bf16_t* tl = (LAS bf16_t*)lds;
#pragma unroll
    for (int i = 0; i < 4; ++i) {
        const int q = tid + 512 * i, mat = q >> 10, r = (q >> 4) & 63, ch = q & 15;
        const u32x4 v = *(const u32x4*)(PROJ + (size_t)(tok0 + r) * NPROJ + (mat ? 2496 : 2240) + 8 * ch);
        *(LAS u32x4*)(tl + (mat * 64 + r) * 136 + 8 * ch) = v;
    }
    __syncthreads();
    bf16_t* VST = (bf16_t*)(ws + OFF_VST); bf16_t* VWT = (bf16_t*)(ws + OFF_VWT);
#pragma unroll
    for (int i = 0; i < 4; ++i) {
        const int q = tid + 512 * i, mat = q >> 10, c = (q >> 3) & 127, j8 = q & 7;
        unsigned e[8];
#pragma unroll
        for (int k = 0; k < 8; ++k) e[k] = tl[(mat * 64 + 8 * j8 + k) * 136 + c];
        u32x4 o; o.x = e[0] | (e[1] << 16); o.y = e[2] | (e[3] << 16); o.z = e[4] | (e[5] << 16); o.w = e[6] | (e[7] << 16);
        const int g = c >> 6, d = c & 63;
        bf16_t* dst = (mat ? VWT : VST) + ((size_t)((b * 2 + g) * 64 + d)) * S_ + s0 + 8 * j8;
        *(u32x4*)dst = o;
    }
    float* RSQ = (float*)(ws + OFF_RSQ); float* RSKV = (float*)(ws + OFF_RSKV);
    const float* COS = (const float*)(ws + OFF_COS); const float* SIN = (const float*)(ws + OFF_SIN);
    bf16_t* KROPE = (bf16_t*)(ws + OFF_KROPE); bf16_t* KCg = (bf16_t*)(ws + OFF_KCG); bf16_t* VCg = (bf16_t*)(ws + OFF_VCG);
    for (int rr = 0; rr < 8; ++rr) {
        const int r = wave * 8 + rr, tok = tok0 + r, s = s0 + r;
        const bf16_t* pr = PROJ + (size_t)tok * NPROJ;
        const u32x4 a = *(const u32x4*)(pr + 8 * lane);
        float sq = 0.f;
        { float f; f = bflo(a.x); sq += f * f; f = bfhi(a.x); sq += f * f; f = bflo(a.y); sq += f * f; f = bfhi(a.y); sq += f * f;
          f = bflo(a.z); sq += f * f; f = bfhi(a.z); sq += f * f; f = bflo(a.w); sq += f * f; f = bfhi(a.w); sq += f * f; }
        sq = wave_sum(sq);
        const u32x2 c2 = *(const u32x2*)(pr + 512 + 4 * lane);
        float sk = 0.f;
        { float f; f = bflo(c2.x); sk += f * f; f = bfhi(c2.x); sk += f * f; f = bflo(c2.y); sk += f * f; f = bfhi(c2.y); sk += f * f; }
        sk = wave_sum(sk);
        if (lane == 0) { RSQ[tok] = frsq(sq * (1.0f / 512.0f) + 1e-6f); RSKV[tok] = frsq(sk * (1.0f / 256.0f) + 1e-6f); }
        if (lane < 32) {
            const float x1 = bf2f(pr[768 + lane]), x2 = bf2f(pr[800 + lane]);
            const float cs = COS[s * 32 + lane], sn = SIN[s * 32 + lane];
            *(unsigned*)(KROPE + (size_t)tok * 64 + 2 * lane) = pk2(x1 * cs - x2 * sn, x1 * sn + x2 * cs);
        }
        const int g = lane >> 5, d = (2 * lane) & 63;
        const unsigned kc2 = *(const unsigned*)(pr + 1856 + 2 * lane);
        *(unsigned*)(KCg + ((size_t)((b * 2 + g) * S_ + s)) * 64 + d) = kc2;
        const unsigned vc2 = *(const unsigned*)(pr + 1984 + 2 * lane);
        *(unsigned*)(VCg + ((size_t)((b * 2 + g) * S_ + s)) * 64 + d) = vc2;
    }
    __syncthreads();
}

constexpr int MLA_BUF = 43008;
DI void mla_load(const bf16_t* KNOPE, const bf16_t* KROPE, const bf16_t* VT, int h, size_t tokb, int kt, u32x4 (&r)[5], int tid) {
#pragma unroll
    for (int i = 0; i < 2; ++i) { const int q = tid + 512 * i, key = q >> 4, ch = q & 15;
        r[i] = *(const u32x4*)(KNOPE + (tokb + kt * 64 + key) * 1024 + h * 128 + 8 * ch); }
    { const int key = tid >> 3, ch = tid & 7; r[2] = *(const u32x4*)(KROPE + (tokb + kt * 64 + key) * 64 + 8 * ch); }
#pragma unroll
    for (int i = 0; i < 2; ++i) { const int q = tid + 512 * i, d = q >> 3, ch = q & 7;
        r[3 + i] = *(const u32x4*)(VT + (size_t)(h * 128 + d) * T_ + tokb + kt * 64 + 8 * ch); }
}
DI void mla_store(LAS unsigned char* buf, const u32x4 (&r)[5], int tid) {
#pragma unroll
    for (int i = 0; i < 2; ++i) { const int q = tid + 512 * i, key = q >> 4, ch = q & 15; *(LAS u32x4*)(buf + key * 400 + ch * 16) = r[i]; }
    { const int key = tid >> 3, ch = tid & 7; *(LAS u32x4*)(buf + key * 400 + 256 + ch * 16) = r[2]; }
#pragma unroll
    for (int i = 0; i < 2; ++i) { const int q = tid + 512 * i, d = q >> 3, ch = q & 7; LAS unsigned char* vp = buf + 25600 + d * 136 + ch * 16;
        *(LAS u32x2*)vp = (u32x2){r[3 + i].x, r[3 + i].y}; *(LAS u32x2*)(vp + 8) = (u32x2){r[3 + i].z, r[3 + i].w}; }
}
DI bf16x8 cat4(bf16x4 lo, bf16x4 hi) { bf16x8 r; r[0] = lo[0]; r[1] = lo[1]; r[2] = lo[2]; r[3] = lo[3]; r[4] = hi[0]; r[5] = hi[1]; r[6] = hi[2]; r[7] = hi[3]; return r; }
DI bf16x8 packp(const f32x16& s, int t) {
    u32x4 w;
    if (t == 0) { w.x = pk2(s[0], s[1]); w.y = pk2(s[2], s[3]); w.z = pk2(s[4], s[5]); w.w = pk2(s[6], s[7]); }
    else { w.x = pk2(s[8], s[9]); w.y = pk2(s[10], s[11]); w.z = pk2(s[12], s[13]); w.w = pk2(s[14], s[15]); }
    return __builtin_bit_cast(bf16x8, w);
}

DI float vmax3(float a, float b, float c) { float r; asm("v_max3_f32 %0, %1, %2, %3" : "=v"(r) : "v"(a), "v"(b), "v"(c)); return r; }
DI float max16(const f32x16& s) {
    float a = vmax3(s[0], s[1], s[2]), b = vmax3(s[3], s[4], s[5]), c = vmax3(s[6], s[7], s[8]), d = vmax3(s[9], s[10], s[11]);
    a = vmax3(a, s[12], s[13]); b = vmax3(b, s[14], s[15]);
    return vmax3(vmax3(a, b, c), d, d);
}
DI void mla_unit(const Params& p, LAS unsigned char* lds, int b, int h, int qb, int tid) {
    unsigned char* ws = p.ws;
    const bf16_t* QMLA = (const bf16_t*)(ws + OFF_QMLA); const bf16_t* KNOPE = (const bf16_t*)(ws + OFF_KNOPE);
    const bf16_t* KROPE = (const bf16_t*)(ws + OFF_KROPE); const bf16_t* VT = (const bf16_t*)(ws + OFF_VT);
    bf16_t* MIX = (bf16_t*)(ws + OFF_MIX);
    const int lane = tid & 63, w = __builtin_amdgcn_readfirstlane(tid >> 6), c = lane & 31, hi = lane >> 5;
    const int q0 = qb * 256, qw0 = q0 + 32 * w, qpos = qw0 + c;
    const size_t tokb = (size_t)b * S_;
    bf16x8 qf[12];
    { const bf16_t* qp = QMLA + (tokb + qpos) * 1536 + h * 192 + 8 * hi;
#pragma unroll
      for (int st = 0; st < 12; ++st) qf[st] = *(const bf16x8*)(qp + 16 * st); }
    f32x16 o[4];
#pragma unroll
    for (int db = 0; db < 4; ++db)
#pragma unroll
        for (int i = 0; i < 16; ++i) o[db][i] = 0.f;
    float m = -1e20f, l = 0.f;
    const int nkt = 4 * qb + 4;
    u32x4 r[5];
    __syncthreads();
    mla_load(KNOPE, KROPE, VT, h, tokb, 0, r, tid); mla_store(lds, r, tid);
    __syncthreads();
    for (int kt = 0; kt < nkt; ++kt) {
        const bool more = kt + 1 < nkt;
        if (more) mla_load(KNOPE, KROPE, VT, h, tokb, kt + 1, r, tid);
        LAS const unsigned char* buf = lds + (kt & 1) * MLA_BUF;
        if (kt * 64 <= qw0 + 31) {
#pragma unroll
            for (int sub = 0; sub < 2; ++sub) {
                const int kbase = kt * 64 + 32 * sub;
                f32x16 s;
#pragma unroll
                for (int i = 0; i < 16; ++i) s[i] = 0.f;
#pragma unroll
                for (int st = 0; st < 12; ++st) {
                    const bf16x8 a = *(LAS const bf16x8*)(buf + (32 * sub + c) * 400 + st * 32 + hi * 16);
                    s = MFMA32(a, qf[st], s);
                }
                if (kbase + 31 > qw0) {
                    int dbase = qpos - kbase - 4 * hi;
                    asm volatile("" : "+v"(dbase));
#pragma unroll
                    for (int i = 0; i < 16; ++i) if ((dbase - ((i & 3) + 8 * (i >> 2))) < 0) s[i] = -1e30f;
                }
                float mx = max16(s);
                mx = xhalf_max(mx);
                const float mn = (mx > m + 8.f) ? mx : m, alpha = fexp2(m - mn); m = mn; l *= alpha;
                if (__any(alpha != 1.f)) {
#pragma unroll
                    for (int db = 0; db < 4; ++db) o[db] = o[db] * alpha;
                }
                float ps = 0.f;
#pragma unroll
                for (int i = 0; i < 16; ++i) { const float pv = fexp2(s[i] - m); s[i] = pv; ps += pv; }
                l += ps;
                const bf16x8 pb0 = packp(s, 0), pb1 = packp(s, 1);
#pragma unroll
                for (int db = 0; db < 4; ++db) {
                    LAS const unsigned char* ap = buf + 25600 + (32 * db + c) * 136 + (32 * sub + 4 * hi) * 2;
                    const bf16x8 v0 = cat4(*(LAS const bf16x4*)(ap), *(LAS const bf16x4*)(ap + 16));
                    const bf16x8 v1 = cat4(*(LAS const bf16x4*)(ap + 32), *(LAS const bf16x4*)(ap + 48));
                    o[db] = MFMA32(v0, pb0, o[db]); o[db] = MFMA32(v1, pb1, o[db]);
                }
            }
        }
        if (more) mla_store(lds + ((kt + 1) & 1) * MLA_BUF, r, tid);
        __syncthreads();
    }
    const float lt = xhalf_sum(l), inv = frcp(lt);
    bf16_t* op = MIX + (tokb + qpos) * 2048 + h * 128 + 4 * hi;
#pragma unroll
    for (int db = 0; db < 4; ++db)
#pragma unroll
        for (int g4 = 0; g4 < 4; ++g4) {
            u32x2 wv; wv.x = pk2(o[db][4 * g4] * inv, o[db][4 * g4 + 1] * inv); wv.y = pk2(o[db][4 * g4 + 2] * inv, o[db][4 * g4 + 3] * inv);
            *(u32x2*)(op + 32 * db + 8 * g4) = wv;
        }
}

constexpr int NSA_KC = 0, NSA_VCT = 73728, NSA_IMP = 140288, NSA_SEL = 156672, NSA_UNI = 157184, NSA_NL = 157200, NSA_LIST = 157216;
constexpr int NSA_TBUF = 17920;

template <int MODE>
DI void nsa_tile(LAS const unsigned char* buf, const bf16x8 (&qf)[4], f32x16 (&o)[2], float& m, float& l, int kbase0, int t, bool lanesel, float slope2, int c, int hi) {
#pragma unroll
    for (int sub = 0; sub < 2; ++sub) {
        const int klo = kbase0 + 32 * sub;
        bool full, none;
        if (MODE == 0) { full = lanesel && (klo + 31 <= t); none = !lanesel || (klo > t); }
        else { full = (klo + 31 <= t) && (klo >= t - 511); none = (klo > t) || (klo + 31 < t - 511); }
        if (__all(none)) continue;
        int dbase = t - klo - 4 * hi;
        asm volatile("" : "+v"(dbase));
        const float b0 = none ? -1e30f : -slope2 * (float)dbase;
        f32x16 s;
#pragma unroll
        for (int i = 0; i < 16; ++i) s[i] = fmaf(slope2, (float)((i & 3) + 8 * (i >> 2)), b0);
#pragma unroll
        for (int st = 0; st < 4; ++st) {
            const bf16x8 a = *(LAS const bf16x8*)(buf + (32 * sub + c) * 144 + st * 32 + hi * 16);
            s = MFMA32(a, qf[st], s);
        }
        if (__any(!full && !none)) {
#pragma unroll
            for (int i = 0; i < 16; ++i) {
                const int dist = dbase - ((i & 3) + 8 * (i >> 2));
                const bool valid = (MODE == 0) ? (lanesel && dist >= 0) : ((unsigned)dist < 512u);
                if (!valid) s[i] = -1e30f;
            }
        }
        float mx = max16(s);
        mx = xhalf_max(mx);
        if (__any(mx > m + 8.f)) {
            const float mn = fmaxf(m, mx), alpha = fexp2(m - mn); m = mn; l *= alpha;
            o[0] = o[0] * alpha; o[1] = o[1] * alpha;
        }
        float ps = 0.f;
#pragma unroll
        for (int i = 0; i < 16; ++i) { const float pv = fexp2(s[i] - m); s[i] = pv; ps += pv; }
        l += ps;
        const bf16x8 pb0 = packp(s, 0), pb1 = packp(s, 1);
#pragma unroll
        for (int db = 0; db < 2; ++db)
#pragma unroll
            for (int tt = 0; tt < 2; ++tt) {
                LAS const unsigned char* ap = buf + 9216 + (32 * db + c) * 136 + (32 * sub + 16 * tt + 4 * hi) * 2;
                const bf16x8 a = cat4(*(LAS const bf16x4*)ap, *(LAS const bf16x4*)(ap + 16));
                o[db] = MFMA32(a, tt == 0 ? pb0 : pb1, o[db]);
            }
    }
}

DI void nsa_unit(const Params& p, LAS unsigned char* lds, unsigned char* ldsg, int bg, int qt, int tid) {
    unsigned char* ws = p.ws;
    const bf16_t* PROJ = (const bf16_t*)(ws + OFF_PROJ);
    const bf16_t* KC = (const bf16_t*)(ws + OFF_KC); const bf16_t* VCT = (const bf16_t*)(ws + OFF_VCT);
    const bf16_t* VST = (const bf16_t*)(ws + OFF_VST); const bf16_t* VWT = (const bf16_t*)(ws + OFF_VWT);
    bf16_t* MIX = (bf16_t*)(ws + OFF_MIX);
    const int lane = tid & 63, w = __builtin_amdgcn_readfirstlane(tid >> 6), c = lane & 31, hi = lane >> 5;
    const int b = bg >> 1, g = bg & 1, q0 = qt * 32;
    const int head = c & 7, qi = c >> 3, tw0 = q0 + 4 * w, t = tw0 + qi, hh = g * 8 + head;
    const size_t tokb = (size_t)b * S_, tok = tokb + t;
    const float sc2 = 0.125f * LOG2E, slope2 = exp2f(-0.5f * (float)(hh + 1)) * LOG2E;

    LAS unsigned* SEL = (LAS unsigned*)(lds + NSA_SEL);
    LAS unsigned* UNI = (LAS unsigned*)(lds + NSA_UNI);
    LAS int* NL = (LAS int*)(lds + NSA_NL);
    LAS int* LIST = (LAS int*)(lds + NSA_LIST);
    LAS float* IMPw = (LAS float*)(lds + NSA_IMP + w * 2048);

    __syncthreads();
    const int nct = (q0 / 16 + 1 + 31) >> 5;
    for (int q0_ = tid; q0_ < nct * 256; q0_ += 4 * NTHREADS) {
        u32x4 v[4];
#pragma unroll
        for (int j = 0; j < 4; ++j) { const int q = q0_ + j * NTHREADS; if (q < nct * 256) v[j] = *(const u32x4*)(KC + ((size_t)(bg * 512 + (q >> 3))) * 64 + 8 * (q & 7)); }
#pragma unroll
        for (int j = 0; j < 4; ++j) { const int q = q0_ + j * NTHREADS; if (q < nct * 256) *(LAS u32x4*)(lds + NSA_KC + (q >> 3) * 144 + (q & 7) * 16) = v[j]; }
    }
    { const int cpr = nct * 4;
      for (int q0_ = tid; q0_ < 64 * cpr; q0_ += 4 * NTHREADS) {
          u32x4 v[4];
#pragma unroll
          for (int j = 0; j < 4; ++j) { const int q = q0_ + j * NTHREADS; if (q < 64 * cpr) { const int d = q / cpr, ch = q - d * cpr; v[j] = *(const u32x4*)(VCT + ((size_t)(bg * 64 + d)) * 512 + 8 * ch); } }
#pragma unroll
          for (int j = 0; j < 4; ++j) { const int q = q0_ + j * NTHREADS; if (q < 64 * cpr) { const int d = q / cpr, ch = q - d * cpr; LAS unsigned char* vp_ = lds + NSA_VCT + d * 1032 + ch * 16; *(LAS u32x2*)vp_ = (u32x2){v[j].x, v[j].y}; *(LAS u32x2*)(vp_ + 8) = (u32x2){v[j].z, v[j].w}; } }
      } }
    if (tid < 4) UNI[tid] = 0u;

    bf16x8 qf[4];
    { const bf16_t* qp = PROJ + tok * NPROJ + 832 + hh * 64 + 8 * hi;
#pragma unroll
      for (int st = 0; st < 4; ++st) {
          const u32x4 raw = *(const u32x4*)(qp + 16 * st); u32x4 sc;
          sc.x = pk2(bflo(raw.x) * sc2, bfhi(raw.x) * sc2); sc.y = pk2(bflo(raw.y) * sc2, bfhi(raw.y) * sc2);
          sc.z = pk2(bflo(raw.z) * sc2, bfhi(raw.z) * sc2); sc.w = pk2(bflo(raw.w) * sc2, bfhi(raw.w) * sc2);
          qf[st] = __builtin_bit_cast(bf16x8, sc); } }
    const bf16_t* gp = PROJ + tok * NPROJ + 2624 + hh * 3;
    const float gate_c = fsigmoid(bf2f(gp[0])), gate_s = fsigmoid(bf2f(gp[1])), gate_w = fsigmoid(bf2f(gp[2]));
    __syncthreads();

    f32x16 out[2];
    {
        const int cwm = (tw0 + 3 >= 31) ? ((tw0 + 3 - 31) >> 4) : -1;
        const int ntw = (cwm >= 0) ? (cwm >> 5) + 1 : 0;
        const float slope16 = 16.f * slope2;
        float m1 = -1e20f, l1 = 0.f;
        for (int tile = 0; tile < ntw; ++tile) {
            int dbase = t - 31 - 512 * tile - 64 * hi;
            asm volatile("" : "+v"(dbase));
            const float b0 = -slope2 * (float)dbase;
            f32x16 s;
#pragma unroll
            for (int i = 0; i < 16; ++i) s[i] = fmaf(slope16, (float)((i & 3) + 8 * (i >> 2)), b0);
#pragma unroll
            for (int st = 0; st < 4; ++st) {
                const bf16x8 a = *(LAS const bf16x8*)(lds + NSA_KC + (32 * tile + c) * 144 + st * 32 + hi * 16);
                s = MFMA32(a, qf[st], s);
            }
            if (512 * tile + 496 + 31 > tw0) {
#pragma unroll
                for (int i = 0; i < 16; ++i) if ((dbase - 16 * ((i & 3) + 8 * (i >> 2))) < 0) s[i] = -1e30f;
            }
            const float mn = fmaxf(m1, max16(s));
            float ps = 0.f;
#pragma unroll
            for (int i = 0; i < 16; ++i) ps += fexp2(s[i] - mn);
            l1 = l1 * fexp2(m1 - mn) + ps; m1 = mn;
        }
        const float mo = xhalf_partner(m1, hi), lo = xhalf_partner(l1, hi);
        const float M = fmaxf(m1, mo), L = l1 * fexp2(m1 - M) + lo * fexp2(mo - M);
        const float Moff = (L > 0.f) ? (M + __log2f(L)) : 1e30f;
#pragma unroll
        for (int i = 0; i < 8; ++i) IMPw[lane + 64 * i] = 0.f;
        LDS_WAIT();
        f32x16 oc[2];
#pragma unroll
        for (int db = 0; db < 2; ++db)
#pragma unroll
            for (int i = 0; i < 16; ++i) oc[db][i] = 0.f;
        float prev3 = 0.f;
        for (int tile = 0; tile < ntw; ++tile) {
            int dbase = t - 31 - 512 * tile - 64 * hi;
            asm volatile("" : "+v"(dbase));
            const float b0 = -slope2 * (float)dbase;
            f32x16 s;
#pragma unroll
            for (int i = 0; i < 16; ++i) s[i] = fmaf(slope16, (float)((i & 3) + 8 * (i >> 2)), b0);
#pragma unroll
            for (int st = 0; st < 4; ++st) {
                const bf16x8 a = *(LAS const bf16x8*)(lds + NSA_KC + (32 * tile + c) * 144 + st * 32 + hi * 16);
                s = MFMA32(a, qf[st], s);
            }
            if (512 * tile + 496 + 31 > tw0) {
#pragma unroll
                for (int i = 0; i < 16; ++i) if ((dbase - 16 * ((i & 3) + 8 * (i >> 2))) < 0) s[i] = -1e30f;
            }
#pragma unroll
            for (int i = 0; i < 16; ++i) s[i] = fexp2(s[i] - Moff);
            float pp[4];
#pragma unroll
            for (int r = 0; r < 4; ++r) pp[r] = xhalf_partner(s[4 * r + 3], hi);
#pragma unroll
            for (int r = 0; r < 4; ++r) {
                const float a = 2.f * (s[4 * r] + s[4 * r + 1] + s[4 * r + 2]) + s[4 * r + 3];
                const float cin = hi ? pp[r] : (r > 0 ? pp[r > 0 ? r - 1 : 0] : prev3);
                float v = a + cin;
                v = sum8(v);
                if (head == 0) IMPw[qi * 128 + 8 * tile + 2 * r + hi] = v;
            }
            prev3 = pp[3];
            const bf16x8 pb0 = packp(s, 0), pb1 = packp(s, 1);
#pragma unroll
            for (int db = 0; db < 2; ++db)
#pragma unroll
                for (int tt = 0; tt < 2; ++tt) {
                    LAS const unsigned char* ap = lds + NSA_VCT + (32 * db + c) * 1032 + (32 * tile + 16 * tt + 4 * hi) * 2;
                    const bf16x8 a = cat4(*(LAS const bf16x4*)ap, *(LAS const bf16x4*)(ap + 16));
                    oc[db] = MFMA32(a, tt == 0 ? pb0 : pb1, oc[db]);
                }
        }
        out[0] = oc[0] * gate_c; out[1] = oc[1] * gate_c;
        LDS_WAIT();
        for (int qi2 = 0; qi2 < 4; ++qi2) {
            const int t2 = tw0 + qi2, blk = t2 >> 6;
            LAS unsigned* kp = (LAS unsigned*)(IMPw + qi2 * 128);
            const int n0 = lane, n1 = lane + 64;
            const unsigned b0 = kp[n0], b1 = kp[n1];
            const bool f0 = (n0 == 0) || (n0 == blk) || (n0 == blk - 1), f1 = (n1 == blk) || (n1 == blk - 1);
            const unsigned k0 = (n0 <= blk) ? ((((f0 ? 0x461C4000u : b0)) & 0xFFFFFF80u) | (unsigned)(127 - n0)) : 0u;
            const unsigned k1 = (n1 <= blk) ? ((((f1 ? 0x461C4000u : b1)) & 0xFFFFFF80u) | (unsigned)(127 - n1)) : 0u;
            unsigned T = 0u;
#pragma unroll 1
            for (int bit = 30; bit >= 0; --bit) {
                const unsigned cand = T | (1u << bit);
                const int cnt = __popcll(__ballot(k0 >= cand)) + __popcll(__ballot(k1 >= cand));
                if (cnt >= 16) T = cand;
            }
            const bool s0 = (k0 != 0u) && (k0 >= T), s1 = (k1 != 0u) && (k1 >= T);
            const unsigned long long m0 = __ballot(s0), m1b = __ballot(s1);
            if (lane == 0) {
                const unsigned w0 = (unsigned)m0, w1 = (unsigned)(m0 >> 32), w2 = (unsigned)m1b, w3 = (unsigned)(m1b >> 32);
                LAS unsigned* sp = SEL + (4 * w + qi2) * 4;
                sp[0] = w0; sp[1] = w1; sp[2] = w2; sp[3] = w3;
                unsigned* ug = (unsigned*)(ldsg + NSA_UNI);
                atomicOr(ug + 0, w0); atomicOr(ug + 1, w1); atomicOr(ug + 2, w2); atomicOr(ug + 3, w3);
            }
        }
    }
    __syncthreads();
    if (tid == 0) {
        int cnt = 0;
        for (int wd = 0; wd < 4; ++wd) { unsigned bits = UNI[wd]; while (bits) { const int nb = 32 * wd + __builtin_ctz(bits); bits &= bits - 1; LIST[cnt++] = nb; } }
        NL[0] = cnt;
    }
    __syncthreads();
    const int kq = tid >> 3, kch = tid & 7;
    const int toff = kq * 144 + kch * 16, voff = 9216 + kq * 136 + kch * 16;
#define ST_V(base, v) do { LAS unsigned char* vp_ = (base) + voff; *(LAS u32x2*)vp_ = (u32x2){(v).x, (v).y}; *(LAS u32x2*)(vp_ + 8) = (u32x2){(v).z, (v).w}; } while (0)
    {
        const int nl = NL[0];
        const bf16_t* Ksrc = PROJ + (tokb + kq) * NPROJ + 2112 + g * 64 + 8 * kch;
        const bf16_t* Vsrc = VST + ((size_t)(bg * 64 + kq)) * S_ + 8 * kch;
        f32x16 o[2];
#pragma unroll
        for (int db = 0; db < 2; ++db)
#pragma unroll
            for (int i = 0; i < 16; ++i) o[db][i] = 0.f;
        float m = -1e20f, l = 0.f;
        u32x4 rk1, rv1, rk2, rv2;
        { const int nb = LIST[0]; rk1 = *(const u32x4*)(Ksrc + (size_t)(64 * nb) * NPROJ); rv1 = *(const u32x4*)(Vsrc + 64 * nb); }
        *(LAS u32x4*)(lds + toff) = rk1; ST_V(lds, rv1);
        if (nl > 1) { const int nb = LIST[1]; rk1 = *(const u32x4*)(Ksrc + (size_t)(64 * nb) * NPROJ); rv1 = *(const u32x4*)(Vsrc + 64 * nb); }
        __syncthreads();
        int cb = 0;
        for (int i = 0; i < nl; ++i) {
            const int nb = LIST[i];
            if (i + 2 < nl) { const int nb2 = LIST[i + 2]; rk2 = *(const u32x4*)(Ksrc + (size_t)(64 * nb2) * NPROJ); rv2 = *(const u32x4*)(Vsrc + 64 * nb2); }
            const bool lanesel = (SEL[(4 * w + qi) * 4 + (nb >> 5)] >> (nb & 31)) & 1u;
            if (__any(lanesel))
                nsa_tile<0>(lds + cb * NSA_TBUF, qf, o, m, l, 64 * nb, t, lanesel, slope2, c, hi);
            const int nbuf = (cb == 2) ? 0 : cb + 1;
            if (i + 1 < nl) { *(LAS u32x4*)(lds + nbuf * NSA_TBUF + toff) = rk1; ST_V(lds + nbuf * NSA_TBUF, rv1); }
            rk1 = rk2; rv1 = rv2; cb = nbuf;
            __syncthreads();
        }
        const float lt = xhalf_sum(l), sc = gate_s * frcp(lt);
        out[0] = out[0] + o[0] * sc; out[1] = out[1] + o[1] * sc;
    }
    {
        const int lo_key = (q0 - 511 > 0) ? (q0 - 511) : 0;
        const int kt_lo = lo_key >> 6, kt_hi = (q0 + 31) >> 6;
        const bf16_t* Ksrc = PROJ + (tokb + kq) * NPROJ + 2368 + g * 64 + 8 * kch;
        const bf16_t* Vsrc = VWT + ((size_t)(bg * 64 + kq)) * S_ + 8 * kch;
        f32x16 o[2];
#pragma unroll
        for (int db = 0; db < 2; ++db)
#pragma unroll
            for (int i = 0; i < 16; ++i) o[db][i] = 0.f;
        float m = -1e20f, l = 0.f;
        u32x4 rk1, rv1, rk2, rv2;
        rk1 = *(const u32x4*)(Ksrc + (size_t)(64 * kt_lo) * NPROJ); rv1 = *(const u32x4*)(Vsrc + 64 * kt_lo);
        *(LAS u32x4*)(lds + toff) = rk1; ST_V(lds, rv1);
        if (kt_lo < kt_hi) { rk1 = *(const u32x4*)(Ksrc + (size_t)(64 * (kt_lo + 1)) * NPROJ); rv1 = *(const u32x4*)(Vsrc + 64 * (kt_lo + 1)); }
        __syncthreads();
        int cb = 0;
        for (int kt = kt_lo; kt <= kt_hi; ++kt) {
            if (kt + 2 <= kt_hi) { rk2 = *(const u32x4*)(Ksrc + (size_t)(64 * (kt + 2)) * NPROJ); rv2 = *(const u32x4*)(Vsrc + 64 * (kt + 2)); }
            if (!(64 * kt + 63 < tw0 - 511 || 64 * kt > tw0 + 3))
                nsa_tile<1>(lds + cb * NSA_TBUF, qf, o, m, l, 64 * kt, t, true, slope2, c, hi);
            const int nbuf = (cb == 2) ? 0 : cb + 1;
            if (kt < kt_hi) { *(LAS u32x4*)(lds + nbuf * NSA_TBUF + toff) = rk1; ST_V(lds + nbuf * NSA_TBUF, rv1); }
            rk1 = rk2; rv1 = rv2; cb = nbuf;
            __syncthreads();
        }
        const float lt = xhalf_sum(l), sc = gate_w * frcp(lt);
        out[0] = out[0] + o[0] * sc; out[1] = out[1] + o[1] * sc;
    }
    bf16_t* op = MIX + tok * 2048 + 1024 + hh * 64 + 4 * hi;
#pragma unroll
    for (int db = 0; db < 2; ++db)
#pragma unroll
        for (int g4 = 0; g4 < 4; ++g4) {
            u32x2 wv; wv.x = pk2(out[db][4 * g4], out[db][4 * g4 + 1]); wv.y = pk2(out[db][4 * g4 + 2], out[db][4 * g4 + 3]);
            *(u32x2*)(op + 32 * db + 8 * g4) = wv;
        }
}

#define XB_TMO      128
#define XB_XCNT(j)  (256  + 64 * (j))
#define XB_XSUB(j)  (1280 + 64 * (j))
#define XB_XGEN(j)  (2304 + 64 * (j))
#define XB_TOP      3328
#define XB_TOPGEN   3392
#define XB_SPIN_CAP (1u << 18)
DI unsigned xb_ld(unsigned* p)              { return __hip_atomic_load(p, __ATOMIC_RELAXED, __HIP_MEMORY_SCOPE_AGENT); }
DI unsigned xb_add(unsigned* p, unsigned v) { return __hip_atomic_fetch_add(p, v, __ATOMIC_RELAXED, __HIP_MEMORY_SCOPE_AGENT); }
DI unsigned xb_xcc_id() { return (unsigned)__builtin_amdgcn_s_getreg((3 << 11) | 20) & 0xFu; }
#define XB_SPIN(cond, bar) do { unsigned _sp = 0; while (cond) { __builtin_amdgcn_s_sleep(1); \
    if ((++_sp & 255u) == 0u) { if (xb_ld(&(bar)[XB_TMO])) break; if (_sp > XB_SPIN_CAP) { atomicAdd(&(bar)[XB_TMO], 1u); break; } } } } while (0)
DI void xcd_barrier_complete(unsigned* bar, unsigned x, unsigned& nloc, unsigned& nx) {
    const unsigned G = gridDim.x * gridDim.y * gridDim.z;
    unsigned sum, cnt, mine, sp = 0u;
    for (;;) {
        sum = 0u; cnt = 0u; mine = 0u;
#pragma unroll
        for (unsigned j = 0; j < 16; ++j) { const unsigned c = xb_ld(&bar[XB_XCNT(j)]); sum += c; cnt += (c > 0u) ? 1u : 0u; mine = (j == x) ? c : mine; }
        if (sum == G) break;
        __builtin_amdgcn_s_sleep(1);
        if ((++sp & 255u) == 0u) { if (xb_ld(&bar[XB_TMO])) break; if (sp > XB_SPIN_CAP) { atomicAdd(&bar[XB_TMO], 1u); break; } }
    }
    nloc = mine > 0u ? mine : 1u; nx = cnt > 0u ? cnt : 1u;
}
DI void xcd_barrier(unsigned* bar, unsigned x, volatile LAS unsigned* st) {
    asm volatile("s_waitcnt vmcnt(0)" ::: "memory");
    __syncthreads();
    if (threadIdx.x == 0) {
        __builtin_amdgcn_s_waitcnt(0);
        unsigned nloc = st[0], nx = st[1];
        if (nloc == 0u) { xcd_barrier_complete(bar, x, nloc, nx); st[0] = nloc; st[1] = nx; }
        const unsigned old = xb_add(&bar[XB_XSUB(x)], 1u);
        const unsigned gen = old / nloc;
        if (old + 1u == (gen + 1u) * nloc) {
            __builtin_amdgcn_fence(__ATOMIC_RELEASE, "agent");
            asm volatile("s_waitcnt vmcnt(0)" ::: "memory");
            const unsigned og = xb_add(&bar[XB_TOP], 1u);
            const unsigned tg = og / nx;
            if (og + 1u == (tg + 1u) * nx) xb_add(&bar[XB_TOPGEN], 1u);
            else XB_SPIN(xb_ld(&bar[XB_TOPGEN]) == tg, bar);
            __builtin_amdgcn_fence(__ATOMIC_ACQUIRE, "agent");
            xb_add(&bar[XB_XGEN(x)], 1u);
            asm volatile("s_waitcnt vmcnt(0)" ::: "memory");
        } else {
            XB_SPIN(xb_ld(&bar[XB_XGEN(x)]) == gen, bar);
            __builtin_amdgcn_fence(__ATOMIC_ACQUIRE, "agent");
            asm volatile("s_waitcnt vmcnt(0)" ::: "memory");
        }
    }
    __syncthreads();
}
__global__ void __launch_bounds__(NTHREADS, 2) fwd_megakernel(Params p) {
    extern __shared__ __attribute__((aligned(16))) unsigned char dyn_lds[];
    cg::grid_group grid = cg::this_grid();
    LAS unsigned char* lds = (LAS unsigned char*)dyn_lds;
    const int G = gridDim.x, bid = blockIdx.x;
    volatile LAS unsigned* xst = (volatile LAS unsigned*)(lds + 158688);
    if (threadIdx.x < 2) xst[threadIdx.x] = 0u;
    __syncthreads();
    unsigned* xbar = (unsigned*)(p.ws + OFF_XBAR);
    const unsigned xcc = xb_xcc_id();
#define PHASE_IDS const int tid = fresh_tid(), lane = tid & 63, wave = __builtin_amdgcn_readfirstlane(tid >> 6); (void)lane; (void)wave
    unsigned char* ws = p.ws;
    bf16_t* HN = (bf16_t*)(ws + OFF_HN); bf16_t* PROJ = (bf16_t*)(ws + OFF_PROJ);
    const float* RSQ = (const float*)(ws + OFF_RSQ); const float* RSKV = (const float*)(ws + OFF_RSKV);
    const float* BIAS = (const float*)(ws + OFF_BIAS);
    using pg8::Gemm; using pg8::Epi; using pg8::StaticOrder;

    for (int rep = 0; rep < REP_P0; ++rep) { PHASE_IDS; prologue(p, lds, tid, lane, wave); }
    grid.sync();
    if (threadIdx.x == 0) (void)xb_add(&xbar[XB_XCNT(xcc)], 1u);
    {
        Gemm g{HN, (const bf16_t*)(ws + OFF_WIN), T_, NPROJ, DM, DM, DM}; StaticOrder S; S.init(T_, NPROJ, G, bid);
        Epi E{pg8::EPI_STORE, PROJ, NPROJ, NPROJ, nullptr, 1.f, nullptr, nullptr, nullptr, nullptr, nullptr, nullptr};
        for (int rep = 0; rep < REP_P1; ++rep) pg8::gemm_phase(lds, g, S, E);
    }
    xcd_barrier(xbar, xcc, xst);
    { PHASE_IDS; for (int tile = bid; tile < T_ / 64; tile += G) postproj_tile(p, lds, tile, tid, lane, wave); }
    xcd_barrier(xbar, xcc, xst);
    {
        { Gemm g{PROJ, (const bf16_t*)(ws + OFF_WUQ), T_, 1536, 512, NPROJ, 512}; StaticOrder S; S.init(T_, 1536, G, bid);
          Epi E{pg8::EPI_Q, (bf16_t*)(ws + OFF_QMLA), 1536, 1536, RSQ, 0.07216878364870322f * LOG2E, (const float*)(ws + OFF_COS), (const float*)(ws + OFF_SIN), nullptr, nullptr, nullptr, nullptr};
          pg8::gemm_phase(lds, g, S, E); }
        { Gemm g{PROJ + 512, (const bf16_t*)(ws + OFF_WK), T_, 1024, 256, NPROJ, 256}; StaticOrder S; S.init(T_, 1024, G, bid);
          Epi E{pg8::EPI_STORE, (bf16_t*)(ws + OFF_KNOPE), 1024, 1024, RSKV, 1.f, nullptr, nullptr, nullptr, nullptr, nullptr, nullptr};
          pg8::gemm_phase(lds, g, S, E); }
        { Gemm g{(const bf16_t*)(ws + OFF_WV), PROJ + 512, 1024, T_, 256, 256, NPROJ}; StaticOrder S; S.init(1024, T_, G, bid);
          Epi E{pg8::EPI_VT, (bf16_t*)(ws + OFF_VT), T_, T_, RSKV, 1.f, nullptr, nullptr, nullptr, nullptr, nullptr, nullptr};
          pg8::gemm_phase(lds, g, S, E); }
    }
    xcd_barrier(xbar, xcc, xst);
    if (bid < 16) {
        StaticOrder S; S.init(4096, 256, 16, bid);
        { Gemm g{(const bf16_t*)(ws + OFF_KCG), (const bf16_t*)(ws + OFF_WC1K), 4096, 256, 2048, 1024, 2048};
          Epi E{pg8::EPI_SILU, (bf16_t*)(ws + OFF_HIDK), 256, 256, nullptr, 1.f, nullptr, nullptr, BIAS, nullptr, nullptr, nullptr};
          pg8::gemm_phase(lds, g, S, E); }
        __threadfence(); __syncthreads();
        { Gemm g{(const bf16_t*)(ws + OFF_HIDK), (const bf16_t*)(ws + OFF_WC2K), 4096, 256, 256, 256, 256};
          Epi E{pg8::EPI_STORE, (bf16_t*)(ws + OFF_KC), 64, 64, nullptr, 1.f, nullptr, nullptr, nullptr, nullptr, nullptr, nullptr};
          pg8::gemm_phase(lds, g, S, E); }
    } else if (bid < 32) {
        { StaticOrder S; S.init(4096, 256, 16, bid - 16);
          Gemm g{(const bf16_t*)(ws + OFF_VCG), (const bf16_t*)(ws + OFF_WC1V), 4096, 256, 2048, 1024, 2048};
          Epi E{pg8::EPI_SILU, (bf16_t*)(ws + OFF_HIDV), 256, 256, nullptr, 1.f, nullptr, nullptr, BIAS + 256, nullptr, nullptr, nullptr};
          pg8::gemm_phase(lds, g, S, E); }
        __threadfence(); __syncthreads();
        { StaticOrder S; S.init(256, 4096, 16, bid - 16);
          Gemm g{(const bf16_t*)(ws + OFF_WC2V), (const bf16_t*)(ws + OFF_HIDV), 256, 4096, 256, 256, 256};
          Epi E{pg8::EPI_VCT, (bf16_t*)(ws + OFF_VCT), 512, 4096, nullptr, 1.f, nullptr, nullptr, nullptr, nullptr, nullptr, nullptr};
          pg8::gemm_phase(lds, g, S, E); }
    }
    for (int rep = 0; rep < REP_MLA; ++rep) {
        unsigned* ctl = (unsigned*)(ws + OFF_CTL) + rep * 256;
        LAS int* QU = (LAS int*)(lds + 158208);
        for (int k = 0; k < 8; ++k) {
            const int qq = (bid + k) & 7;
            for (;;) {
                PHASE_IDS;
                __syncthreads();
                if (tid == 0) QU[0] = (int)atomicAdd(ctl + qq * 16, 1u);
                __syncthreads();
                const int qi_ = QU[0];
                if (qi_ >= 128) break;
                const int pr_ = qi_ >> 6, r_ = qi_ & 63;
                const int qb = 31 - (r_ >> 1), bh = qq + 8 * (2 * pr_ + (r_ & 1));
                mla_unit(p, lds, bh >> 3, bh & 7, qb, tid);
            }
        }
    }
    xcd_barrier(xbar, xcc, xst);
    for (int rep = 0; rep < REP_NSA; ++rep)
    for (int u = bid, rnd = 0; u < 2048; u += G, ++rnd) {
        PHASE_IDS;
        const int bg = (u + rnd) & 7, qt = 255 - (u >> 3);
        nsa_unit(p, lds, dyn_lds, bg, qt, tid);
    }
    xcd_barrier(xbar, xcc, xst);
    {
        Gemm g{(const bf16_t*)(ws + OFF_MIX), (const bf16_t*)(ws + OFF_WO), T_, DM, DM, DM, DM}; StaticOrder S; S.init(T_, DM, G, bid);
        Epi E{pg8::EPI_RESID_NORM, HN, DM, DM, nullptr, 1.f, nullptr, nullptr, nullptr, p.in[0], p.out, (float*)(ws + OFF_ROWSQ)};
        pg8::gemm_phase(lds, g, S, E);
    }
    xcd_barrier(xbar, xcc, xst);
    {
        Gemm g{HN, (const bf16_t*)(ws + OFF_WGU), T_, 2 * FF, DM, DM, DM}; StaticOrder S; S.init(T_, 2 * FF, G, bid);
        Epi E{pg8::EPI_SWIGLU, (bf16_t*)(ws + OFF_ACT), FF, 2 * FF, nullptr, 1.f, nullptr, nullptr, nullptr, nullptr, nullptr, (float*)(ws + OFF_ROWSQ)};
        for (int rep = 0; rep < REP_P8; ++rep) pg8::gemm_phase(lds, g, S, E);
    }
    xcd_barrier(xbar, xcc, xst);
    {
        Gemm g{(const bf16_t*)(ws + OFF_ACT), (const bf16_t*)(ws + OFF_WD), T_, DM, FF, FF, FF}; StaticOrder S; S.init(T_, DM, G, bid);
        Epi E{pg8::EPI_RESID, nullptr, DM, DM, nullptr, 1.f, nullptr, nullptr, nullptr, p.out, p.out, nullptr};
        pg8::gemm_phase(lds, g, S, E);
    }
    xcd_barrier(xbar, xcc, xst);
    {
        PHASE_IDS;
        const int gw = bid * 8 + wave, NGW = G * 8;
        for (int m = gw; m < T_; m += NGW) norm_row_f32_inplace(p.out + (size_t)m * DM, p.in[19], lane);
    }
}

extern "C" void kernel_launch(void* const* d_in, const int* in_sizes, int n_in, void* d_out, int out_size, void* d_ws, size_t ws_size, hipStream_t stream) {
    static int grid_blocks = 0;
    if (grid_blocks == 0) {
        if (n_in != 20 || ws_size < WS_END) { fprintf(stderr, "kernel_launch: unexpected n_in %d or ws_size %zu (< %zu)\n", n_in, ws_size, (size_t)WS_END); grid_blocks = -1; return; }
        int dev = 0, cus = 0, per_cu = 0;
        hipGetDevice(&dev);
        hipDeviceGetAttribute(&cus, hipDeviceAttributeMultiprocessorCount, dev);
        if (hipFuncSetAttribute((const void*)fwd_megakernel, hipFuncAttributeMaxDynamicSharedMemorySize, LDS_BYTES) != hipSuccess) fprintf(stderr, "kernel_launch: hipFuncSetAttribute failed\n");
        if (hipOccupancyMaxActiveBlocksPerMultiprocessor(&per_cu, (const void*)fwd_megakernel, NTHREADS, LDS_BYTES) != hipSuccess || per_cu < 1) { fprintf(stderr, "kernel_launch: occupancy query gave %d\n", per_cu); per_cu = 1; }
        (void)hipGetLastError();
        grid_blocks = cus * per_cu;
    }
    if (grid_blocks < 0) return;
    unsigned char* ws = (unsigned char*)d_ws;
    Params p{};
    for (int i = 0; i < 20; ++i) p.in[i] = (const float*)d_in[i];
    p.out = (float*)d_out; p.ws = ws;
    void* args[] = {&p};
    hipError_t e = hipLaunchCooperativeKernel((const void*)fwd_megakernel, dim3(grid_blocks), dim3(NTHREADS), args, LDS_BYTES, stream);
    if (e != hipSuccess) fprintf(stderr, "kernel_launch: cooperative launch failed: %s (grid %d)\n", hipGetErrorString(e), grid_blocks);
}
```

```cpp
#include <hip/hip_runtime.h>
#include <hip/hip_cooperative_groups.h>
#include <cstdio>
#include <cstdint>
namespace cg = cooperative_groups;

#define LAS __attribute__((address_space(3)))
#define DI __device__ __forceinline__
typedef unsigned short bf16_t;
typedef short bf16x8 __attribute__((ext_vector_type(8)));
typedef short bf16x4 __attribute__((ext_vector_type(4)));
typedef float f32x4 __attribute__((ext_vector_type(4)));
typedef float f32x16 __attribute__((ext_vector_type(16)));
typedef unsigned u32x4 __attribute__((ext_vector_type(4)));
typedef unsigned u32x2 __attribute__((ext_vector_type(2)));

constexpr int T_ = 32768, S_ = 8192, DM = 2048, NPROJ = 2816, FF = 5632;
constexpr float LOG2E = 1.4426950408889634f;
constexpr int NTHREADS = 512;
constexpr int LDS_BYTES = 158720;
constexpr int REP_P0 = 1, REP_P1 = 1, REP_MLA = 1, REP_NSA = 1, REP_P8 = 1;

constexpr size_t MiB = 1048576;
constexpr size_t OFF_HN = 0;
constexpr size_t OFF_PROJ = 128 * MiB;
constexpr size_t OFF_QMLA = 304 * MiB;
constexpr size_t OFF_KNOPE = 400 * MiB;
constexpr size_t OFF_VT = 464 * MiB;
constexpr size_t OFF_ACT = 128 * MiB;
constexpr size_t OFF_MIX = 528 * MiB;
constexpr size_t OFF_W = 656 * MiB;
constexpr size_t OFF_WIN = OFF_W;
constexpr size_t OFF_WUQ = OFF_WIN + 2816ull * 2048 * 2;
constexpr size_t OFF_WK = OFF_WUQ + 1536ull * 512 * 2;
constexpr size_t OFF_WV = OFF_WK + 1024ull * 256 * 2;
constexpr size_t OFF_WO = OFF_WV + 1024ull * 256 * 2;
constexpr size_t OFF_WGU = OFF_WO + 2048ull * 2048 * 2;
constexpr size_t OFF_WD = OFF_WGU + 11264ull * 2048 * 2;
constexpr size_t OFF_WC1K = OFF_WD + 2048ull * 5632 * 2;
constexpr size_t OFF_WC1V = OFF_WC1K + 256ull * 2048 * 2;
constexpr size_t OFF_WC2K = OFF_WC1V + 256ull * 2048 * 2;
constexpr size_t OFF_WC2V = OFF_WC2K + 256ull * 256 * 2;
constexpr size_t OFF_MISC = 752 * MiB;
constexpr size_t OFF_KROPE = OFF_MISC;
constexpr size_t OFF_KCG = OFF_KROPE + 4 * MiB;
constexpr size_t OFF_VCG = OFF_KCG + 8 * MiB + 65536;
constexpr size_t OFF_VST = OFF_VCG + 8 * MiB + 65536;
constexpr size_t OFF_VWT = OFF_VST + 8 * MiB;
constexpr size_t OFF_HIDK = OFF_VWT + 8 * MiB;
constexpr size_t OFF_HIDV = OFF_HIDK + 2 * MiB;
constexpr size_t OFF_KC = OFF_HIDV + 2 * MiB;
constexpr size_t OFF_VCT = OFF_KC + MiB / 2;
constexpr size_t OFF_RSQ = OFF_VCT + MiB / 2;
constexpr size_t OFF_RSKV = OFF_RSQ + 131072;
constexpr size_t OFF_COS = OFF_RSKV + 131072;
constexpr size_t OFF_SIN = OFF_COS + MiB;
constexpr size_t OFF_BIAS = OFF_SIN + MiB;
constexpr size_t OFF_CTL = OFF_BIAS + 4096;
constexpr size_t OFF_ROWSQ = OFF_CTL + 4096;
constexpr size_t OFF_XBAR = OFF_ROWSQ + 131072;
constexpr size_t WS_END = OFF_XBAR + 16384;

DI unsigned f2bf(float f) { unsigned u = __builtin_bit_cast(unsigned, f); return (u + 0x7fffu + ((u >> 16) & 1u)) >> 16; }
typedef __bf16 hwbf16x2 __attribute__((ext_vector_type(2)));
typedef float f32x2 __attribute__((ext_vector_type(2)));
DI unsigned pk2(float lo, float hi) { const f32x2 v = {lo, hi}; const hwbf16x2 b = __builtin_convertvector(v, hwbf16x2); return __builtin_bit_cast(unsigned, b); }
DI float bf2f(unsigned b) { return __builtin_bit_cast(float, b << 16); }
DI float bflo(unsigned w) { return __builtin_bit_cast(float, w << 16); }
DI float bfhi(unsigned w) { return __builtin_bit_cast(float, w & 0xffff0000u); }
DI float wave_sum(float v) {
#pragma unroll
    for (int o = 1; o < 64; o <<= 1) v += __shfl_xor(v, o);
    return v;
}
DI void swap32(unsigned& a, unsigned& b) { asm volatile("s_nop 1\n\tv_permlane32_swap_b32 %0, %1" : "+v"(a), "+v"(b)); }
DI float xhalf_max(float v) { unsigned a = __builtin_bit_cast(unsigned, v), b = a; swap32(a, b); return fmaxf(__builtin_bit_cast(float, a), __builtin_bit_cast(float, b)); }
DI float xhalf_sum(float v) { unsigned a = __builtin_bit_cast(unsigned, v), b = a; swap32(a, b); return __builtin_bit_cast(float, a) + __builtin_bit_cast(float, b); }
DI float xhalf_partner(float v, int hi) { unsigned a = __builtin_bit_cast(unsigned, v), b = a; swap32(a, b); return __builtin_bit_cast(float, hi ? a : b); }
DI float sum8(float v) {
    v += __builtin_bit_cast(float, __builtin_amdgcn_mov_dpp(__builtin_bit_cast(int, v), 0xB1, 0xF, 0xF, true));
    v += __builtin_bit_cast(float, __builtin_amdgcn_mov_dpp(__builtin_bit_cast(int, v), 0x4E, 0xF, 0xF, true));
    v += __builtin_bit_cast(float, __builtin_amdgcn_mov_dpp(__builtin_bit_cast(int, v), 0x141, 0xF, 0xF, true));
    return v;
}
DI float fexp2(float x) { return __builtin_amdgcn_exp2f(x); }
DI float frcp(float x) { return __builtin_amdgcn_rcpf(x); }
DI float frsq(float x) { return __builtin_amdgcn_rsqf(x); }
DI float fsilu(float v) { return v * frcp(1.f + __expf(-v)); }
DI float fsigmoid(float v) { return frcp(1.f + __expf(-v)); }
#define LDS_WAIT() asm volatile("s_waitcnt lgkmcnt(0)" ::: "memory")
#define MFMA32(a, b, c) __builtin_amdgcn_mfma_f32_32x32x16_bf16((a), (b), (c), 0, 0, 0)
DI int crow(int r, int hi) { return (r & 3) + 8 * (r >> 2) + 4 * hi; }
DI int fresh_tid() { int t = threadIdx.x; asm volatile("" : "+v"(t)); return t; }

struct Params { const float* in[20]; float* out; unsigned char* ws; };

namespace pg8 {
constexpr int BM = 256, BK = 64, HALF = 128, HTB = HALF * BK * 2, STAGE_BYTES = 8 * HTB, NXCD = 8, WGM = 4;
DI int lds_byte(int r, int c) { const int st = (r >> 4) * 2 + (c >> 5), rr = r & 15, cc = c & 31, ob = rr * 64 + cc * 2; return st * 1024 + (ob ^ (((ob >> 9) & 1) << 5)); }
DI void stage_rc(int b, int& R, int& C) { const int st = b / 1024, sb = b % 1024, swz = sb ^ (((sb >> 9) & 1) << 5); R = (st >> 1) * 16 + swz / 64; C = (st & 1) * 32 + (swz % 64) / 2; }
DI int perm32(int rho) { const int n = rho >> 4, i = rho & 15; return 8 * (i >> 2) + 4 * n + (i & 3); }
struct Unit { int pm, pn; };
struct Gemm { const bf16_t* A; const bf16_t* Bt; int M, N, K, lda, ldb; };
struct StaticOrder {
    int nM, nN, nwg, G, c;
    DI void init(int M, int N, int G_, int c_) { nM = M / BM; nN = N / BM; nwg = nM * nN; G = G_; c = c_; }
    DI bool next(int i, Unit& u) const {
        const long L = (long)i * G + c; if (L >= nwg) return false;
        int wgid = (int)L; { const int q = nwg / NXCD, r = nwg % NXCD, xcd = wgid % NXCD, off = wgid / NXCD; wgid = (xcd < r ? xcd * (q + 1) : r * (q + 1) + (xcd - r) * q) + off; }
        const int nig = WGM * nN, gid = wgid / nig, fm = gid * WGM, gsz = (nM - fm) < WGM ? (nM - fm) : WGM;
        u.pm = fm + ((wgid % nig) % gsz); u.pn = (wgid % nig) / gsz; return true;
    }
};

enum { EPI_STORE = 0, EPI_Q = 1, EPI_VT = 2, EPI_SILU = 3, EPI_VCT = 4, EPI_RESID = 5, EPI_SWIGLU = 6, EPI_RESID_NORM = 7, EPI_RESID_BF = 8 };
struct Epi {
    int mode; bf16_t* O; int ldc; int ncols; const float* rscale; float qscale; const float* cosT; const float* sinT; const float* bias; const float* resid; float* outf; float* rowsq;
    DI void operator()(const f32x4 (&acc)[2][2][4][2], const Unit& u, int wr, int wc, int fr, int fq) const {
        const int row0 = u.pm * BM + wr * 64 + fr, col0 = u.pn * BM + wc * 32 + 8 * fq;
#pragma unroll
        for (int ai = 0; ai < 2; ++ai)
#pragma unroll
            for (int m = 0; m < 4; ++m) {
                const int row = row0 + ai * HALF + m * 16;
                float rs = 1.f, rowacc = 0.f;
                if (mode == EPI_STORE || mode == EPI_Q) { if (rscale) rs = rscale[row]; }
                if (mode == EPI_SWIGLU) rs = frsq(rowsq[row] * (1.0f / DM) + 1e-6f);
#pragma unroll
                for (int bj = 0; bj < 2; ++bj) {
                    const int col = col0 + bj * HALF;
                    f32x4 v0 = acc[ai][bj][m][0], v1 = acc[ai][bj][m][1];
                    if (mode == EPI_STORE) {
                        if (col < ncols) { v0 = v0 * rs; v1 = v1 * rs; u32x4 w; w.x = pk2(v0[0], v0[1]); w.y = pk2(v0[2], v0[3]); w.z = pk2(v1[0], v1[1]); w.w = pk2(v1[2], v1[3]);
                            *(u32x4*)(O + (size_t)row * ldc + col) = w; }
                    } else if (mode == EPI_Q) {
                        const float sc = rs * qscale; v0 = v0 * sc; v1 = v1 * sc;
                        const int c192 = col % 192;
                        if (c192 >= 128) {
                            const int i0 = (c192 - 128) >> 1, pos = row & (S_ - 1);
                            const f32x4 cs = *(const f32x4*)(cosT + pos * 32 + i0), sn = *(const f32x4*)(sinT + pos * 32 + i0);
                            float a, b;
                            a = v0[0]; b = v0[1]; v0[0] = a * cs[0] - b * sn[0]; v0[1] = a * sn[0] + b * cs[0];
                            a = v0[2]; b = v0[3]; v0[2] = a * cs[1] - b * sn[1]; v0[3] = a * sn[1] + b * cs[1];
                            a = v1[0]; b = v1[1]; v1[0] = a * cs[2] - b * sn[2]; v1[1] = a * sn[2] + b * cs[2];
                            a = v1[2]; b = v1[3]; v1[2] = a * cs[3] - b * sn[3]; v1[3] = a * sn[3] + b * cs[3];
                        }
                        u32x4 w; w.x = pk2(v0[0], v0[1]); w.y = pk2(v0[2], v0[3]); w.z = pk2(v1[0], v1[1]); w.w = pk2(v1[2], v1[3]);
                        *(u32x4*)(O + (size_t)row * ldc + col) = w;
                    } else if (mode == EPI_VT) {
                        const f32x4 s0 = *(const f32x4*)(rscale + col), s1 = *(const f32x4*)(rscale + col + 4);
                        v0 = v0 * s0; v1 = v1 * s1;
                        u32x4 w; w.x = pk2(v0[0], v0[1]); w.y = pk2(v0[2], v0[3]); w.z = pk2(v1[0], v1[1]); w.w = pk2(v1[2], v1[3]);
                        *(u32x4*)(O + (size_t)row * ldc + col) = w;
                    } else if (mode == EPI_SILU) {
                        const f32x4 b0 = *(const f32x4*)(bias + col), b1 = *(const f32x4*)(bias + col + 4);
                        v0 = v0 + b0; v1 = v1 + b1;
                        u32x4 w; w.x = pk2(fsilu(v0[0]), fsilu(v0[1])); w.y = pk2(fsilu(v0[2]), fsilu(v0[3])); w.z = pk2(fsilu(v1[0]), fsilu(v1[1])); w.w = pk2(fsilu(v1[2]), fsilu(v1[3]));
                        *(u32x4*)(O + (size_t)row * ldc + col) = w;
                    } else if (mode == EPI_VCT) {
                        if (row < 64) { u32x4 w; w.x = pk2(v0[0], v0[1]); w.y = pk2(v0[2], v0[3]); w.z = pk2(v1[0], v1[1]); w.w = pk2(v1[2], v1[3]);
                            *(u32x4*)(O + ((size_t)((col >> 9) * 64 + row)) * 512 + (col & 511)) = w; }
                    } else if (mode == EPI_RESID) {
                        const size_t ix = (size_t)row * DM + col;
                        const f32x4 r0 = *(const f32x4*)(resid + ix), r1 = *(const f32x4*)(resid + ix + 4);
                        *(f32x4*)(outf + ix) = v0 + r0; *(f32x4*)(outf + ix + 4) = v1 + r1;
                    } else if (mode == EPI_RESID_BF) {
                        const size_t ix = (size_t)row * DM + col;
                        const u32x4 rb = *(const u32x4*)(O + ix);
                        v0[0] += bflo(rb.x); v0[1] += bfhi(rb.x); v0[2] += bflo(rb.y); v0[3] += bfhi(rb.y);
                        v1[0] += bflo(rb.z); v1[1] += bfhi(rb.z); v1[2] += bflo(rb.w); v1[3] += bfhi(rb.w);
                        *(f32x4*)(outf + ix) = v0; *(f32x4*)(outf + ix + 4) = v1;
                    } else if (mode == EPI_RESID_NORM) {
                        const size_t ix = (size_t)row * DM + col;
                        const f32x4 r0 = *(const f32x4*)(resid + ix), r1 = *(const f32x4*)(resid + ix + 4);
                        v0 = v0 + r0; v1 = v1 + r1;
                        if (outf) { *(f32x4*)(outf + ix) = v0; *(f32x4*)(outf + ix + 4) = v1; }
                        u32x4 w; w.x = pk2(v0[0], v0[1]); w.y = pk2(v0[2], v0[3]); w.z = pk2(v1[0], v1[1]); w.w = pk2(v1[2], v1[3]);
                        *(u32x4*)(O + ix) = w;
                        rowacc += (v0[0] * v0[0] + v0[1] * v0[1]) + (v0[2] * v0[2] + v0[3] * v0[3]) + (v1[0] * v1[0] + v1[1] * v1[1]) + (v1[2] * v1[2] + v1[3] * v1[3]);
                    } else {
                        v0 = v0 * rs; v1 = v1 * rs;
                        u32x2 w; w.x = pk2(fsilu(v0[0]) * v1[0], fsilu(v0[1]) * v1[1]); w.y = pk2(fsilu(v0[2]) * v1[2], fsilu(v0[3]) * v1[3]);
                        *(u32x2*)(O + (size_t)row * ldc + (col >> 1)) = w;
                    }
                }
                if (mode == EPI_RESID_NORM) {
                    rowacc += __shfl_xor(rowacc, 16); rowacc += __shfl_xor(rowacc, 32);
                    if (fq == 0) atomicAdd(rowsq + row, rowacc);
                }
            }
    }
};

DI void gemm_phase(LAS unsigned char* lds, const Gemm g, const StaticOrder& S, const Epi& E) {
    const int tid = fresh_tid(), wid = __builtin_amdgcn_readfirstlane(tid >> 6), lane = tid & 63, wr = wid >> 2, wc = wid & 3, fr = lane & 15, fq = lane >> 4;
    const int K = g.K, nt = K / BK;
    unsigned voffA[2], voffB[2];
#pragma unroll
    for (int i = 0; i < 2; ++i) { int R, C; stage_rc(tid * 16 + i * 8192, R, C); const int Rb = (R & ~31) + perm32(R & 31);
        voffA[i] = (unsigned)(R * g.lda + C) * 2u; voffB[i] = (unsigned)(Rb * g.ldb + C) * 2u; }
    const size_t kstep = (size_t)(BK * 2);
    const size_t hsA = (size_t)HALF * g.lda * 2, hsB = (size_t)HALF * g.ldb * 2;
    const size_t tsA = 2 * hsA, tsB = 2 * hsB;
    const unsigned ldsw = (unsigned)wid * 1024u;
    const int aoff = lds_byte(wr * 64 + fr, fq * 8), boff = lds_byte(wc * 32 + fr, fq * 8);
#define PG8_SA(b, h) (((b) * 2 + (h)) * HTB)
#define PG8_SB(b, h) ((4 + (b) * 2 + (h)) * HTB)
#define PG8_STAGE(bufoff, gbase, voff) do { _Pragma("unroll") for (int _i = 0; _i < 2; ++_i) \
        __builtin_amdgcn_global_load_lds((const unsigned*)((const char*)(gbase) + (voff)[_i]), (LAS unsigned*)(lds + (bufoff) + ldsw + _i * 8192), 16, 0, 0); } while (0)
#define PG8_LDA(dst, b, h) do { _Pragma("unroll") for (int m = 0; m < 4; ++m) _Pragma("unroll") for (int k = 0; k < 2; ++k) dst[m][k] = *(const LAS bf16x8*)(lds + PG8_SA(b, h) + aoff + m * 2048 + k * 1024); } while (0)
#define PG8_LDB(dst, b, h) do { _Pragma("unroll") for (int n = 0; n < 2; ++n) _Pragma("unroll") for (int k = 0; k < 2; ++k) dst[n][k] = *(const LAS bf16x8*)(lds + PG8_SB(b, h) + boff + n * 2048 + k * 1024); } while (0)
#define PG8_MMA(ai, bj, At, Bt) do { __builtin_amdgcn_s_setprio(1); _Pragma("unroll") for (int m = 0; m < 4; ++m) _Pragma("unroll") for (int n = 0; n < 2; ++n) _Pragma("unroll") for (int k = 0; k < 2; ++k) \
        acc[ai][bj][m][n] = __builtin_amdgcn_mfma_f32_16x16x32_bf16(Bt[n][k], At[m][k], acc[ai][bj][m][n], 0, 0, 0); __builtin_amdgcn_s_setprio(0); } while (0)
#define PG8_WAIT_V(n) asm volatile("s_waitcnt vmcnt(" #n ")" ::: "memory")
#define PG8_WAIT_L(n) asm volatile("s_waitcnt lgkmcnt(" #n ")" ::: "memory")
#define PG8_BAR __builtin_amdgcn_s_barrier()
#define PG8_SCHED __builtin_amdgcn_sched_barrier(0)
    Unit cur, nxt; int ui = 0;
    if (!S.next(0, cur)) return;
    f32x4 acc[2][2][4][2];
#pragma unroll
    for (int a = 0; a < 2; ++a)
#pragma unroll
        for (int b = 0; b < 2; ++b)
#pragma unroll
            for (int m = 0; m < 4; ++m)
#pragma unroll
                for (int n = 0; n < 2; ++n) acc[a][b][m][n] = (f32x4){0.f, 0.f, 0.f, 0.f};
    bf16x8 At[4][2], B0[2][2], B1[2][2];
    const char* cA = (const char*)g.A + (size_t)cur.pm * tsA; const char* cB = (const char*)g.Bt + (size_t)cur.pn * tsB;
    PG8_STAGE(PG8_SB(0, 0), cB, voffB); PG8_STAGE(PG8_SB(0, 1), cB + hsB, voffB); PG8_STAGE(PG8_SA(0, 0), cA, voffA); PG8_STAGE(PG8_SA(0, 1), cA + hsA, voffA);
    if (wr == 1) PG8_BAR;
    PG8_WAIT_V(2); PG8_BAR;
    PG8_STAGE(PG8_SB(1, 0), cB + kstep, voffB); PG8_STAGE(PG8_SA(1, 0), cA + kstep, voffA); PG8_STAGE(PG8_SB(1, 1), cB + hsB + kstep, voffB);
    PG8_WAIT_V(6); PG8_BAR;
    for (;;) {
        const bool has_next = S.next(ui + 1, nxt);
        const char* nA = has_next ? (const char*)g.A + (size_t)nxt.pm * tsA : cA; const char* nB = has_next ? (const char*)g.Bt + (size_t)nxt.pn * tsB : cB;
        for (int t = 0; t < nt; t += 2) {
            const bool last = (t == nt - 2);
            const char* a1 = cA + (size_t)(t + 1) * kstep;
            const char* a2 = last ? nA : cA + (size_t)(t + 2) * kstep; const char* b2 = last ? nB : cB + (size_t)(t + 2) * kstep;
            const char* a3 = a2 + kstep; const char* b3 = b2 + kstep;
            PG8_LDB(B0, 0, 0); PG8_LDB(B1, 0, 1); PG8_SCHED; PG8_LDA(At, 0, 0); PG8_STAGE(PG8_SA(1, 1), a1 + hsA, voffA);
            PG8_WAIT_V(8); PG8_WAIT_L(0); PG8_BAR; PG8_MMA(0, 0, At, B0); PG8_MMA(0, 1, At, B1); PG8_BAR; PG8_SCHED;
            PG8_LDA(At, 0, 1); PG8_STAGE(PG8_SB(0, 0), b2, voffB); PG8_STAGE(PG8_SB(0, 1), b2 + hsB, voffB); PG8_STAGE(PG8_SA(0, 0), a2, voffA);
            PG8_WAIT_V(8); PG8_WAIT_L(0); PG8_BAR; PG8_MMA(1, 0, At, B0); PG8_MMA(1, 1, At, B1); PG8_BAR; PG8_SCHED;
            PG8_LDB(B0, 1, 0); PG8_LDB(B1, 1, 1); PG8_SCHED; PG8_LDA(At, 1, 0); PG8_STAGE(PG8_SA(0, 1), a2 + hsA, voffA);
            PG8_WAIT_V(8); PG8_WAIT_L(0); PG8_BAR; PG8_MMA(0, 0, At, B0); PG8_MMA(0, 1, At, B1); PG8_BAR; PG8_SCHED;
            PG8_LDA(At, 1, 1); PG8_STAGE(PG8_SB(1, 0), b3, voffB); PG8_STAGE(PG8_SB(1, 1), b3 + hsB, voffB); PG8_STAGE(PG8_SA(1, 0), a3, voffA);
            PG8_WAIT_V(8); PG8_WAIT_L(0); PG8_BAR; PG8_MMA(1, 0, At, B0); PG8_MMA(1, 1, At, B1); PG8_BAR; PG8_SCHED;
        }
        if (wr == 0) PG8_BAR;
        E(acc, cur, wr, wc, fr, fq);
        if (!has_next) break;
#pragma unroll
        for (int a = 0; a < 2; ++a)
#pragma unroll
            for (int b = 0; b < 2; ++b)
#pragma unroll
                for (int m = 0; m < 4; ++m)
#pragma unroll
                    for (int n = 0; n < 2; ++n) acc[a][b][m][n] = (f32x4){0.f, 0.f, 0.f, 0.f};
        cur = nxt; cA = nA; cB = nB; ++ui;
        if (wr == 1) PG8_BAR;
    }
    PG8_WAIT_V(0);
    PG8_BAR;
#undef PG8_SA
#undef PG8_SB
#undef PG8_STAGE
#undef PG8_LDA
#undef PG8_LDB
#undef PG8_MMA
#undef PG8_WAIT_V
#undef PG8_WAIT_L
#undef PG8_BAR
#undef PG8_SCHED
}
}

DI int map_row(int map, int n) {
    if (map == 1) { const int hd = n / 192, c = n - hd * 192; if (c >= 160) return hd * 192 + 128 + 2 * (c - 160) + 1; if (c >= 128) return hd * 192 + 128 + 2 * (c - 128); return n; }
    if (map == 2) return (n >> 2) * 8 + (n & 3);
    if (map == 3) return (n >> 2) * 8 + 4 + (n & 3);
    return n;
}
DI void transpose_item(const float* dW, const float* dks, bf16_t* dWT, int dK, int dN, int dNpad, int dldt, int dmap, LAS float* scr, int item, int lane) {
    const int nblk = dNpad / 32, kb = item / nblk, nb = item - kb * nblk, k0 = 64 * kb, n0 = 32 * nb;
    f32x4 ld[8];
#pragma unroll
    for (int i = 0; i < 8; ++i) {
        const int kk = 8 * i + (lane >> 3), k = k0 + kk, n = n0 + 4 * (lane & 7);
        ld[i] = (f32x4){0.f, 0.f, 0.f, 0.f};
        if (k < dK && n < dN) { ld[i] = *(const f32x4*)(dW + (size_t)k * dN + n); if (dks) ld[i] = ld[i] * dks[k]; }
    }
#pragma unroll
    for (int i = 0; i < 8; ++i) {
        const int kk = 8 * i + (lane >> 3); LAS float* d = scr + kk * 33 + 4 * (lane & 7);
        d[0] = ld[i].x; d[1] = ld[i].y; d[2] = ld[i].z; d[3] = ld[i].w;
    }
    LDS_WAIT();
    const int c = lane & 7;
#pragma unroll
    for (int j = 0; j < 4; ++j) {
        const int n = (lane >> 3) + 8 * j; const LAS float* s = scr + (8 * c) * 33 + n;
        u32x4 o; o.x = pk2(s[0 * 33], s[1 * 33]); o.y = pk2(s[2 * 33], s[3 * 33]); o.z = pk2(s[4 * 33], s[5 * 33]); o.w = pk2(s[6 * 33], s[7 * 33]);
        *(u32x4*)(dWT + (size_t)map_row(dmap, n0 + n) * dldt + k0 + 8 * c) = o;
    }
    LDS_WAIT();
}
DI void norm_row_bf16(const float* xrow, const float* g, bf16_t* orow, int lane) {
    const f32x4* xr = (const f32x4*)xrow + lane; f32x4 v[8]; float s = 0.f;
#pragma unroll
    for (int j = 0; j < 8; ++j) { v[j] = xr[64 * j]; s += (v[j].x * v[j].x + v[j].y * v[j].y) + (v[j].z * v[j].z + v[j].w * v[j].w); }
    s = wave_sum(s);
    const float rs = frsq(s * (1.0f / DM) + 1e-6f);
    const f32x4* gr = (const f32x4*)g + lane;
    u32x2* o8 = (u32x2*)orow + lane;
#pragma unroll
    for (int j = 0; j < 8; ++j) { const f32x4 gg = gr[64 * j]; u32x2 o; o.x = pk2(v[j].x * rs * gg.x, v[j].y * rs * gg.y); o.y = pk2(v[j].z * rs * gg.z, v[j].w * rs * gg.w); o8[64 * j] = o; }
}
DI void norm_row_f32_inplace(float* xrow, const float* g, int lane) {
    f32x4* xr = (f32x4*)xrow + lane; f32x4 v[8]; float s = 0.f;
#pragma unroll
    for (int j = 0; j < 8; ++j) { v[j] = xr[64 * j]; s += (v[j].x * v[j].x + v[j].y * v[j].y) + (v[j].z * v[j].z + v[j].w * v[j].w); }
    s = wave_sum(s);
    const float rs = frsq(s * (1.0f / DM) + 1e-6f);
    const f32x4* gr = (const f32x4*)g + lane;
#pragma unroll
    for (int j = 0; j < 8; ++j) { const f32x4 gg = gr[64 * j]; xr[64 * j] = v[j] * rs * gg; }
}
DI void sincos_acc(float angf, float& sn, float& cs) {
    const double x = (double)angf;
    const double n = rint(x * 0.15915494309189535);
    double r = fma(-n, 6.283185307179586, x); r = fma(-n, 2.4492935982947064e-16, r);
    const double r2 = r * r;
    double ts = r, ss = r, tc = 1.0, cc = 1.0;
    for (int k = 1; k <= 13; ++k) {
        ts *= -r2 / (double)((2 * k) * (2 * k + 1)); ss += ts;
        tc *= -r2 / (double)((2 * k - 1) * (2 * k)); cc += tc;
    }
    sn = (float)ss; cs = (float)cc;
}

DI void prologue(const Params& p, LAS unsigned char* lds, int tid, int lane, int wave) {
    unsigned char* ws = p.ws;
    const int gw = blockIdx.x * 8 + wave, NGW = gridDim.x * 8;
    LAS float* scr = (LAS float*)(lds + wave * 16384);
    constexpr int I0 = 32 * 88, I1 = I0 + 8 * 48, I2 = I1 + 4 * 32, I3 = I2 + 4 * 32, I4 = I3 + 32 * 64, I5 = I4 + 32 * 176, I6 = I5 + 32 * 176, I7 = I6 + 88 * 64,
                  I8 = I7 + 32 * 8, I9 = I8 + 32 * 8, I10 = I9 + 4 * 8, I11 = I10 + 4 * 8;
    typedef const float* cfp;
    LAS cfp* PTg = (LAS cfp*)(lds + 158208);
    if (tid == 0) { PTg[2] = p.in[2]; PTg[3] = p.in[3]; PTg[4] = p.in[4]; PTg[5] = p.in[5]; PTg[6] = p.in[6]; PTg[7] = p.in[7]; PTg[10] = p.in[10]; PTg[11] = p.in[11];
                    PTg[12] = p.in[12]; PTg[13] = p.in[13]; PTg[14] = p.in[14]; PTg[15] = p.in[15]; PTg[16] = p.in[16]; PTg[17] = p.in[17]; PTg[18] = p.in[18]; PTg[0] = nullptr; }
    __syncthreads();
    for (int it = gw; it < I11; it += NGW) {
        int ii, ksi, dK, dN, dNpad, dldt, dmap, i0; size_t off;
        if (it < I0)       { ii = 2;  ksi = 0;  off = OFF_WIN;  dK = 2048; dN = 2672; dNpad = 2816; dldt = 2048; dmap = 0; i0 = 0; }
        else if (it < I1)  { ii = 5;  ksi = 3;  off = OFF_WUQ;  dK = 512;  dN = 1536; dNpad = 1536; dldt = 512;  dmap = 1; i0 = I0; }
        else if (it < I2)  { ii = 6;  ksi = 4;  off = OFF_WK;   dK = 256;  dN = 1024; dNpad = 1024; dldt = 256;  dmap = 0; i0 = I1; }
        else if (it < I3)  { ii = 7;  ksi = 4;  off = OFF_WV;   dK = 256;  dN = 1024; dNpad = 1024; dldt = 256;  dmap = 0; i0 = I2; }
        else if (it < I4)  { ii = 14; ksi = 0;  off = OFF_WO;   dK = 2048; dN = 2048; dNpad = 2048; dldt = 2048; dmap = 0; i0 = I3; }
        else if (it < I5)  { ii = 16; ksi = 15; off = OFF_WGU;  dK = 2048; dN = 5632; dNpad = 5632; dldt = 2048; dmap = 2; i0 = I4; }
        else if (it < I6)  { ii = 17; ksi = 15; off = OFF_WGU;  dK = 2048; dN = 5632; dNpad = 5632; dldt = 2048; dmap = 3; i0 = I5; }
        else if (it < I7)  { ii = 18; ksi = 0;  off = OFF_WD;   dK = 5632; dN = 2048; dNpad = 2048; dldt = 5632; dmap = 0; i0 = I6; }
        else if (it < I8)  { ii = 10; ksi = 0;  off = OFF_WC1K; dK = 2048; dN = 128;  dNpad = 256;  dldt = 2048; dmap = 0; i0 = I7; }
        else if (it < I9)  { ii = 12; ksi = 0;  off = OFF_WC1V; dK = 2048; dN = 128;  dNpad = 256;  dldt = 2048; dmap = 0; i0 = I8; }
        else if (it < I10) { ii = 11; ksi = 0;  off = OFF_WC2K; dK = 128;  dN = 64;   dNpad = 256;  dldt = 256;  dmap = 0; i0 = I9; }
        else               { ii = 13; ksi = 0;  off = OFF_WC2V; dK = 128;  dN = 64;   dNpad = 256;  dldt = 256;  dmap = 0; i0 = I10; }
        transpose_item(PTg[ii], PTg[ksi], (bf16_t*)(ws + off), dK, dN, dNpad, dldt, dmap, scr, it - i0, lane);
    }
    bf16_t* HN = (bf16_t*)(ws + OFF_HN);
    for (int m = gw; m < T_; m += NGW) norm_row_bf16(p.in[0] + (size_t)m * DM, p.in[1], HN + (size_t)m * DM, lane);
    float* COS = (float*)(ws + OFF_COS); float* SIN = (float*)(ws + OFF_SIN);
    for (int idx = blockIdx.x * NTHREADS + tid; idx < S_ * 32; idx += gridDim.x * NTHREADS) {
        const int pos = idx >> 5, i = idx & 31;
        const float inv = exp2f(-(float)i * (13.287712379549449f / 32.0f));
        const float ang = (float)pos * inv;
        float sn, cs; sincos_acc(ang, sn, cs);
        COS[idx] = cs; SIN[idx] = sn;
    }
    float* BIAS = (float*)(ws + OFF_BIAS);
    if (gw < 256) {
        const int which = gw >> 7, j = gw & 127;
        const float* W = which ? p.in[12] : p.in[10]; const float* pe = which ? p.in[9] : p.in[8];
        float s = 0.f;
        for (int k = lane; k < 2048; k += 64) s += pe[k] * W[(size_t)k * 128 + j];
        s = wave_sum(s);
        if (lane == 0) { BIAS[which * 256 + j] = s; BIAS[which * 256 + 128 + j] = 0.f; }
    }
    { unsigned* ctl = (unsigned*)(ws + OFF_CTL); float* rowsq = (float*)(ws + OFF_ROWSQ);
      for (int i = blockIdx.x * NTHREADS + tid; i < T_; i += gridDim.x * NTHREADS) { rowsq[i] = 0.f; if (i < 1024) ctl[i] = 0u; } }
    if (blockIdx.x == 1 % gridDim.x) { unsigned* xb = (unsigned*)(ws + OFF_XBAR); for (int i = tid; i < 4096; i += NTHREADS) xb[i] = 0u; }
    if (blockIdx.x == 0) {
        bf16_t* KCg = (bf16_t*)(ws + OFF_KCG) + (size_t)8 * S_ * 64; bf16_t* VCg = (bf16_t*)(ws + OFF_VCG) + (size_t)8 * S_ * 64;
        for (int i = tid; i < 4096; i += NTHREADS) { KCg[i] = 0; VCg[i] = 0; }
    }
}

DI void postproj_tile(const Params& p, LAS unsigned char* lds, int tile, int tid, int lane, int wave) {
    unsigned char* ws = p.ws;
    const bf16_t* PROJ = (const bf16_t*)(ws + OFF_PROJ);
    const int tok0 = tile * 64, b = tok0 >> 13, s0 = tok0 & (S_ - 1);
    LAS bf16_t* tl = (LAS bf16_t*)lds;
#pragma unroll
    for (int i = 0; i < 4; ++i) {
        const int q = tid + 512 * i, mat = q >> 10, r = (q >> 4) & 63, ch = q & 15;
        const u32x4 v = *(const u32x4*)(PROJ + (size_t)(tok0 + r) * NPROJ + (mat ? 2496 : 2240) + 8 * ch);
        *(LAS u32x4*)(tl + (mat * 64 + r) * 136 + 8 * ch) = v;
    }
    __syncthreads();
    bf16_t* VST = (bf16_t*)(ws + OFF_VST); bf16_t* VWT = (bf16_t*)(ws + OFF_VWT);
#pragma unroll
    for (int i = 0; i < 4; ++i) {
        const int q = tid + 512 * i, mat = q >> 10, c = (q >> 3) & 127, j8 = q & 7;
        unsigned e[8];
#pragma unroll
        for (int k = 0; k < 8; ++k) e[k] = tl[(mat * 64 + 8 * j8 + k) * 136 + c];
        u32x4 o; o.x = e[0] | (e[1] << 16); o.y = e[2] | (e[3] << 16); o.z = e[4] | (e[5] << 16); o.w = e[6] | (e[7] << 16);
        const int g = c >> 6, d = c & 63;
        bf16_t* dst = (mat ? VWT : VST) + ((size_t)((b * 2 + g) * 64 + d)) * S_ + s0 + 8 * j8;
        *(u32x4*)dst = o;
    }
    float* RSQ = (float*)(ws + OFF_RSQ); float* RSKV = (float*)(ws + OFF_RSKV);
    const float* COS = (const float*)(ws + OFF_COS); const float* SIN = (const float*)(ws + OFF_SIN);
    bf16_t* KROPE = (bf16_t*)(ws + OFF_KROPE); bf16_t* KCg = (bf16_t*)(ws + OFF_KCG); bf16_t* VCg = (bf16_t*)(ws + OFF_VCG);
    for (int rr = 0; rr < 8; ++rr) {
        const int r = wave * 8 + rr, tok = tok0 + r, s = s0 + r;
        const bf16_t* pr = PROJ + (size_t)tok * NPROJ;
        const u32x4 a = *(const u32x4*)(pr + 8 * lane);
        float sq = 0.f;
        { float f; f = bflo(a.x); sq += f * f; f = bfhi(a.x); sq += f * f; f = bflo(a.y); sq += f * f; f = bfhi(a.y); sq += f * f;
          f = bflo(a.z); sq += f * f; f = bfhi(a.z); sq += f * f; f = bflo(a.w); sq += f * f; f = bfhi(a.w); sq += f * f; }
        sq = wave_sum(sq);
        const u32x2 c2 = *(const u32x2*)(pr + 512 + 4 * lane);
        float sk = 0.f;
        { float f; f = bflo(c2.x); sk += f * f; f = bfhi(c2.x); sk += f * f; f = bflo(c2.y); sk += f * f; f = bfhi(c2.y); sk += f * f; }
        sk = wave_sum(sk);
        if (lane == 0) { RSQ[tok] = frsq(sq * (1.0f / 512.0f) + 1e-6f); RSKV[tok] = frsq(sk * (1.0f / 256.0f) + 1e-6f); }
        if (lane < 32) {
            const float x1 = bf2f(pr[768 + lane]), x2 = bf2f(pr[800 + lane]);
            const float cs = COS[s * 32 + lane], sn = SIN[s * 32 + lane];
            *(unsigned*)(KROPE + (size_t)tok * 64 + 2 * lane) = pk2(x1 * cs - x2 * sn, x1 * sn + x2 * cs);
        }
        const int g = lane >> 5, d = (2 * lane) & 63;
        const unsigned kc2 = *(const unsigned*)(pr + 1856 + 2 * lane);
        *(unsigned*)(KCg + ((size_t)((b * 2 + g) * S_ + s)) * 64 + d) = kc2;
        const unsigned vc2 = *(const unsigned*)(pr + 1984 + 2 * lane);
        *(unsigned*)(VCg + ((size_t)((b * 2 + g) * S_ + s)) * 64 + d) = vc2;
    }
    __syncthreads();
}

constexpr int MLA_BUF = 43008;
DI void mla_load(const bf16_t* KNOPE, const bf16_t* KROPE, const bf16_t* VT, int h, size_t tokb, int kt, u32x4 (&r)[5], int tid) {
#pragma unroll
    for (int i = 0; i < 2; ++i) { const int q = tid + 512 * i, key = q >> 4, ch = q & 15;
        r[i] = *(const u32x4*)(KNOPE + (tokb + kt * 64 + key) * 1024 + h * 128 + 8 * ch); }
    { const int key = tid >> 3, ch = tid & 7; r[2] = *(const u32x4*)(KROPE + (tokb + kt * 64 + key) * 64 + 8 * ch); }
#pragma unroll
    for (int i = 0; i < 2; ++i) { const int q = tid + 512 * i, d = q >> 3, ch = q & 7;
        r[3 + i] = *(const u32x4*)(VT + (size_t)(h * 128 + d) * T_ + tokb + kt * 64 + 8 * ch); }
}
DI void mla_store(LAS unsigned char* buf, const u32x4 (&r)[5], int tid) {
#pragma unroll
    for (int i = 0; i < 2; ++i) { const int q = tid + 512 * i, key = q >> 4, ch = q & 15; *(LAS u32x4*)(buf + key * 400 + ch * 16) = r[i]; }
    { const int key = tid >> 3, ch = tid & 7; *(LAS u32x4*)(buf + key * 400 + 256 + ch * 16) = r[2]; }
#pragma unroll
    for (int i = 0; i < 2; ++i) { const int q = tid + 512 * i, d = q >> 3, ch = q & 7; LAS unsigned char* vp = buf + 25600 + d * 136 + ch * 16;
        *(LAS u32x2*)vp = (u32x2){r[3 + i].x, r[3 + i].y}; *(LAS u32x2*)(vp + 8) = (u32x2){r[3 + i].z, r[3 + i].w}; }
}
DI bf16x8 cat4(bf16x4 lo, bf16x4 hi) { bf16x8 r; r[0] = lo[0]; r[1] = lo[1]; r[2] = lo[2]; r[3] = lo[3]; r[4] = hi[0]; r[5] = hi[1]; r[6] = hi[2]; r[7] = hi[3]; return r; }
DI bf16x8 packp(const f32x16& s, int t) {
    u32x4 w;
    if (t == 0) { w.x = pk2(s[0], s[1]); w.y = pk2(s[2], s[3]); w.z = pk2(s[4], s[5]); w.w = pk2(s[6], s[7]); }
    else { w.x = pk2(s[8], s[9]); w.y = pk2(s[10], s[11]); w.z = pk2(s[12], s[13]); w.w = pk2(s[14], s[15]); }
    return __builtin_bit_cast(bf16x8, w);
}

DI float vmax3(float a, float b, float c) { float r; asm("v_max3_f32 %0, %1, %2, %3" : "=v"(r) : "v"(a), "v"(b), "v"(c)); return r; }
DI float max16(const f32x16& s) {
    float a = vmax3(s[0], s[1], s[2]), b = vmax3(s[3], s[4], s[5]), c = vmax3(s[6], s[7], s[8]), d = vmax3(s[9], s[10], s[11]);
    a = vmax3(a, s[12], s[13]); b = vmax3(b, s[14], s[15]);
    return vmax3(vmax3(a, b, c), d, d);
}
DI void mla_unit(const Params& p, LAS unsigned char* lds, int b, int h, int qb, int tid) {
    unsigned char* ws = p.ws;
    const bf16_t* QMLA = (const bf16_t*)(ws + OFF_QMLA); const bf16_t* KNOPE = (const bf16_t*)(ws + OFF_KNOPE);
    const bf16_t* KROPE = (const bf16_t*)(ws + OFF_KROPE); const bf16_t* VT = (const bf16_t*)(ws + OFF_VT);
    bf16_t* MIX = (bf16_t*)(ws + OFF_MIX);
    const int lane = tid & 63, w = __builtin_amdgcn_readfirstlane(tid >> 6), c = lane & 31, hi = lane >> 5;
    const int q0 = qb * 256, qw0 = q0 + 32 * w, qpos = qw0 + c;
    const size_t tokb = (size_t)b * S_;
    bf16x8 qf[12];
    { const bf16_t* qp = QMLA + (tokb + qpos) * 1536 + h * 192 + 8 * hi;
#pragma unroll
      for (int st = 0; st < 12; ++st) qf[st] = *(const bf16x8*)(qp + 16 * st); }
    f32x16 o[4];
#pragma unroll
    for (int db = 0; db < 4; ++db)
#pragma unroll
        for (int i = 0; i < 16; ++i) o[db][i] = 0.f;
    float m = -1e20f, l = 0.f;
    const int nkt = 4 * qb + 4;
    u32x4 r[5];
    __syncthreads();
    mla_load(KNOPE, KROPE, VT, h, tokb, 0, r, tid); mla_store(lds, r, tid);
    __syncthreads();
    for (int kt = 0; kt < nkt; ++kt) {
        const bool more = kt + 1 < nkt;
        if (more) mla_load(KNOPE, KROPE, VT, h, tokb, kt + 1, r, tid);
        LAS const unsigned char* buf = lds + (kt & 1) * MLA_BUF;
        if (kt * 64 <= qw0 + 31) {
#pragma unroll
            for (int sub = 0; sub < 2; ++sub) {
                const int kbase = kt * 64 + 32 * sub;
                f32x16 s;
#pragma unroll
                for (int i = 0; i < 16; ++i) s[i] = 0.f;
#pragma unroll
                for (int st = 0; st < 12; ++st) {
                    const bf16x8 a = *(LAS const bf16x8*)(buf + (32 * sub + c) * 400 + st * 32 + hi * 16);
                    s = MFMA32(a, qf[st], s);
                }
                if (kbase + 31 > qw0) {
                    int dbase = qpos - kbase - 4 * hi;
                    asm volatile("" : "+v"(dbase));
#pragma unroll
                    for (int i = 0; i < 16; ++i) if ((dbase - ((i & 3) + 8 * (i >> 2))) < 0) s[i] = -1e30f;
                }
                float mx = max16(s);
                mx = xhalf_max(mx);
                const float mn = (mx > m + 8.f) ? mx : m, alpha = fexp2(m - mn); m = mn; l *= alpha;
                if (__any(alpha != 1.f)) {
#pragma unroll
                    for (int db = 0; db < 4; ++db) o[db] = o[db] * alpha;
                }
                float ps = 0.f;
#pragma unroll
                for (int i = 0; i < 16; ++i) { const float pv = fexp2(s[i] - m); s[i] = pv; ps += pv; }
                l += ps;
                const bf16x8 pb0 = packp(s, 0), pb1 = packp(s, 1);
#pragma unroll
                for (int db = 0; db < 4; ++db) {
                    LAS const unsigned char* ap = buf + 25600 + (32 * db + c) * 136 + (32 * sub + 4 * hi) * 2;
                    const bf16x8 v0 = cat4(*(LAS const bf16x4*)(ap), *(LAS const bf16x4*)(ap + 16));
                    const bf16x8 v1 = cat4(*(LAS const bf16x4*)(ap + 32), *(LAS const bf16x4*)(ap + 48));
                    o[db] = MFMA32(v0, pb0, o[db]); o[db] = MFMA32(v1, pb1, o[db]);
                }
            }
        }
        if (more) mla_store(lds + ((kt + 1) & 1) * MLA_BUF, r, tid);
        __syncthreads();
    }
    const float lt = xhalf_sum(l), inv = frcp(lt);
    bf16_t* op = MIX + (tokb + qpos) * 2048 + h * 128 + 4 * hi;
#pragma unroll
    for (int db = 0; db < 4; ++db)
#pragma unroll
        for (int g4 = 0; g4 < 4; ++g4) {
            u32x2 wv; wv.x = pk2(o[db][4 * g4] * inv, o[db][4 * g4 + 1] * inv); wv.y = pk2(o[db][4 * g4 + 2] * inv, o[db][4 * g4 + 3] * inv);
            *(u32x2*)(op + 32 * db + 8 * g4) = wv;
        }
}

constexpr int NSA_KC = 0, NSA_VCT = 73728, NSA_IMP = 140288, NSA_SEL = 156672, NSA_UNI = 157184, NSA_NL = 157200, NSA_LIST = 157216;
constexpr int NSA_TBUF = 17920;

template <int MODE>
DI void nsa_tile(LAS const unsigned char* buf, const bf16x8 (&qf)[4], f32x16 (&o)[2], float& m, float& l, int kbase0, int t, bool lanesel, float slope2, int c, int hi) {
#pragma unroll
    for (int sub = 0; sub < 2; ++sub) {
        const int klo = kbase0 + 32 * sub;
        bool full, none;
        if (MODE == 0) { full = lanesel && (klo + 31 <= t); none = !lanesel || (klo > t); }
        else { full = (klo + 31 <= t) && (klo >= t - 511); none = (klo > t) || (klo + 31 < t - 511); }
        if (__all(none)) continue;
        int dbase = t - klo - 4 * hi;
        asm volatile("" : "+v"(dbase));
        const float b0 = none ? -1e30f : -slope2 * (float)dbase;
        f32x16 s;
#pragma unroll
        for (int i = 0; i < 16; ++i) s[i] = fmaf(slope2, (float)((i & 3) + 8 * (i >> 2)), b0);
#pragma unroll
        for (int st = 0; st < 4; ++st) {
            const bf16x8 a = *(LAS const bf16x8*)(buf + (32 * sub + c) * 144 + st * 32 + hi * 16);
            s = MFMA32(a, qf[st], s);
        }
        if (__any(!full && !none)) {
#pragma unroll
            for (int i = 0; i < 16; ++i) {
                const int dist = dbase - ((i & 3) + 8 * (i >> 2));
                const bool valid = (MODE == 0) ? (lanesel && dist >= 0) : ((unsigned)dist < 512u);
                if (!valid) s[i] = -1e30f;
            }
        }
        float mx = max16(s);
        mx = xhalf_max(mx);
        if (__any(mx > m + 8.f)) {
            const float mn = fmaxf(m, mx), alpha = fexp2(m - mn); m = mn; l *= alpha;
            o[0] = o[0] * alpha; o[1] = o[1] * alpha;
        }
        float ps = 0.f;
#pragma unroll
        for (int i = 0; i < 16; ++i) { const float pv = fexp2(s[i] - m); s[i] = pv; ps += pv; }
        l += ps;
        const bf16x8 pb0 = packp(s, 0), pb1 = packp(s, 1);
#pragma unroll
        for (int db = 0; db < 2; ++db)
#pragma unroll
            for (int tt = 0; tt < 2; ++tt) {
                LAS const unsigned char* ap = buf + 9216 + (32 * db + c) * 136 + (32 * sub + 16 * tt + 4 * hi) * 2;
                const bf16x8 a = cat4(*(LAS const bf16x4*)ap, *(LAS const bf16x4*)(ap + 16));
                o[db] = MFMA32(a, tt == 0 ? pb0 : pb1, o[db]);
            }
    }
}

DI void nsa_unit(const Params& p, LAS unsigned char* lds, unsigned char* ldsg, int bg, int qt, int tid) {
    unsigned char* ws = p.ws;
    const bf16_t* PROJ = (const bf16_t*)(ws + OFF_PROJ);
    const bf16_t* KC = (const bf16_t*)(ws + OFF_KC); const bf16_t* VCT = (const bf16_t*)(ws + OFF_VCT);
    const bf16_t* VST = (const bf16_t*)(ws + OFF_VST); const bf16_t* VWT = (const bf16_t*)(ws + OFF_VWT);
    bf16_t* MIX = (bf16_t*)(ws + OFF_MIX);
    const int lane = tid & 63, w = __builtin_amdgcn_readfirstlane(tid >> 6), c = lane & 31, hi = lane >> 5;
    const int b = bg >> 1, g = bg & 1, q0 = qt * 32;
    const int head = c & 7, qi = c >> 3, tw0 = q0 + 4 * w, t = tw0 + qi, hh = g * 8 + head;
    const size_t tokb = (size_t)b * S_, tok = tokb + t;
    const float sc2 = 0.125f * LOG2E, slope2 = exp2f(-0.5f * (float)(hh + 1)) * LOG2E;

    LAS unsigned* SEL = (LAS unsigned*)(lds + NSA_SEL);
    LAS unsigned* UNI = (LAS unsigned*)(lds + NSA_UNI);
    LAS int* NL = (LAS int*)(lds + NSA_NL);
    LAS int* LIST = (LAS int*)(lds + NSA_LIST);
    LAS float* IMPw = (LAS float*)(lds + NSA_IMP + w * 2048);

    __syncthreads();
    const int nct = (q0 / 16 + 1 + 31) >> 5;
    for (int q0_ = tid; q0_ < nct * 256; q0_ += 4 * NTHREADS) {
        u32x4 v[4];
#pragma unroll
        for (int j = 0; j < 4; ++j) { const int q = q0_ + j * NTHREADS; if (q < nct * 256) v[j] = *(const u32x4*)(KC + ((size_t)(bg * 512 + (q >> 3))) * 64 + 8 * (q & 7)); }
#pragma unroll
        for (int j = 0; j < 4; ++j) { const int q = q0_ + j * NTHREADS; if (q < nct * 256) *(LAS u32x4*)(lds + NSA_KC + (q >> 3) * 144 + (q & 7) * 16) = v[j]; }
    }
    { const int cpr = nct * 4;
      for (int q0_ = tid; q0_ < 64 * cpr; q0_ += 4 * NTHREADS) {
          u32x4 v[4];
#pragma unroll
          for (int j = 0; j < 4; ++j) { const int q = q0_ + j * NTHREADS; if (q < 64 * cpr) { const int d = q / cpr, ch = q - d * cpr; v[j] = *(const u32x4*)(VCT + ((size_t)(bg * 64 + d)) * 512 + 8 * ch); } }
#pragma unroll
          for (int j = 0; j < 4; ++j) { const int q = q0_ + j * NTHREADS; if (q < 64 * cpr) { const int d = q / cpr, ch = q - d * cpr; LAS unsigned char* vp_ = lds + NSA_VCT + d * 1032 + ch * 16; *(LAS u32x2*)vp_ = (u32x2){v[j].x, v[j].y}; *(LAS u32x2*)(vp_ + 8) = (u32x2){v[j].z, v[j].w}; } }
      } }
    if (tid < 4) UNI[tid] = 0u;

    bf16x8 qf[4];
    { const bf16_t* qp = PROJ + tok * NPROJ + 832 + hh * 64 + 8 * hi;
#pragma unroll
      for (int st = 0; st < 4; ++st) {
          const u32x4 raw = *(const u32x4*)(qp + 16 * st); u32x4 sc;
          sc.x = pk2(bflo(raw.x) * sc2, bfhi(raw.x) * sc2); sc.y = pk2(bflo(raw.y) * sc2, bfhi(raw.y) * sc2);
          sc.z = pk2(bflo(raw.z) * sc2, bfhi(raw.z) * sc2); sc.w = pk2(bflo(raw.w) * sc2, bfhi(raw.w) * sc2);
          qf[st] = __builtin_bit_cast(bf16x8, sc); } }
    const bf16_t* gp = PROJ + tok * NPROJ + 2624 + hh * 3;
    const float gate_c = fsigmoid(bf2f(gp[0])), gate_s = fsigmoid(bf2f(gp[1])), gate_w = fsigmoid(bf2f(gp[2]));
    __syncthreads();

    f32x16 out[2];
    {
        const int cwm = (tw0 + 3 >= 31) ? ((tw0 + 3 - 31) >> 4) : -1;
        const int ntw = (cwm >= 0) ? (cwm >> 5) + 1 : 0;
        const float slope16 = 16.f * slope2;
        float m1 = -1e20f, l1 = 0.f;
        for (int tile = 0; tile < ntw; ++tile) {
            int dbase = t - 31 - 512 * tile - 64 * hi;
            asm volatile("" : "+v"(dbase));
            const float b0 = -slope2 * (float)dbase;
            f32x16 s;
#pragma unroll
            for (int i = 0; i < 16; ++i) s[i] = fmaf(slope16, (float)((i & 3) + 8 * (i >> 2)), b0);
#pragma unroll
            for (int st = 0; st < 4; ++st) {
                const bf16x8 a = *(LAS const bf16x8*)(lds + NSA_KC + (32 * tile + c) * 144 + st * 32 + hi * 16);
                s = MFMA32(a, qf[st], s);
            }
            if (512 * tile + 496 + 31 > tw0) {
#pragma unroll
                for (int i = 0; i < 16; ++i) if ((dbase - 16 * ((i & 3) + 8 * (i >> 2))) < 0) s[i] = -1e30f;
            }
            const float mn = fmaxf(m1, max16(s));
            float ps = 0.f;
#pragma unroll
            for (int i = 0; i < 16; ++i) ps += fexp2(s[i] - mn);
            l1 = l1 * fexp2(m1 - mn) + ps; m1 = mn;
        }
        const float mo = xhalf_partner(m1, hi), lo = xhalf_partner(l1, hi);
        const float M = fmaxf(m1, mo), L = l1 * fexp2(m1 - M) + lo * fexp2(mo - M);
        const float Moff = (L > 0.f) ? (M + __log2f(L)) : 1e30f;
#pragma unroll
        for (int i = 0; i < 8; ++i) IMPw[lane + 64 * i] = 0.f;
        LDS_WAIT();
        f32x16 oc[2];
#pragma unroll
        for (int db = 0; db < 2; ++db)
#pragma unroll
            for (int i = 0; i < 16; ++i) oc[db][i] = 0.f;
        float prev3 = 0.f;
        for (int tile = 0; tile < ntw; ++tile) {
            int dbase = t - 31 - 512 * tile - 64 * hi;
            asm volatile("" : "+v"(dbase));
            const float b0 = -slope2 * (float)dbase;
            f32x16 s;
#pragma unroll
            for (int i = 0; i < 16; ++i) s[i] = fmaf(slope16, (float)((i & 3) + 8 * (i >> 2)), b0);
#pragma unroll
            for (int st = 0; st < 4; ++st) {
                const bf16x8 a = *(LAS const bf16x8*)(lds + NSA_KC + (32 * tile + c) * 144 + st * 32 + hi * 16);
                s = MFMA32(a, qf[st], s);
            }
            if (512 * tile + 496 + 31 > tw0) {
#pragma unroll
                for (int i = 0; i < 16; ++i) if ((dbase - 16 * ((i & 3) + 8 * (i >> 2))) < 0) s[i] = -1e30f;
            }
#pragma unroll
            for (int i = 0; i < 16; ++i) s[i] = fexp2(s[i] - Moff);
            float pp[4];
#pragma unroll
            for (int r = 0; r < 4; ++r) pp[r] = xhalf_partner(s[4 * r + 3], hi);
#pragma unroll
            for (int r = 0; r < 4; ++r) {
                const float a = 2.f * (s[4 * r] + s[4 * r + 1] + s[4 * r + 2]) + s[4 * r + 3];
                const float cin = hi ? pp[r] : (r > 0 ? pp[r > 0 ? r - 1 : 0] : prev3);
                float v = a + cin;
                v = sum8(v);
                if (head == 0) IMPw[qi * 128 + 8 * tile + 2 * r + hi] = v;
            }
            prev3 = pp[3];
            const bf16x8 pb0 = packp(s, 0), pb1 = packp(s, 1);
#pragma unroll
            for (int db = 0; db < 2; ++db)
#pragma unroll
                for (int tt = 0; tt < 2; ++tt) {
                    LAS const unsigned char* ap = lds + NSA_VCT + (32 * db + c) * 1032 + (32 * tile + 16 * tt + 4 * hi) * 2;
                    const bf16x8 a = cat4(*(LAS const bf16x4*)ap, *(LAS const bf16x4*)(ap + 16));
                    oc[db] = MFMA32(a, tt == 0 ? pb0 : pb1, oc[db]);
                }
        }
        out[0] = oc[0] * gate_c; out[1] = oc[1] * gate_c;
        LDS_WAIT();
        for (int qi2 = 0; qi2 < 4; ++qi2) {
            const int t2 = tw0 + qi2, blk = t2 >> 6;
            LAS unsigned* kp = (LAS unsigned*)(IMPw + qi2 * 128);
            const int n0 = lane, n1 = lane + 64;
            const unsigned b0 = kp[n0], b1 = kp[n1];
            const bool f0 = (n0 == 0) || (n0 == blk) || (n0 == blk - 1), f1 = (n1 == blk) || (n1 == blk - 1);
            const unsigned k0 = (n0 <= blk) ? ((((f0 ? 0x461C4000u : b0)) & 0xFFFFFF80u) | (unsigned)(127 - n0)) : 0u;
            const unsigned k1 = (n1 <= blk) ? ((((f1 ? 0x461C4000u : b1)) & 0xFFFFFF80u) | (unsigned)(127 - n1)) : 0u;
            unsigned T = 0u;
#pragma unroll 1
            for (int bit = 30; bit >= 0; --bit) {
                const unsigned cand = T | (1u << bit);
                const int cnt = __popcll(__ballot(k0 >= cand)) + __popcll(__ballot(k1 >= cand));
                if (cnt >= 16) T = cand;
            }
            const bool s0 = (k0 != 0u) && (k0 >= T), s1 = (k1 != 0u) && (k1 >= T);
            const unsigned long long m0 = __ballot(s0), m1b = __ballot(s1);
            if (lane == 0) {
                const unsigned w0 = (unsigned)m0, w1 = (unsigned)(m0 >> 32), w2 = (unsigned)m1b, w3 = (unsigned)(m1b >> 32);
                LAS unsigned* sp = SEL + (4 * w + qi2) * 4;
                sp[0] = w0; sp[1] = w1; sp[2] = w2; sp[3] = w3;
                unsigned* ug = (unsigned*)(ldsg + NSA_UNI);
                atomicOr(ug + 0, w0); atomicOr(ug + 1, w1); atomicOr(ug + 2, w2); atomicOr(ug + 3, w3);
            }
        }
    }
    __syncthreads();
    if (tid == 0) {
        int cnt = 0;
        for (int wd = 0; wd < 4; ++wd) { unsigned bits = UNI[wd]; while (bits) { const int nb = 32 * wd + __builtin_ctz(bits); bits &= bits - 1; LIST[cnt++] = nb; } }
        NL[0] = cnt;
    }
    __syncthreads();
    const int kq = tid >> 3, kch = tid & 7;
    const int toff = kq * 144 + kch * 16, voff = 9216 + kq * 136 + kch * 16;
#define ST_V(base, v) do { LAS unsigned char* vp_ = (base) + voff; *(LAS u32x2*)vp_ = (u32x2){(v).x, (v).y}; *(LAS u32x2*)(vp_ + 8) = (u32x2){(v).z, (v).w}; } while (0)
    {
        const int nl = NL[0];
        const bf16_t* Ksrc = PROJ + (tokb + kq) * NPROJ + 2112 + g * 64 + 8 * kch;
        const bf16_t* Vsrc = VST + ((size_t)(bg * 64 + kq)) * S_ + 8 * kch;
        f32x16 o[2];
#pragma unroll
        for (int db = 0; db < 2; ++db)
#pragma unroll
            for (int i = 0; i < 16; ++i) o[db][i] = 0.f;
        float m = -1e20f, l = 0.f;
        u32x4 rk1, rv1, rk2, rv2;
        { const int nb = LIST[0]; rk1 = *(const u32x4*)(Ksrc + (size_t)(64 * nb) * NPROJ); rv1 = *(const u32x4*)(Vsrc + 64 * nb); }
        *(LAS u32x4*)(lds + toff) = rk1; ST_V(lds, rv1);
        if (nl > 1) { const int nb = LIST[1]; rk1 = *(const u32x4*)(Ksrc + (size_t)(64 * nb) * NPROJ); rv1 = *(const u32x4*)(Vsrc + 64 * nb); }
        __syncthreads();
        int cb = 0;
        for (int i = 0; i < nl; ++i) {
            const int nb = LIST[i];
            if (i + 2 < nl) { const int nb2 = LIST[i + 2]; rk2 = *(const u32x4*)(Ksrc + (size_t)(64 * nb2) * NPROJ); rv2 = *(const u32x4*)(Vsrc + 64 * nb2); }
            const bool lanesel = (SEL[(4 * w + qi) * 4 + (nb >> 5)] >> (nb & 31)) & 1u;
            if (__any(lanesel))
                nsa_tile<0>(lds + cb * NSA_TBUF, qf, o, m, l, 64 * nb, t, lanesel, slope2, c, hi);
            const int nbuf = (cb == 2) ? 0 : cb + 1;
            if (i + 1 < nl) { *(LAS u32x4*)(lds + nbuf * NSA_TBUF + toff) = rk1; ST_V(lds + nbuf * NSA_TBUF, rv1); }
            rk1 = rk2; rv1 = rv2; cb = nbuf;
            __syncthreads();
        }
        const float lt = xhalf_sum(l), sc = gate_s * frcp(lt);
        out[0] = out[0] + o[0] * sc; out[1] = out[1] + o[1] * sc;
    }
    {
        const int lo_key = (q0 - 511 > 0) ? (q0 - 511) : 0;
        const int kt_lo = lo_key >> 6, kt_hi = (q0 + 31) >> 6;
        const bf16_t* Ksrc = PROJ + (tokb + kq) * NPROJ + 2368 + g * 64 + 8 * kch;
        const bf16_t* Vsrc = VWT + ((size_t)(bg * 64 + kq)) * S_ + 8 * kch;
        f32x16 o[2];
#pragma unroll
        for (int db = 0; db < 2; ++db)
#pragma unroll
            for (int i = 0; i < 16; ++i) o[db][i] = 0.f;
        float m = -1e20f, l = 0.f;
        u32x4 rk1, rv1, rk2, rv2;
        rk1 = *(const u32x4*)(Ksrc + (size_t)(64 * kt_lo) * NPROJ); rv1 = *(const u32x4*)(Vsrc + 64 * kt_lo);
        *(LAS u32x4*)(lds + toff) = rk1; ST_V(lds, rv1);
        if (kt_lo < kt_hi) { rk1 = *(const u32x4*)(Ksrc + (size_t)(64 * (kt_lo + 1)) * NPROJ); rv1 = *(const u32x4*)(Vsrc + 64 * (kt_lo + 1)); }
        __syncthreads();
        int cb = 0;
        for (int kt = kt_lo; kt <= kt_hi; ++kt) {
            if (kt + 2 <= kt_hi) { rk2 = *(const u32x4*)(Ksrc + (size_t)(64 * (kt + 2)) * NPROJ); rv2 = *(const u32x4*)(Vsrc + 64 * (kt + 2)); }
            if (!(64 * kt + 63 < tw0 - 511 || 64 * kt > tw0 + 3))
                nsa_tile<1>(lds + cb * NSA_TBUF, qf, o, m, l, 64 * kt, t, true, slope2, c, hi);
            const int nbuf = (cb == 2) ? 0 : cb + 1;
            if (kt < kt_hi) { *(LAS u32x4*)(lds + nbuf * NSA_TBUF + toff) = rk1; ST_V(lds + nbuf * NSA_TBUF, rv1); }
            rk1 = rk2; rv1 = rv2; cb = nbuf;
            __syncthreads();
        }
        const float lt = xhalf_sum(l), sc = gate_w * frcp(lt);
        out[0] = out[0] + o[0] * sc; out[1] = out[1] + o[1] * sc;
    }
    bf16_t* op = MIX + tok * 2048 + 1024 + hh * 64 + 4 * hi;
#pragma unroll
    for (int db = 0; db < 2; ++db)
#pragma unroll
        for (int g4 = 0; g4 < 4; ++g4) {
            u32x2 wv; wv.x = pk2(out[db][4 * g4], out[db][4 * g4 + 1]); wv.y = pk2(out[db][4 * g4 + 2], out[db][4 * g4 + 3]);
            *(u32x2*)(op + 32 * db + 8 * g4) = wv;
        }
}

#define XB_TMO      128
#define XB_XCNT(j)  (256  + 64 * (j))
#define XB_XSUB(j)  (1280 + 64 * (j))
#define XB_XGEN(j)  (2304 + 64 * (j))
#define XB_TOP      3328
#define XB_TOPGEN   3392
#define XB_SPIN_CAP (1u << 18)
DI unsigned xb_ld(unsigned* p)              { return __hip_atomic_load(p, __ATOMIC_RELAXED, __HIP_MEMORY_SCOPE_AGENT); }
DI unsigned xb_add(unsigned* p, unsigned v) { return __hip_atomic_fetch_add(p, v, __ATOMIC_RELAXED, __HIP_MEMORY_SCOPE_AGENT); }
DI unsigned xb_xcc_id() { return (unsigned)__builtin_amdgcn_s_getreg((3 << 11) | 20) & 0xFu; }
#define XB_SPIN(cond, bar) do { unsigned _sp = 0; while (cond) { __builtin_amdgcn_s_sleep(1); \
    if ((++_sp & 255u) == 0u) { if (xb_ld(&(bar)[XB_TMO])) break; if (_sp > XB_SPIN_CAP) { atomicAdd(&(bar)[XB_TMO], 1u); break; } } } } while (0)
DI void xcd_barrier_complete(unsigned* bar, unsigned x, unsigned& nloc, unsigned& nx) {
    const unsigned G = gridDim.x * gridDim.y * gridDim.z;
    unsigned sum, cnt, mine, sp = 0u;
    for (;;) {
        sum = 0u; cnt = 0u; mine = 0u;
#pragma unroll
        for (unsigned j = 0; j < 16; ++j) { const unsigned c = xb_ld(&bar[XB_XCNT(j)]); sum += c; cnt += (c > 0u) ? 1u : 0u; mine = (j == x) ? c : mine; }
        if (sum == G) break;
        __builtin_amdgcn_s_sleep(1);
        if ((++sp & 255u) == 0u) { if (xb_ld(&bar[XB_TMO])) break; if (sp > XB_SPIN_CAP) { atomicAdd(&bar[XB_TMO], 1u); break; } }
    }
    nloc = mine > 0u ? mine : 1u; nx = cnt > 0u ? cnt : 1u;
}
DI void xcd_barrier(unsigned* bar, unsigned x, volatile LAS unsigned* st) {
    asm volatile("s_waitcnt vmcnt(0)" ::: "memory");
    __syncthreads();
    if (threadIdx.x == 0) {
        __builtin_amdgcn_s_waitcnt(0);
        unsigned nloc = st[0], nx = st[1];
        if (nloc == 0u) { xcd_barrier_complete(bar, x, nloc, nx); st[0] = nloc; st[1] = nx; }
        const unsigned old = xb_add(&bar[XB_XSUB(x)], 1u);
        const unsigned gen = old / nloc;
        if (old + 1u == (gen + 1u) * nloc) {
            __builtin_amdgcn_fence(__ATOMIC_RELEASE, "agent");
            asm volatile("s_waitcnt vmcnt(0)" ::: "memory");
            const unsigned og = xb_add(&bar[XB_TOP], 1u);
            const unsigned tg = og / nx;
            if (og + 1u == (tg + 1u) * nx) xb_add(&bar[XB_TOPGEN], 1u);
            else XB_SPIN(xb_ld(&bar[XB_TOPGEN]) == tg, bar);
            __builtin_amdgcn_fence(__ATOMIC_ACQUIRE, "agent");
            xb_add(&bar[XB_XGEN(x)], 1u);
            asm volatile("s_waitcnt vmcnt(0)" ::: "memory");
        } else {
            XB_SPIN(xb_ld(&bar[XB_XGEN(x)]) == gen, bar);
            __builtin_amdgcn_fence(__ATOMIC_ACQUIRE, "agent");
            asm volatile("s_waitcnt vmcnt(0)" ::: "memory");
        }
    }
    __syncthreads();
}
__global__ void __launch_bounds__(NTHREADS, 2) fwd_megakernel(Params p) {
    extern __shared__ __attribute__((aligned(16))) unsigned char dyn_lds[];
    cg::grid_group grid = cg::this_grid();
    LAS unsigned char* lds = (LAS unsigned char*)dyn_lds;
    const int G = gridDim.x, bid = blockIdx.x;
    volatile LAS unsigned* xst = (volatile LAS unsigned*)(lds + 158688);
    if (threadIdx.x < 2) xst[threadIdx.x] = 0u;
    __syncthreads();
    unsigned* xbar = (unsigned*)(p.ws + OFF_XBAR);
    const unsigned xcc = xb_xcc_id();
#define PHASE_IDS const int tid = fresh_tid(), lane = tid & 63, wave = __builtin_amdgcn_readfirstlane(tid >> 6); (void)lane; (void)wave
    unsigned char* ws = p.ws;
    bf16_t* HN = (bf16_t*)(ws + OFF_HN); bf16_t* PROJ = (bf16_t*)(ws + OFF_PROJ);
    const float* RSQ = (const float*)(ws + OFF_RSQ); const float* RSKV = (const float*)(ws + OFF_RSKV);
    const float* BIAS = (const float*)(ws + OFF_BIAS);
    using pg8::Gemm; using pg8::Epi; using pg8::StaticOrder;

    for (int rep = 0; rep < REP_P0; ++rep) { PHASE_IDS; prologue(p, lds, tid, lane, wave); }
    grid.sync();
    if (threadIdx.x == 0) (void)xb_add(&xbar[XB_XCNT(xcc)], 1u);
    {
        Gemm g{HN, (const bf16_t*)(ws + OFF_WIN), T_, NPROJ, DM, DM, DM}; StaticOrder S; S.init(T_, NPROJ, G, bid);
        Epi E{pg8::EPI_STORE, PROJ, NPROJ, NPROJ, nullptr, 1.f, nullptr, nullptr, nullptr, nullptr, nullptr, nullptr};
        for (int rep = 0; rep < REP_P1; ++rep) pg8::gemm_phase(lds, g, S, E);
    }
    xcd_barrier(xbar, xcc, xst);
    { PHASE_IDS; for (int tile = bid; tile < T_ / 64; tile += G) postproj_tile(p, lds, tile, tid, lane, wave); }
    xcd_barrier(xbar, xcc, xst);
    {
        { Gemm g{PROJ, (const bf16_t*)(ws + OFF_WUQ), T_, 1536, 512, NPROJ, 512}; StaticOrder S; S.init(T_, 1536, G, bid);
          Epi E{pg8::EPI_Q, (bf16_t*)(ws + OFF_QMLA), 1536, 1536, RSQ, 0.07216878364870322f * LOG2E, (const float*)(ws + OFF_COS), (const float*)(ws + OFF_SIN), nullptr, nullptr, nullptr, nullptr};
          pg8::gemm_phase(lds, g, S, E); }
        { Gemm g{PROJ + 512, (const bf16_t*)(ws + OFF_WK), T_, 1024, 256, NPROJ, 256}; StaticOrder S; S.init(T_, 1024, G, bid);
          Epi E{pg8::EPI_STORE, (bf16_t*)(ws + OFF_KNOPE), 1024, 1024, RSKV, 1.f, nullptr, nullptr, nullptr, nullptr, nullptr, nullptr};
          pg8::gemm_phase(lds, g, S, E); }
        { Gemm g{(const bf16_t*)(ws + OFF_WV), PROJ + 512, 1024, T_, 256, 256, NPROJ}; StaticOrder S; S.init(1024, T_, G, bid);
          Epi E{pg8::EPI_VT, (bf16_t*)(ws + OFF_VT), T_, T_, RSKV, 1.f, nullptr, nullptr, nullptr, nullptr, nullptr, nullptr};
          pg8::gemm_phase(lds, g, S, E); }
    }
    xcd_barrier(xbar, xcc, xst);
    if (bid < 16) {
        StaticOrder S; S.init(4096, 256, 16, bid);
        { Gemm g{(const bf16_t*)(ws + OFF_KCG), (const bf16_t*)(ws + OFF_WC1K), 4096, 256, 2048, 1024, 2048};
          Epi E{pg8::EPI_SILU, (bf16_t*)(ws + OFF_HIDK), 256, 256, nullptr, 1.f, nullptr, nullptr, BIAS, nullptr, nullptr, nullptr};
          pg8::gemm_phase(lds, g, S, E); }
        __threadfence(); __syncthreads();
        { Gemm g{(const bf16_t*)(ws + OFF_HIDK), (const bf16_t*)(ws + OFF_WC2K), 4096, 256, 256, 256, 256};
          Epi E{pg8::EPI_STORE, (bf16_t*)(ws + OFF_KC), 64, 64, nullptr, 1.f, nullptr, nullptr, nullptr, nullptr, nullptr, nullptr};
          pg8::gemm_phase(lds, g, S, E); }
    } else if (bid < 32) {
        { StaticOrder S; S.init(4096, 256, 16, bid - 16);
          Gemm g{(const bf16_t*)(ws + OFF_VCG), (const bf16_t*)(ws + OFF_WC1V), 4096, 256, 2048, 1024, 2048};
          Epi E{pg8::EPI_SILU, (bf16_t*)(ws + OFF_HIDV), 256, 256, nullptr, 1.f, nullptr, nullptr, BIAS + 256, nullptr, nullptr, nullptr};
          pg8::gemm_phase(lds, g, S, E); }
        __threadfence(); __syncthreads();
        { StaticOrder S; S.init(256, 4096, 16, bid - 16);
          Gemm g{(const bf16_t*)(ws + OFF_WC2V), (const bf16_t*)(ws + OFF_HIDV), 256, 4096, 256, 256, 256};
          Epi E{pg8::EPI_VCT, (bf16_t*)(ws + OFF_VCT), 512, 4096, nullptr, 1.f, nullptr, nullptr, nullptr, nullptr, nullptr, nullptr};
          pg8::gemm_phase(lds, g, S, E); }
    }
    for (int rep = 0; rep < REP_MLA; ++rep) {
        unsigned* ctl = (unsigned*)(ws + OFF_CTL) + rep * 256;
        LAS int* QU = (LAS int*)(lds + 158208);
        for (int k = 0; k < 8; ++k) {
            const int qq = (bid + k) & 7;
            for (;;) {
                PHASE_IDS;
                __syncthreads();
                if (tid == 0) QU[0] = (int)atomicAdd(ctl + qq * 16, 1u);
                __syncthreads();
                const int qi_ = QU[0];
                if (qi_ >= 128) break;
                const int pr_ = qi_ >> 6, r_ = qi_ & 63;
                const int qb = 31 - (r_ >> 1), bh = qq + 8 * (2 * pr_ + (r_ & 1));
                mla_unit(p, lds, bh >> 3, bh & 7, qb, tid);
            }
        }
    }
    xcd_barrier(xbar, xcc, xst);
    for (int rep = 0; rep < REP_NSA; ++rep)
    for (int u = bid, rnd = 0; u < 2048; u += G, ++rnd) {
        PHASE_IDS;
        const int bg = (u + rnd) & 7, qt = 255 - (u >> 3);
        nsa_unit(p, lds, dyn_lds, bg, qt, tid);
    }
    xcd_barrier(xbar, xcc, xst);
    {
        Gemm g{(const bf16_t*)(ws + OFF_MIX), (const bf16_t*)(ws + OFF_WO), T_, DM, DM, DM, DM}; StaticOrder S; S.init(T_, DM, G, bid);
        Epi E{pg8::EPI_RESID_NORM, HN, DM, DM, nullptr, 1.f, nullptr, nullptr, nullptr, p.in[0], nullptr, (float*)(ws + OFF_ROWSQ)};
        pg8::gemm_phase(lds, g, S, E);
    }
    xcd_barrier(xbar, xcc, xst);
    {
        Gemm g{HN, (const bf16_t*)(ws + OFF_WGU), T_, 2 * FF, DM, DM, DM}; StaticOrder S; S.init(T_, 2 * FF, G, bid);
        Epi E{pg8::EPI_SWIGLU, (bf16_t*)(ws + OFF_ACT), FF, 2 * FF, nullptr, 1.f, nullptr, nullptr, nullptr, nullptr, nullptr, (float*)(ws + OFF_ROWSQ)};
        for (int rep = 0; rep < REP_P8; ++rep) pg8::gemm_phase(lds, g, S, E);
    }
    xcd_barrier(xbar, xcc, xst);
    {
        Gemm g{(const bf16_t*)(ws + OFF_ACT), (const bf16_t*)(ws + OFF_WD), T_, DM, FF, FF, FF}; StaticOrder S; S.init(T_, DM, G, bid);
        Epi E{pg8::EPI_RESID_BF, HN, DM, DM, nullptr, 1.f, nullptr, nullptr, nullptr, nullptr, p.out, nullptr};
        pg8::gemm_phase(lds, g, S, E);
    }
    xcd_barrier(xbar, xcc, xst);
    {
        PHASE_IDS;
        const int gw = bid * 8 + wave, NGW = G * 8;
        for (int m = gw; m < T_; m += NGW) norm_row_f32_inplace(p.out + (size_t)m * DM, p.in[19], lane);
    }
}

extern "C" void kernel_launch(void* const* d_in, const int* in_sizes, int n_in, void* d_out, int out_size, void* d_ws, size_t ws_size, hipStream_t stream) {
    static int grid_blocks = 0;
    if (grid_blocks == 0) {
        if (n_in != 20 || ws_size < WS_END) { fprintf(stderr, "kernel_launch: unexpected n_in %d or ws_size %zu (< %zu)\n", n_in, ws_size, (size_t)WS_END); grid_blocks = -1; return; }
        int dev = 0, cus = 0, per_cu = 0;
        hipGetDevice(&dev);
        hipDeviceGetAttribute(&cus, hipDeviceAttributeMultiprocessorCount, dev);
        if (hipFuncSetAttribute((const void*)fwd_megakernel, hipFuncAttributeMaxDynamicSharedMemorySize, LDS_BYTES) != hipSuccess) fprintf(stderr, "kernel_launch: hipFuncSetAttribute failed\n");
        if (hipOccupancyMaxActiveBlocksPerMultiprocessor(&per_cu, (const void*)fwd_megakernel, NTHREADS, LDS_BYTES) != hipSuccess || per_cu < 1) { fprintf(stderr, "kernel_launch: occupancy query gave %d\n", per_cu); per_cu = 1; }
        (void)hipGetLastError();
        grid_blocks = cus * per_cu;
    }
    if (grid_blocks < 0) return;
    unsigned char* ws = (unsigned char*)d_ws;
    Params p{};
    for (int i = 0; i < 20; ++i) p.in[i] = (const float*)d_in[i];
    p.out = (float*)d_out; p.ws = ws;
    void* args[] = {&p};
    hipError_t e = hipLaunchCooperativeKernel((const void*)fwd_megakernel, dim3(grid_blocks), dim3(NTHREADS), args, LDS_BYTES, stream);
    if (e != hipSuccess) fprintf(stderr, "kernel_launch: cooperative launch failed: %s (grid %d)\n", hipGetErrorString(e), grid_blocks);
}
```

```cpp
#include <hip/hip_runtime.h>
#include <hip/hip_cooperative_groups.h>
#include <cstdio>
#include <cstdint>
namespace cg = cooperative_groups;

#define LAS __attribute__((address_space(3)))
#define DI __device__ __forceinline__
typedef unsigned short bf16_t;
typedef short bf16x8 __attribute__((ext_vector_type(8)));
typedef short bf16x4 __attribute__((ext_vector_type(4)));
typedef float f32x4 __attribute__((ext_vector_type(4)));
typedef float f32x16 __attribute__((ext_vector_type(16)));
typedef unsigned u32x4 __attribute__((ext_vector_type(4)));
typedef unsigned u32x2 __attribute__((ext_vector_type(2)));

constexpr int T_ = 32768, S_ = 8192, DM = 2048, NPROJ = 2816, FF = 5632;
constexpr float LOG2E = 1.4426950408889634f;
constexpr int NTHREADS = 512;
constexpr int LDS_BYTES = 158720;
constexpr int REP_P0 = 1, REP_P1 = 1, REP_MLA = 1, REP_NSA = 1, REP_P8 = 1;

constexpr size_t MiB = 1048576;
constexpr size_t OFF_HN = 0;
constexpr size_t OFF_PROJ = 128 * MiB;
constexpr size_t OFF_QMLA = 304 * MiB;
constexpr size_t OFF_KNOPE = 400 * MiB;
constexpr size_t OFF_VT = 464 * MiB;
constexpr size_t OFF_ACT = 128 * MiB;
constexpr size_t OFF_MIX = 528 * MiB;
constexpr size_t OFF_W = 656 * MiB;
constexpr size_t OFF_WIN = OFF_W;
constexpr size_t OFF_WUQ = OFF_WIN + 2816ull * 2048 * 2;
constexpr size_t OFF_WK = OFF_WUQ + 1536ull * 512 * 2;
constexpr size_t OFF_WV = OFF_WK + 1024ull * 256 * 2;
constexpr size_t OFF_WO = OFF_WV + 1024ull * 256 * 2;
constexpr size_t OFF_WGU = OFF_WO + 2048ull * 2048 * 2;
constexpr size_t OFF_WD = OFF_WGU + 11264ull * 2048 * 2;
constexpr size_t OFF_WC1K = OFF_WD + 2048ull * 5632 * 2;
constexpr size_t OFF_WC1V = OFF_WC1K + 256ull * 2048 * 2;
constexpr size_t OFF_WC2K = OFF_WC1V + 256ull * 2048 * 2;
constexpr size_t OFF_WC2V = OFF_WC2K + 256ull * 256 * 2;
constexpr size_t OFF_MISC = 752 * MiB;
constexpr size_t OFF_KROPE = OFF_MISC;
constexpr size_t OFF_KCG = OFF_KROPE + 4 * MiB;
constexpr size_t OFF_VCG = OFF_KCG + 8 * MiB + 65536;
constexpr size_t OFF_VST = OFF_VCG + 8 * MiB + 65536;
constexpr size_t OFF_VWT = OFF_VST + 8 * MiB;
constexpr size_t OFF_HIDK = OFF_VWT + 8 * MiB;
constexpr size_t OFF_HIDV = OFF_HIDK + 2 * MiB;
constexpr size_t OFF_KC = OFF_HIDV + 2 * MiB;
constexpr size_t OFF_VCT = OFF_KC + MiB / 2;
constexpr size_t OFF_RSQ = OFF_VCT + MiB / 2;
constexpr size_t OFF_RSKV = OFF_RSQ + 131072;
constexpr size_t OFF_COS = OFF_RSKV + 131072;
constexpr size_t OFF_SIN = OFF_COS + MiB;
constexpr size_t OFF_BIAS = OFF_SIN + MiB;
constexpr size_t OFF_CTL = OFF_BIAS + 4096;
constexpr size_t OFF_ROWSQ = OFF_CTL + 4096;
constexpr size_t OFF_XBAR = OFF_ROWSQ + 131072;
constexpr size_t WS_END = OFF_XBAR + 16384;

DI unsigned f2bf(float f) { unsigned u = __builtin_bit_cast(unsigned, f); return (u + 0x7fffu + ((u >> 16) & 1u)) >> 16; }
typedef __bf16 hwbf16x2 __attribute__((ext_vector_type(2)));
typedef float f32x2 __attribute__((ext_vector_type(2)));
DI unsigned pk2(float lo, float hi) { const f32x2 v = {lo, hi}; const hwbf16x2 b = __builtin_convertvector(v, hwbf16x2); return __builtin_bit_cast(unsigned, b); }
DI float bf2f(unsigned b) { return __builtin_bit_cast(float, b << 16); }
DI float bflo(unsigned w) { return __builtin_bit_cast(float, w << 16); }
DI float bfhi(unsigned w) { return __builtin_bit_cast(float, w & 0xffff0000u); }
DI float wave_sum(float v) {
#pragma unroll
    for (int o = 1; o < 64; o <<= 1) v += __shfl_xor(v, o);
    return v;
}
DI void swap32(unsigned& a, unsigned& b) { asm volatile("s_nop 1\n\tv_permlane32_swap_b32 %0, %1" : "+v"(a), "+v"(b)); }
DI float xhalf_max(float v) { unsigned a = __builtin_bit_cast(unsigned, v), b = a; swap32(a, b); return fmaxf(__builtin_bit_cast(float, a), __builtin_bit_cast(float, b)); }
DI float xhalf_sum(float v) { unsigned a = __builtin_bit_cast(unsigned, v), b = a; swap32(a, b); return __builtin_bit_cast(float, a) + __builtin_bit_cast(float, b); }
DI float xhalf_partner(float v, int hi) { unsigned a = __builtin_bit_cast(unsigned, v), b = a; swap32(a, b); return __builtin_bit_cast(float, hi ? a : b); }
DI float sum8(float v) {
    v += __builtin_bit_cast(float, __builtin_amdgcn_mov_dpp(__builtin_bit_cast(int, v), 0xB1, 0xF, 0xF, true));
    v += __builtin_bit_cast(float, __builtin_amdgcn_mov_dpp(__builtin_bit_cast(int, v), 0x4E, 0xF, 0xF, true));
    v += __builtin_bit_cast(float, __builtin_amdgcn_mov_dpp(__builtin_bit_cast(int, v), 0x141, 0xF, 0xF, true));
    return v;
}
DI float fexp2(float x) { return __builtin_amdgcn_exp2f(x); }
DI float frcp(float x) { return __builtin_amdgcn_rcpf(x); }
DI float frsq(float x) { return __builtin_amdgcn_rsqf(x); }
DI float fsilu(float v) { return v * frcp(1.f + __expf(-v)); }
DI float fsigmoid(float v) { return frcp(1.f + __expf(-v)); }
#define LDS_WAIT() asm volatile("s_waitcnt lgkmcnt(0)" ::: "memory")
#define MFMA32(a, b, c) __builtin_amdgcn_mfma_f32_32x32x16_bf16((a), (b), (c), 0, 0, 0)
DI int crow(int r, int hi) { return (r & 3) + 8 * (r >> 2) + 4 * hi; }
DI int fresh_tid() { int t = threadIdx.x; asm volatile("" : "+v"(t)); return t; }

struct Params { const float* in[20]; float* out; unsigned char* ws; };

namespace pg8 {
constexpr int BM = 256, BK = 64, HALF = 128, HTB = HALF * BK * 2, STAGE_BYTES = 8 * HTB, NXCD = 8, WGM = 4;
DI int lds_byte(int r, int c) { const int st = (r >> 4) * 2 + (c >> 5), rr = r & 15, cc = c & 31, ob = rr * 64 + cc * 2; return st * 1024 + (ob ^ (((ob >> 9) & 1) << 5)); }
DI void stage_rc(int b, int& R, int& C) { const int st = b / 1024, sb = b % 1024, swz = sb ^ (((sb >> 9) & 1) << 5); R = (st >> 1) * 16 + swz / 64; C = (st & 1) * 32 + (swz % 64) / 2; }
DI int perm32(int rho) { const int n = rho >> 4, i = rho & 15; return 8 * (i >> 2) + 4 * n + (i & 3); }
struct Unit { int pm, pn; };
struct Gemm { const bf16_t* A; const bf16_t* Bt; int M, N, K, lda, ldb; };
struct StaticOrder {
    int nM, nN, nwg, G, c;
    DI void init(int M, int N, int G_, int c_) { nM = M / BM; nN = N / BM; nwg = nM * nN; G = G_; c = c_; }
    DI bool next(int i, Unit& u) const {
        const long L = (long)i * G + c; if (L >= nwg) return false;
        int wgid = (int)L; { const int q = nwg / NXCD, r = nwg % NXCD, xcd = wgid % NXCD, off = wgid / NXCD; wgid = (xcd < r ? xcd * (q + 1) : r * (q + 1) + (xcd - r) * q) + off; }
        const int nig = WGM * nN, gid = wgid / nig, fm = gid * WGM, gsz = (nM - fm) < WGM ? (nM - fm) : WGM;
        u.pm = fm + ((wgid % nig) % gsz); u.pn = (wgid % nig) / gsz; return true;
    }
};

enum { EPI_STORE = 0, EPI_Q = 1, EPI_VT = 2, EPI_SILU = 3, EPI_VCT = 4, EPI_RESID = 5, EPI_SWIGLU = 6, EPI_RESID_NORM = 7, EPI_RESID_BF = 8 };
struct Epi {
    int mode; bf16_t* O; int ldc; int ncols; const float* rscale; float qscale; const float* cosT; const float* sinT; const float* bias; const float* resid; float* outf; float* rowsq;
    DI void operator()(const f32x4 (&acc)[2][2][4][2], const Unit& u, int wr, int wc, int fr, int fq) const {
        const int row0 = u.pm * BM + wr * 64 + fr, col0 = u.pn * BM + wc * 32 + 8 * fq;
#pragma unroll
        for (int ai = 0; ai < 2; ++ai)
#pragma unroll
            for (int m = 0; m < 4; ++m) {
                const int row = row0 + ai * HALF + m * 16;
                float rs = 1.f, rowacc = 0.f;
                if (mode == EPI_STORE || mode == EPI_Q) { if (rscale) rs = rscale[row]; }
                if (mode == EPI_SWIGLU) rs = frsq(rowsq[row] * (1.0f / DM) + 1e-6f);
#pragma unroll
                for (int bj = 0; bj < 2; ++bj) {
                    const int col = col0 + bj * HALF;
                    f32x4 v0 = acc[ai][bj][m][0], v1 = acc[ai][bj][m][1];
                    if (mode == EPI_STORE) {
                        if (col < ncols) { v0 = v0 * rs; v1 = v1 * rs; u32x4 w; w.x = pk2(v0[0], v0[1]); w.y = pk2(v0[2], v0[3]); w.z = pk2(v1[0], v1[1]); w.w = pk2(v1[2], v1[3]);
                            *(u32x4*)(O + (size_t)row * ldc + col) = w; }
                    } else if (mode == EPI_Q) {
                        const float sc = rs * qscale; v0 = v0 * sc; v1 = v1 * sc;
                        const int c192 = col % 192;
                        if (c192 >= 128) {
                            const int i0 = (c192 - 128) >> 1, pos = row & (S_ - 1);
                            const f32x4 cs = *(const f32x4*)(cosT + pos * 32 + i0), sn = *(const f32x4*)(sinT + pos * 32 + i0);
                            float a, b;
                            a = v0[0]; b = v0[1]; v0[0] = a * cs[0] - b * sn[0]; v0[1] = a * sn[0] + b * cs[0];
                            a = v0[2]; b = v0[3]; v0[2] = a * cs[1] - b * sn[1]; v0[3] = a * sn[1] + b * cs[1];
                            a = v1[0]; b = v1[1]; v1[0] = a * cs[2] - b * sn[2]; v1[1] = a * sn[2] + b * cs[2];
                            a = v1[2]; b = v1[3]; v1[2] = a * cs[3] - b * sn[3]; v1[3] = a * sn[3] + b * cs[3];
                        }
                        u32x4 w; w.x = pk2(v0[0], v0[1]); w.y = pk2(v0[2], v0[3]); w.z = pk2(v1[0], v1[1]); w.w = pk2(v1[2], v1[3]);
                        *(u32x4*)(O + (size_t)row * ldc + col) = w;
                    } else if (mode == EPI_VT) {
                        const f32x4 s0 = *(const f32x4*)(rscale + col), s1 = *(const f32x4*)(rscale + col + 4);
                        v0 = v0 * s0; v1 = v1 * s1;
                        u32x4 w; w.x = pk2(v0[0], v0[1]); w.y = pk2(v0[2], v0[3]); w.z = pk2(v1[0], v1[1]); w.w = pk2(v1[2], v1[3]);
                        *(u32x4*)(O + (size_t)row * ldc + col) = w;
                    } else if (mode == EPI_SILU) {
                        const f32x4 b0 = *(const f32x4*)(bias + col), b1 = *(const f32x4*)(bias + col + 4);
                        v0 = v0 + b0; v1 = v1 + b1;
                        u32x4 w; w.x = pk2(fsilu(v0[0]), fsilu(v0[1])); w.y = pk2(fsilu(v0[2]), fsilu(v0[3])); w.z = pk2(fsilu(v1[0]), fsilu(v1[1])); w.w = pk2(fsilu(v1[2]), fsilu(v1[3]));
                        *(u32x4*)(O + (size_t)row * ldc + col) = w;
                    } else if (mode == EPI_VCT) {
                        if (row < 64) { u32x4 w; w.x = pk2(v0[0], v0[1]); w.y = pk2(v0[2], v0[3]); w.z = pk2(v1[0], v1[1]); w.w = pk2(v1[2], v1[3]);
                            *(u32x4*)(O + ((size_t)((col >> 9) * 64 + row)) * 512 + (col & 511)) = w; }
                    } else if (mode == EPI_RESID) {
                        const size_t ix = (size_t)row * DM + col;
                        const f32x4 r0 = *(const f32x4*)(resid + ix), r1 = *(const f32x4*)(resid + ix + 4);
                        *(f32x4*)(outf + ix) = v0 + r0; *(f32x4*)(outf + ix + 4) = v1 + r1;
                    } else if (mode == EPI_RESID_BF) {
                        const size_t ix = (size_t)row * DM + col;
                        const u32x4 rb = *(const u32x4*)(O + ix);
                        v0[0] += bflo(rb.x); v0[1] += bfhi(rb.x); v0[2] += bflo(rb.y); v0[3] += bfhi(rb.y);
                        v1[0] += bflo(rb.z); v1[1] += bfhi(rb.z); v1[2] += bflo(rb.w); v1[3] += bfhi(rb.w);
                        u32x4 w; w.x = pk2(v0[0], v0[1]); w.y = pk2(v0[2], v0[3]); w.z = pk2(v1[0], v1[1]); w.w = pk2(v1[2], v1[3]);
                        *(u32x4*)(O + ix) = w;
                    } else if (mode == EPI_RESID_NORM) {
                        const size_t ix = (size_t)row * DM + col;
                        const f32x4 r0 = *(const f32x4*)(resid + ix), r1 = *(const f32x4*)(resid + ix + 4);
                        v0 = v0 + r0; v1 = v1 + r1;
                        if (outf) { *(f32x4*)(outf + ix) = v0; *(f32x4*)(outf + ix + 4) = v1; }
                        u32x4 w; w.x = pk2(v0[0], v0[1]); w.y = pk2(v0[2], v0[3]); w.z = pk2(v1[0], v1[1]); w.w = pk2(v1[2], v1[3]);
                        *(u32x4*)(O + ix) = w;
                        rowacc += (v0[0] * v0[0] + v0[1] * v0[1]) + (v0[2] * v0[2] + v0[3] * v0[3]) + (v1[0] * v1[0] + v1[1] * v1[1]) + (v1[2] * v1[2] + v1[3] * v1[3]);
                    } else {
                        v0 = v0 * rs; v1 = v1 * rs;
                        u32x2 w; w.x = pk2(fsilu(v0[0]) * v1[0], fsilu(v0[1]) * v1[1]); w.y = pk2(fsilu(v0[2]) * v1[2], fsilu(v0[3]) * v1[3]);
                        *(u32x2*)(O + (size_t)row * ldc + (col >> 1)) = w;
                    }
                }
                if (mode == EPI_RESID_NORM) {
                    rowacc += __shfl_xor(rowacc, 16); rowacc += __shfl_xor(rowacc, 32);
                    if (fq == 0) atomicAdd(rowsq + row, rowacc);
                }
            }
    }
};

DI void gemm_phase(LAS unsigned char* lds, const Gemm g, const StaticOrder& S, const Epi& E) {
    const int tid = fresh_tid(), wid = __builtin_amdgcn_readfirstlane(tid >> 6), lane = tid & 63, wr = wid >> 2, wc = wid & 3, fr = lane & 15, fq = lane >> 4;
    const int K = g.K, nt = K / BK;
    unsigned voffA[2], voffB[2];
#pragma unroll
    for (int i = 0; i < 2; ++i) { int R, C; stage_rc(tid * 16 + i * 8192, R, C); const int Rb = (R & ~31) + perm32(R & 31);
        voffA[i] = (unsigned)(R * g.lda + C) * 2u; voffB[i] = (unsigned)(Rb * g.ldb + C) * 2u; }
    const size_t kstep = (size_t)(BK * 2);
    const size_t hsA = (size_t)HALF * g.lda * 2, hsB = (size_t)HALF * g.ldb * 2;
    const size_t tsA = 2 * hsA, tsB = 2 * hsB;
    const unsigned ldsw = (unsigned)wid * 1024u;
    const int aoff = lds_byte(wr * 64 + fr, fq * 8), boff = lds_byte(wc * 32 + fr, fq * 8);
#define PG8_SA(b, h) (((b) * 2 + (h)) * HTB)
#define PG8_SB(b, h) ((4 + (b) * 2 + (h)) * HTB)
#define PG8_STAGE(bufoff, gbase, voff) do { _Pragma("unroll") for (int _i = 0; _i < 2; ++_i) \
        __builtin_amdgcn_global_load_lds((const unsigned*)((const char*)(gbase) + (voff)[_i]), (LAS unsigned*)(lds + (bufoff) + ldsw + _i * 8192), 16, 0, 0); } while (0)
#define PG8_LDA(dst, b, h) do { _Pragma("unroll") for (int m = 0; m < 4; ++m) _Pragma("unroll") for (int k = 0; k < 2; ++k) dst[m][k] = *(const LAS bf16x8*)(lds + PG8_SA(b, h) + aoff + m * 2048 + k * 1024); } while (0)
#define PG8_LDB(dst, b, h) do { _Pragma("unroll") for (int n = 0; n < 2; ++n) _Pragma("unroll") for (int k = 0; k < 2; ++k) dst[n][k] = *(const LAS bf16x8*)(lds + PG8_SB(b, h) + boff + n * 2048 + k * 1024); } while (0)
#define PG8_MMA(ai, bj, At, Bt) do { __builtin_amdgcn_s_setprio(1); _Pragma("unroll") for (int m = 0; m < 4; ++m) _Pragma("unroll") for (int n = 0; n < 2; ++n) _Pragma("unroll") for (int k = 0; k < 2; ++k) \
        acc[ai][bj][m][n] = __builtin_amdgcn_mfma_f32_16x16x32_bf16(Bt[n][k], At[m][k], acc[ai][bj][m][n], 0, 0, 0); __builtin_amdgcn_s_setprio(0); } while (0)
#define PG8_WAIT_V(n) asm volatile("s_waitcnt vmcnt(" #n ")" ::: "memory")
#define PG8_WAIT_L(n) asm volatile("s_waitcnt lgkmcnt(" #n ")" ::: "memory")
#define PG8_BAR __builtin_amdgcn_s_barrier()
#define PG8_SCHED __builtin_amdgcn_sched_barrier(0)
    Unit cur, nxt; int ui = 0;
    if (!S.next(0, cur)) return;
    f32x4 acc[2][2][4][2];
#pragma unroll
    for (int a = 0; a < 2; ++a)
#pragma unroll
        for (int b = 0; b < 2; ++b)
#pragma unroll
            for (int m = 0; m < 4; ++m)
#pragma unroll
                for (int n = 0; n < 2; ++n) acc[a][b][m][n] = (f32x4){0.f, 0.f, 0.f, 0.f};
    bf16x8 At[4][2], B0[2][2], B1[2][2];
    const char* cA = (const char*)g.A + (size_t)cur.pm * tsA; const char* cB = (const char*)g.Bt + (size_t)cur.pn * tsB;
    PG8_STAGE(PG8_SB(0, 0), cB, voffB); PG8_STAGE(PG8_SB(0, 1), cB + hsB, voffB); PG8_STAGE(PG8_SA(0, 0), cA, voffA); PG8_STAGE(PG8_SA(0, 1), cA + hsA, voffA);
    if (wr == 1) PG8_BAR;
    PG8_WAIT_V(2); PG8_BAR;
    PG8_STAGE(PG8_SB(1, 0), cB + kstep, voffB); PG8_STAGE(PG8_SA(1, 0), cA + kstep, voffA); PG8_STAGE(PG8_SB(1, 1), cB + hsB + kstep, voffB);
    PG8_WAIT_V(6); PG8_BAR;
    for (;;) {
        const bool has_next = S.next(ui + 1, nxt);
        const char* nA = has_next ? (const char*)g.A + (size_t)nxt.pm * tsA : cA; const char* nB = has_next ? (const char*)g.Bt + (size_t)nxt.pn * tsB : cB;
        for (int t = 0; t < nt; t += 2) {
            const bool last = (t == nt - 2);
            const char* a1 = cA + (size_t)(t + 1) * kstep;
            const char* a2 = last ? nA : cA + (size_t)(t + 2) * kstep; const char* b2 = last ? nB : cB + (size_t)(t + 2) * kstep;
            const char* a3 = a2 + kstep; const char* b3 = b2 + kstep;
            PG8_LDB(B0, 0, 0); PG8_LDB(B1, 0, 1); PG8_SCHED; PG8_LDA(At, 0, 0); PG8_STAGE(PG8_SA(1, 1), a1 + hsA, voffA);
            PG8_WAIT_V(8); PG8_WAIT_L(0); PG8_BAR; PG8_MMA(0, 0, At, B0); PG8_MMA(0, 1, At, B1); PG8_BAR; PG8_SCHED;
            PG8_LDA(At, 0, 1); PG8_STAGE(PG8_SB(0, 0), b2, voffB); PG8_STAGE(PG8_SB(0, 1), b2 + hsB, voffB); PG8_STAGE(PG8_SA(0, 0), a2, voffA);
            PG8_WAIT_V(8); PG8_WAIT_L(0); PG8_BAR; PG8_MMA(1, 0, At, B0); PG8_MMA(1, 1, At, B1); PG8_BAR; PG8_SCHED;
            PG8_LDB(B0, 1, 0); PG8_LDB(B1, 1, 1); PG8_SCHED; PG8_LDA(At, 1, 0); PG8_STAGE(PG8_SA(0, 1), a2 + hsA, voffA);
            PG8_WAIT_V(8); PG8_WAIT_L(0); PG8_BAR; PG8_MMA(0, 0, At, B0); PG8_MMA(0, 1, At, B1); PG8_BAR; PG8_SCHED;
            PG8_LDA(At, 1, 1); PG8_STAGE(PG8_SB(1, 0), b3, voffB); PG8_STAGE(PG8_SB(1, 1), b3 + hsB, voffB); PG8_STAGE(PG8_SA(1, 0), a3, voffA);
            PG8_WAIT_V(8); PG8_WAIT_L(0); PG8_BAR; PG8_MMA(1, 0, At, B0); PG8_MMA(1, 1, At, B1); PG8_BAR; PG8_SCHED;
        }
        if (wr == 0) PG8_BAR;
        E(acc, cur, wr, wc, fr, fq);
        if (!has_next) break;
#pragma unroll
        for (int a = 0; a < 2; ++a)
#pragma unroll
            for (int b = 0; b < 2; ++b)
#pragma unroll
                for (int m = 0; m < 4; ++m)
#pragma unroll
                    for (int n = 0; n < 2; ++n) acc[a][b][m][n] = (f32x4){0.f, 0.f, 0.f, 0.f};
        cur = nxt; cA = nA; cB = nB; ++ui;
        if (wr == 1) PG8_BAR;
    }
    PG8_WAIT_V(0);
    PG8_BAR;
#undef PG8_SA
#undef PG8_SB
#undef PG8_STAGE
#undef PG8_LDA
#undef PG8_LDB
#undef PG8_MMA
#undef PG8_WAIT_V
#undef PG8_WAIT_L
#undef PG8_BAR
#undef PG8_SCHED
}
}

DI int map_row(int map, int n) {
    if (map == 1) { const int hd = n / 192, c = n - hd * 192; if (c >= 160) return hd * 192 + 128 + 2 * (c - 160) + 1; if (c >= 128) return hd * 192 + 128 + 2 * (c - 128); return n; }
    if (map == 2) return (n >> 2) * 8 + (n & 3);
    if (map == 3) return (n >> 2) * 8 + 4 + (n & 3);
    return n;
}
DI void transpose_item(const float* dW, const float* dks, bf16_t* dWT, int dK, int dN, int dNpad, int dldt, int dmap, LAS float* scr, int item, int lane) {
    const int nblk = dNpad / 32, kb = item / nblk, nb = item - kb * nblk, k0 = 64 * kb, n0 = 32 * nb;
    f32x4 ld[8];
#pragma unroll
    for (int i = 0; i < 8; ++i) {
        const int kk = 8 * i + (lane >> 3), k = k0 + kk, n = n0 + 4 * (lane & 7);
        ld[i] = (f32x4){0.f, 0.f, 0.f, 0.f};
        if (k < dK && n < dN) { ld[i] = *(const f32x4*)(dW + (size_t)k * dN + n); if (dks) ld[i] = ld[i] * dks[k]; }
    }
#pragma unroll
    for (int i = 0; i < 8; ++i) {
        const int kk = 8 * i + (lane >> 3); LAS float* d = scr + kk * 33 + 4 * (lane & 7);
        d[0] = ld[i].x; d[1] = ld[i].y; d[2] = ld[i].z; d[3] = ld[i].w;
    }
    LDS_WAIT();
    const int c = lane & 7;
#pragma unroll
    for (int j = 0; j < 4; ++j) {
        const int n = (lane >> 3) + 8 * j; const LAS float* s = scr + (8 * c) * 33 + n;
        u32x4 o; o.x = pk2(s[0 * 33], s[1 * 33]); o.y = pk2(s[2 * 33], s[3 * 33]); o.z = pk2(s[4 * 33], s[5 * 33]); o.w = pk2(s[6 * 33], s[7 * 33]);
        *(u32x4*)(dWT + (size_t)map_row(dmap, n0 + n) * dldt + k0 + 8 * c) = o;
    }
    LDS_WAIT();
}
DI void norm_row_bf16(const float* xrow, const float* g, bf16_t* orow, int lane) {
    const f32x4* xr = (const f32x4*)xrow + lane; f32x4 v[8]; float s = 0.f;
#pragma unroll
    for (int j = 0; j < 8; ++j) { v[j] = xr[64 * j]; s += (v[j].x * v[j].x + v[j].y * v[j].y) + (v[j].z * v[j].z + v[j].w * v[j].w); }
    s = wave_sum(s);
    const float rs = frsq(s * (1.0f / DM) + 1e-6f);
    const f32x4* gr = (const f32x4*)g + lane;
    u32x2* o8 = (u32x2*)orow + lane;
#pragma unroll
    for (int j = 0; j < 8; ++j) { const f32x4 gg = gr[64 * j]; u32x2 o; o.x = pk2(v[j].x * rs * gg.x, v[j].y * rs * gg.y); o.y = pk2(v[j].z * rs * gg.z, v[j].w * rs * gg.w); o8[64 * j] = o; }
}
DI void norm_row_f32_inplace(float* xrow, const float* g, int lane) {
    f32x4* xr = (f32x4*)xrow + lane; f32x4 v[8]; float s = 0.f;
#pragma unroll
    for (int j = 0; j < 8; ++j) { v[j] = xr[64 * j]; s += (v[j].x * v[j].x + v[j].y * v[j].y) + (v[j].z * v[j].z + v[j].w * v[j].w); }
    s = wave_sum(s);
    const float rs = frsq(s * (1.0f / DM) + 1e-6f);
    const f32x4* gr = (const f32x4*)g + lane;
#pragma unroll
    for (int j = 0; j < 8; ++j) { const f32x4 gg = gr[64 * j]; xr[64 * j] = v[j] * rs * gg; }
}
DI void norm_row_bf16_to_f32(const bf16_t* xrow, const float* g, float* orow, int lane) {
    u32x4 v[4]; float s = 0.f;
#pragma unroll
    for (int j = 0; j < 4; ++j) {
        v[j] = *((const u32x4*)xrow + lane + 64 * j);
        float f;
        f = bflo(v[j].x); s += f * f; f = bfhi(v[j].x); s += f * f; f = bflo(v[j].y); s += f * f; f = bfhi(v[j].y); s += f * f;
        f = bflo(v[j].z); s += f * f; f = bfhi(v[j].z); s += f * f; f = bflo(v[j].w); s += f * f; f = bfhi(v[j].w); s += f * f;
    }
    s = wave_sum(s);
    const float rs = frsq(s * (1.0f / DM) + 1e-6f);
#pragma unroll
    for (int j = 0; j < 4; ++j) {
        const f32x4 g0 = *((const f32x4*)g + 2 * (lane + 64 * j)), g1 = *((const f32x4*)g + 2 * (lane + 64 * j) + 1);
        f32x4 o0, o1;
        o0.x = bflo(v[j].x) * rs * g0.x; o0.y = bfhi(v[j].x) * rs * g0.y; o0.z = bflo(v[j].y) * rs * g0.z; o0.w = bfhi(v[j].y) * rs * g0.w;
        o1.x = bflo(v[j].z) * rs * g1.x; o1.y = bfhi(v[j].z) * rs * g1.y; o1.z = bflo(v[j].w) * rs * g1.z; o1.w = bfhi(v[j].w) * rs * g1.w;
        *((f32x4*)orow + 2 * (lane + 64 * j)) = o0; *((f32x4*)orow + 2 * (lane + 64 * j) + 1) = o1;
    }
}
DI void sincos_acc(float angf, float& sn, float& cs) {
    const double x = (double)angf;
    const double n = rint(x * 0.15915494309189535);
    double r = fma(-n, 6.283185307179586, x); r = fma(-n, 2.4492935982947064e-16, r);
    const double r2 = r * r;
    double ts = r, ss = r, tc = 1.0, cc = 1.0;
    for (int k = 1; k <= 13; ++k) {
        ts *= -r2 / (double)((2 * k) * (2 * k + 1)); ss += ts;
        tc *= -r2 / (double)((2 * k - 1) * (2 * k)); cc += tc;
    }
    sn = (float)ss; cs = (float)cc;
}

DI void prologue(const Params& p, LAS unsigned char* lds, int tid, int lane, int wave) {
    unsigned char* ws = p.ws;
    const int gw = blockIdx.x * 8 + wave, NGW = gridDim.x * 8;
    LAS float* scr = (LAS float*)(lds + wave * 16384);
    constexpr int I0 = 32 * 88, I1 = I0 + 8 * 48, I2 = I1 + 4 * 32, I3 = I2 + 4 * 32, I4 = I3 + 32 * 64, I5 = I4 + 32 * 176, I6 = I5 + 32 * 176, I7 = I6 + 88 * 64,
                  I8 = I7 + 32 * 8, I9 = I8 + 32 * 8, I10 = I9 + 4 * 8, I11 = I10 + 4 * 8;
    typedef const float* cfp;
    LAS cfp* PTg = (LAS cfp*)(lds + 158208);
    if (tid == 0) { PTg[2] = p.in[2]; PTg[3] = p.in[3]; PTg[4] = p.in[4]; PTg[5] = p.in[5]; PTg[6] = p.in[6]; PTg[7] = p.in[7]; PTg[10] = p.in[10]; PTg[11] = p.in[11];
                    PTg[12] = p.in[12]; PTg[13] = p.in[13]; PTg[14] = p.in[14]; PTg[15] = p.in[15]; PTg[16] = p.in[16]; PTg[17] = p.in[17]; PTg[18] = p.in[18]; PTg[0] = nullptr; }
    __syncthreads();
    for (int it = gw; it < I11; it += NGW) {
        int ii, ksi, dK, dN, dNpad, dldt, dmap, i0; size_t off;
        if (it < I0)       { ii = 2;  ksi = 0;  off = OFF_WIN;  dK = 2048; dN = 2672; dNpad = 2816; dldt = 2048; dmap = 0; i0 = 0; }
        else if (it < I1)  { ii = 5;  ksi = 3;  off = OFF_WUQ;  dK = 512;  dN = 1536; dNpad = 1536; dldt = 512;  dmap = 1; i0 = I0; }
        else if (it < I2)  { ii = 6;  ksi = 4;  off = OFF_WK;   dK = 256;  dN = 1024; dNpad = 1024; dldt = 256;  dmap = 0; i0 = I1; }
        else if (it < I3)  { ii = 7;  ksi = 4;  off = OFF_WV;   dK = 256;  dN = 1024; dNpad = 1024; dldt = 256;  dmap = 0; i0 = I2; }
        else if (it < I4)  { ii = 14; ksi = 0;  off = OFF_WO;   dK = 2048; dN = 2048; dNpad = 2048; dldt = 2048; dmap = 0; i0 = I3; }
        else if (it < I5)  { ii = 16; ksi = 15; off = OFF_WGU;  dK = 2048; dN = 5632; dNpad = 5632; dldt = 2048; dmap = 2; i0 = I4; }
        else if (it < I6)  { ii = 17; ksi = 15; off = OFF_WGU;  dK = 2048; dN = 5632; dNpad = 5632; dldt = 2048; dmap = 3; i0 = I5; }
        else if (it < I7)  { ii = 18; ksi = 0;  off = OFF_WD;   dK = 5632; dN = 2048; dNpad = 2048; dldt = 5632; dmap = 0; i0 = I6; }
        else if (it < I8)  { ii = 10; ksi = 0;  off = OFF_WC1K; dK = 2048; dN = 128;  dNpad = 256;  dldt = 2048; dmap = 0; i0 = I7; }
        else if (it < I9)  { ii = 12; ksi = 0;  off = OFF_WC1V; dK = 2048; dN = 128;  dNpad = 256;  dldt = 2048; dmap = 0; i0 = I8; }
        else if (it < I10) { ii = 11; ksi = 0;  off = OFF_WC2K; dK = 128;  dN = 64;   dNpad = 256;  dldt = 256;  dmap = 0; i0 = I9; }
        else               { ii = 13; ksi = 0;  off = OFF_WC2V; dK = 128;  dN = 64;   dNpad = 256;  dldt = 256;  dmap = 0; i0 = I10; }
        transpose_item(PTg[ii], PTg[ksi], (bf16_t*)(ws + off), dK, dN, dNpad, dldt, dmap, scr, it - i0, lane);
    }
    bf16_t* HN = (bf16_t*)(ws + OFF_HN);
    for (int m = gw; m < T_; m += NGW) norm_row_bf16(p.in[0] + (size_t)m * DM, p.in[1], HN + (size_t)m * DM, lane);
    float* COS = (float*)(ws + OFF_COS); float* SIN = (float*)(ws + OFF_SIN);
    for (int idx = blockIdx.x * NTHREADS + tid; idx < S_ * 32; idx += gridDim.x * NTHREADS) {
        const int pos = idx >> 5, i = idx & 31;
        const float inv = exp2f(-(float)i * (13.287712379549449f / 32.0f));
        const float ang = (float)pos * inv;
        float sn, cs; sincos_acc(ang, sn, cs);
        COS[idx] = cs; SIN[idx] = sn;
    }
    float* BIAS = (float*)(ws + OFF_BIAS);
    if (gw < 256) {
        const int which = gw >> 7, j = gw & 127;
        const float* W = which ? p.in[12] : p.in[10]; const float* pe = which ? p.in[9] : p.in[8];
        float s = 0.f;
        for (int k = lane; k < 2048; k += 64) s += pe[k] * W[(size_t)k * 128 + j];
        s = wave_sum(s);
        if (lane == 0) { BIAS[which * 256 + j] = s; BIAS[which * 256 + 128 + j] = 0.f; }
    }
    { unsigned* ctl = (unsigned*)(ws + OFF_CTL); float* rowsq = (float*)(ws + OFF_ROWSQ);
      for (int i = blockIdx.x * NTHREADS + tid; i < T_; i += gridDim.x * NTHREADS) { rowsq[i] = 0.f; if (i < 1024) ctl[i] = 0u; } }
    if (blockIdx.x == 1 % gridDim.x) { unsigned* xb = (unsigned*)(ws + OFF_XBAR); for (int i = tid; i < 4096; i += NTHREADS) xb[i] = 0u; }
    if (blockIdx.x == 0) {
        bf16_t* KCg = (bf16_t*)(ws + OFF_KCG) + (size_t)8 * S_ * 64; bf16_t* VCg = (bf16_t*)(ws + OFF_VCG) + (size_t)8 * S_ * 64;
        for (int i = tid; i < 4096; i += NTHREADS) { KCg[i] = 0; VCg[i] = 0; }
    }
}

DI void postproj_tile(const Params& p, LAS unsigned char* lds, int tile, int tid, int lane, int wave) {
    unsigned char* ws = p.ws;
    const bf16_t* PROJ = (const bf16_t*)(ws + OFF_PROJ);
    const int tok0 = tile * 64, b = tok0 >> 13, s0 = tok0 & (S_ - 1);
    LAS bf16_t* tl = (LAS bf16_t*)lds;
#pragma unroll
    for (int i = 0; i < 4; ++i) {
        const int q = tid + 512 * i, mat = q >> 10, r = (q >> 4) & 63, ch = q & 15;
        const u32x4 v = *(const u32x4*)(PROJ + (size_t)(tok0 + r) * NPROJ + (mat ? 2496 : 2240) + 8 * ch);
        *(LAS u32x4*)(tl + (mat * 64 + r) * 136 + 8 * ch) = v;
    }
    __syncthreads();
    bf16_t* VST = (bf16_t*)(ws + OFF_VST); bf16_t* VWT = (bf16_t*)(ws + OFF_VWT);
#pragma unroll
    for (int i = 0; i < 4; ++i) {
        const int q = tid + 512 * i, mat = q >> 10, c = (q >> 3) & 127, j8 = q & 7;
        unsigned e[8];
#pragma unroll
        for (int k = 0; k < 8; ++k) e[k] = tl[(mat * 64 + 8 * j8 + k) * 136 + c];
        u32x4 o; o.x = e[0] | (e[1] << 16); o.y = e[2] | (e[3] << 16); o.z = e[4] | (e[5] << 16); o.w = e[6] | (e[7] << 16);
        const int g = c >> 6, d = c & 63;
        bf16_t* dst = (mat ? VWT : VST) + ((size_t)((b * 2 + g) * 64 + d)) * S_ + s0 + 8 * j8;
        *(u32x4*)dst = o;
    }
    float* RSQ = (float*)(ws + OFF_RSQ); float* RSKV = (float*)(ws + OFF_RSKV);
    const float* COS = (const float*)(ws + OFF_COS); const float* SIN = (const float*)(ws + OFF_SIN);
    bf16_t* KROPE = (bf16_t*)(ws + OFF_KROPE); bf16_t* KCg = (bf16_t*)(ws + OFF_KCG); bf16_t* VCg = (bf16_t*)(ws + OFF_VCG);
    for (int rr = 0; rr < 8; ++rr) {
        const int r = wave * 8 + rr, tok = tok0 + r, s = s0 + r;
        const bf16_t* pr = PROJ + (size_t)tok * NPROJ;
        const u32x4 a = *(const u32x4*)(pr + 8 * lane);
        float sq = 0.f;
        { float f; f = bflo(a.x); sq += f * f; f = bfhi(a.x); sq += f * f; f = bflo(a.y); sq += f * f; f = bfhi(a.y); sq += f * f;
          f = bflo(a.z); sq += f * f; f = bfhi(a.z); sq += f * f; f = bflo(a.w); sq += f * f; f = bfhi(a.w); sq += f * f; }
        sq = wave_sum(sq);
        const u32x2 c2 = *(const u32x2*)(pr + 512 + 4 * lane);
        float sk = 0.f;
        { float f; f = bflo(c2.x); sk += f * f; f = bfhi(c2.x); sk += f * f; f = bflo(c2.y); sk += f * f; f = bfhi(c2.y); sk += f * f; }
        sk = wave_sum(sk);
        if (lane == 0) { RSQ[tok] = frsq(sq * (1.0f / 512.0f) + 1e-6f); RSKV[tok] = frsq(sk * (1.0f / 256.0f) + 1e-6f); }
        if (lane < 32) {
            const float x1 = bf2f(pr[768 + lane]), x2 = bf2f(pr[800 + lane]);
            const float cs = COS[s * 32 + lane], sn = SIN[s * 32 + lane];
            *(unsigned*)(KROPE + (size_t)tok * 64 + 2 * lane) = pk2(x1 * cs - x2 * sn, x1 * sn + x2 * cs);
        }
        const int g = lane >> 5, d = (2 * lane) & 63;
        const unsigned kc2 = *(const unsigned*)(pr + 1856 + 2 * lane);
        *(unsigned*)(KCg + ((size_t)((b * 2 + g) * S_ + s)) * 64 + d) = kc2;
        const unsigned vc2 = *(const unsigned*)(pr + 1984 + 2 * lane);
        *(unsigned*)(VCg + ((size_t)((b * 2 + g) * S_ + s)) * 64 + d) = vc2;
    }
    __syncthreads();
}

constexpr int MLA_BUF = 43008;
DI void mla_load(const bf16_t* KNOPE, const bf16_t* KROPE, const bf16_t* VT, int h, size_t tokb, int kt, u32x4 (&r)[5], int tid) {
#pragma unroll
    for (int i = 0; i < 2; ++i) { const int q = tid + 512 * i, key = q >> 4, ch = q & 15;
        r[i] = *(const u32x4*)(KNOPE + (tokb + kt * 64 + key) * 1024 + h * 128 + 8 * ch); }
    { const int key = tid >> 3, ch = tid & 7; r[2] = *(const u32x4*)(KROPE + (tokb + kt * 64 + key) * 64 + 8 * ch); }
#pragma unroll
    for (int i = 0; i < 2; ++i) { const int q = tid + 512 * i, d = q >> 3, ch = q & 7;
        r[3 + i] = *(const u32x4*)(VT + (size_t)(h * 128 + d) * T_ + tokb + kt * 64 + 8 * ch); }
}
DI void mla_store(LAS unsigned char* buf, const u32x4 (&r)[5], int tid) {
#pragma unroll
    for (int i = 0; i < 2; ++i) { const int q = tid + 512 * i, key = q >> 4, ch = q & 15; *(LAS u32x4*)(buf + key * 400 + ch * 16) = r[i]; }
    { const int key = tid >> 3, ch = tid & 7; *(LAS u32x4*)(buf + key * 400 + 256 + ch * 16) = r[2]; }
#pragma unroll
    for (int i = 0; i < 2; ++i) { const int q = tid + 512 * i, d = q >> 3, ch = q & 7; LAS unsigned char* vp = buf + 25600 + d * 136 + ch * 16;
        *(LAS u32x2*)vp = (u32x2){r[3 + i].x, r[3 + i].y}; *(LAS u32x2*)(vp + 8) = (u32x2){r[3 + i].z, r[3 + i].w}; }
}
DI bf16x8 cat4(bf16x4 lo, bf16x4 hi) { bf16x8 r; r[0] = lo[0]; r[1] = lo[1]; r[2] = lo[2]; r[3] = lo[3]; r[4] = hi[0]; r[5] = hi[1]; r[6] = hi[2]; r[7] = hi[3]; return r; }
DI bf16x8 packp(const f32x16& s, int t) {
    u32x4 w;
    if (t == 0) { w.x = pk2(s[0], s[1]); w.y = pk2(s[2], s[3]); w.z = pk2(s[4], s[5]); w.w = pk2(s[6], s[7]); }
    else { w.x = pk2(s[8], s[9]); w.y = pk2(s[10], s[11]); w.z = pk2(s[12], s[13]); w.w = pk2(s[14], s[15]); }
    return __builtin_bit_cast(bf16x8, w);
}

DI float vmax3(float a, float b, float c) { float r; asm("v_max3_f32 %0, %1, %2, %3" : "=v"(r) : "v"(a), "v"(b), "v"(c)); return r; }
DI float max16(const f32x16& s) {
    float a = vmax3(s[0], s[1], s[2]), b = vmax3(s[3], s[4], s[5]), c = vmax3(s[6], s[7], s[8]), d = vmax3(s[9], s[10], s[11]);
    a = vmax3(a, s[12], s[13]); b = vmax3(b, s[14], s[15]);
    return vmax3(vmax3(a, b, c), d, d);
}
DI void mla_unit(const Params& p, LAS unsigned char* lds, int b, int h, int qb, int tid) {
    unsigned char* ws = p.ws;
    const bf16_t* QMLA = (const bf16_t*)(ws + OFF_QMLA); const bf16_t* KNOPE = (const bf16_t*)(ws + OFF_KNOPE);
    const bf16_t* KROPE = (const bf16_t*)(ws + OFF_KROPE); const bf16_t* VT = (const bf16_t*)(ws + OFF_VT);
    bf16_t* MIX = (bf16_t*)(ws + OFF_MIX);
    const int lane = tid & 63, w = __builtin_amdgcn_readfirstlane(tid >> 6), c = lane & 31, hi = lane >> 5;
    const int q0 = qb * 256, qw0 = q0 + 32 * w, qpos = qw0 + c;
    const size_t tokb = (size_t)b * S_;
    bf16x8 qf[12];
    { const bf16_t* qp = QMLA + (tokb + qpos) * 1536 + h * 192 + 8 * hi;
#pragma unroll
      for (int st = 0; st < 12; ++st) qf[st] = *(const bf16x8*)(qp + 16 * st); }
    f32x16 o[4];
#pragma unroll
    for (int db = 0; db < 4; ++db)
#pragma unroll
        for (int i = 0; i < 16; ++i) o[db][i] = 0.f;
    float m = -1e20f, l = 0.f;
    const int nkt = 4 * qb + 4;
    u32x4 r[5];
    __syncthreads();
    mla_load(KNOPE, KROPE, VT, h, tokb, 0, r, tid); mla_store(lds, r, tid);
    __syncthreads();
    for (int kt = 0; kt < nkt; ++kt) {
        const bool more = kt + 1 < nkt;
        if (more) mla_load(KNOPE, KROPE, VT, h, tokb, kt + 1, r, tid);
        LAS const unsigned char* buf = lds + (kt & 1) * MLA_BUF;
        if (kt * 64 <= qw0 + 31) {
#pragma unroll
            for (int sub = 0; sub < 2; ++sub) {
                const int kbase = kt * 64 + 32 * sub;
                f32x16 s;
#pragma unroll
                for (int i = 0; i < 16; ++i) s[i] = 0.f;
#pragma unroll
                for (int st = 0; st < 12; ++st) {
                    const bf16x8 a = *(LAS const bf16x8*)(buf + (32 * sub + c) * 400 + st * 32 + hi * 16);
                    s = MFMA32(a, qf[st], s);
                }
                if (kbase + 31 > qw0) {
                    int dbase = qpos - kbase - 4 * hi;
                    asm volatile("" : "+v"(dbase));
#pragma unroll
                    for (int i = 0; i < 16; ++i) if ((dbase - ((i & 3) + 8 * (i >> 2))) < 0) s[i] = -1e30f;
                }
                float mx = max16(s);
                mx = xhalf_max(mx);
                const float mn = (mx > m + 8.f) ? mx : m, alpha = fexp2(m - mn); m = mn; l *= alpha;
                if (__any(alpha != 1.f)) {
#pragma unroll
                    for (int db = 0; db < 4; ++db) o[db] = o[db] * alpha;
                }
                float ps = 0.f;
#pragma unroll
                for (int i = 0; i < 16; ++i) { const float pv = fexp2(s[i] - m); s[i] = pv; ps += pv; }
                l += ps;
                const bf16x8 pb0 = packp(s, 0), pb1 = packp(s, 1);
#pragma unroll
                for (int db = 0; db < 4; ++db) {
                    LAS const unsigned char* ap = buf + 25600 + (32 * db + c) * 136 + (32 * sub + 4 * hi) * 2;
                    const bf16x8 v0 = cat4(*(LAS const bf16x4*)(ap), *(LAS const bf16x4*)(ap + 16));
                    const bf16x8 v1 = cat4(*(LAS const bf16x4*)(ap + 32), *(LAS const bf16x4*)(ap + 48));
                    o[db] = MFMA32(v0, pb0, o[db]); o[db] = MFMA32(v1, pb1, o[db]);
                }
            }
        }
        if (more) mla_store(lds + ((kt + 1) & 1) * MLA_BUF, r, tid);
        __syncthreads();
    }
    const float lt = xhalf_sum(l), inv = frcp(lt);
    bf16_t* op = MIX + (tokb + qpos) * 2048 + h * 128 + 4 * hi;
#pragma unroll
    for (int db = 0; db < 4; ++db)
#pragma unroll
        for (int g4 = 0; g4 < 4; ++g4) {
            u32x2 wv; wv.x = pk2(o[db][4 * g4] * inv, o[db][4 * g4 + 1] * inv); wv.y = pk2(o[db][4 * g4 + 2] * inv, o[db][4 * g4 + 3] * inv);
            *(u32x2*)(op + 32 * db + 8 * g4) = wv;
        }
}

constexpr int NSA_KC = 0, NSA_VCT = 73728, NSA_IMP = 140288, NSA_SEL = 156672, NSA_UNI = 157184, NSA_NL = 157200, NSA_LIST = 157216;
constexpr int NSA_TBUF = 17920;

template <int MODE>
DI void nsa_tile(LAS const unsigned char* buf, const bf16x8 (&qf)[4], f32x16 (&o)[2], float& m, float& l, int kbase0, int t, bool lanesel, float slope2, int c, int hi) {
#pragma unroll
    for (int sub = 0; sub < 2; ++sub) {
        const int klo = kbase0 + 32 * sub;
        bool full, none;
        if (MODE == 0) { full = lanesel && (klo + 31 <= t); none = !lanesel || (klo > t); }
        else { full = (klo + 31 <= t) && (klo >= t - 511); none = (klo > t) || (klo + 31 < t - 511); }
        if (__all(none)) continue;
        int dbase = t - klo - 4 * hi;
        asm volatile("" : "+v"(dbase));
        const float b0 = none ? -1e30f : -slope2 * (float)dbase;
        f32x16 s;
#pragma unroll
        for (int i = 0; i < 16; ++i) s[i] = fmaf(slope2, (float)((i & 3) + 8 * (i >> 2)), b0);
#pragma unroll
        for (int st = 0; st < 4; ++st) {
            const bf16x8 a = *(LAS const bf16x8*)(buf + (32 * sub + c) * 144 + st * 32 + hi * 16);
            s = MFMA32(a, qf[st], s);
        }
        if (__any(!full && !none)) {
#pragma unroll
            for (int i = 0; i < 16; ++i) {
                const int dist = dbase - ((i & 3) + 8 * (i >> 2));
                const bool valid = (MODE == 0) ? (lanesel && dist >= 0) : ((unsigned)dist < 512u);
                if (!valid) s[i] = -1e30f;
            }
        }
        float mx = max16(s);
        mx = xhalf_max(mx);
        if (__any(mx > m + 8.f)) {
            const float mn = fmaxf(m, mx), alpha = fexp2(m - mn); m = mn; l *= alpha;
            o[0] = o[0] * alpha; o[1] = o[1] * alpha;
        }
        float ps = 0.f;
#pragma unroll
        for (int i = 0; i < 16; ++i) { const float pv = fexp2(s[i] - m); s[i] = pv; ps += pv; }
        l += ps;
        const bf16x8 pb0 = packp(s, 0), pb1 = packp(s, 1);
#pragma unroll
        for (int db = 0; db < 2; ++db)
#pragma unroll
            for (int tt = 0; tt < 2; ++tt) {
                LAS const unsigned char* ap = buf + 9216 + (32 * db + c) * 136 + (32 * sub + 16 * tt + 4 * hi) * 2;
                const bf16x8 a = cat4(*(LAS const bf16x4*)ap, *(LAS const bf16x4*)(ap + 16));
                o[db] = MFMA32(a, tt == 0 ? pb0 : pb1, o[db]);
            }
    }
}

DI void nsa_unit(const Params& p, LAS unsigned char* lds, unsigned char* ldsg, int bg, int qt, int tid) {
    unsigned char* ws = p.ws;
    const bf16_t* PROJ = (const bf16_t*)(ws + OFF_PROJ);
    const bf16_t* KC = (const bf16_t*)(ws + OFF_KC); const bf16_t* VCT = (const bf16_t*)(ws + OFF_VCT);
    const bf16_t* VST = (const bf16_t*)(ws + OFF_VST); const bf16_t* VWT = (const bf16_t*)(ws + OFF_VWT);
    bf16_t* MIX = (bf16_t*)(ws + OFF_MIX);
    const int lane = tid & 63, w = __builtin_amdgcn_readfirstlane(tid >> 6), c = lane & 31, hi = lane >> 5;
    const int b = bg >> 1, g = bg & 1, q0 = qt * 32;
    const int head = c & 7, qi = c >> 3, tw0 = q0 + 4 * w, t = tw0 + qi, hh = g * 8 + head;
    const size_t tokb = (size_t)b * S_, tok = tokb + t;
    const float sc2 = 0.125f * LOG2E, slope2 = exp2f(-0.5f * (float)(hh + 1)) * LOG2E;

    LAS unsigned* SEL = (LAS unsigned*)(lds + NSA_SEL);
    LAS unsigned* UNI = (LAS unsigned*)(lds + NSA_UNI);
    LAS int* NL = (LAS int*)(lds + NSA_NL);
    LAS int* LIST = (LAS int*)(lds + NSA_LIST);
    LAS float* IMPw = (LAS float*)(lds + NSA_IMP + w * 2048);

    __syncthreads();
    const int nct = (q0 / 16 + 1 + 31) >> 5;
    for (int q0_ = tid; q0_ < nct * 256; q0_ += 4 * NTHREADS) {
        u32x4 v[4];
#pragma unroll
        for (int j = 0; j < 4; ++j) { const int q = q0_ + j * NTHREADS; if (q < nct * 256) v[j] = *(const u32x4*)(KC + ((size_t)(bg * 512 + (q >> 3))) * 64 + 8 * (q & 7)); }
#pragma unroll
        for (int j = 0; j < 4; ++j) { const int q = q0_ + j * NTHREADS; if (q < nct * 256) *(LAS u32x4*)(lds + NSA_KC + (q >> 3) * 144 + (q & 7) * 16) = v[j]; }
    }
    { const int cpr = nct * 4;
      for (int q0_ = tid; q0_ < 64 * cpr; q0_ += 4 * NTHREADS) {
          u32x4 v[4];
#pragma unroll
          for (int j = 0; j < 4; ++j) { const int q = q0_ + j * NTHREADS; if (q < 64 * cpr) { const int d = q / cpr, ch = q - d * cpr; v[j] = *(const u32x4*)(VCT + ((size_t)(bg * 64 + d)) * 512 + 8 * ch); } }
#pragma unroll
          for (int j = 0; j < 4; ++j) { const int q = q0_ + j * NTHREADS; if (q < 64 * cpr) { const int d = q / cpr, ch = q - d * cpr; LAS unsigned char* vp_ = lds + NSA_VCT + d * 1032 + ch * 16; *(LAS u32x2*)vp_ = (u32x2){v[j].x, v[j].y}; *(LAS u32x2*)(vp_ + 8) = (u32x2){v[j].z, v[j].w}; } }
      } }
    if (tid < 4) UNI[tid] = 0u;

    bf16x8 qf[4];
    { const bf16_t* qp = PROJ + tok * NPROJ + 832 + hh * 64 + 8 * hi;
#pragma unroll
      for (int st = 0; st < 4; ++st) {
          const u32x4 raw = *(const u32x4*)(qp + 16 * st); u32x4 sc;
          sc.x = pk2(bflo(raw.x) * sc2, bfhi(raw.x) * sc2); sc.y = pk2(bflo(raw.y) * sc2, bfhi(raw.y) * sc2);
          sc.z = pk2(bflo(raw.z) * sc2, bfhi(raw.z) * sc2); sc.w = pk2(bflo(raw.w) * sc2, bfhi(raw.w) * sc2);
          qf[st] = __builtin_bit_cast(bf16x8, sc); } }
    const bf16_t* gp = PROJ + tok * NPROJ + 2624 + hh * 3;
    const float gate_c = fsigmoid(bf2f(gp[0])), gate_s = fsigmoid(bf2f(gp[1])), gate_w = fsigmoid(bf2f(gp[2]));
    __syncthreads();

    f32x16 out[2];
    {
        const int cwm = (tw0 + 3 >= 31) ? ((tw0 + 3 - 31) >> 4) : -1;
        const int ntw = (cwm >= 0) ? (cwm >> 5) + 1 : 0;
        const float slope16 = 16.f * slope2;
        float m1 = -1e20f, l1 = 0.f;
        for (int tile = 0; tile < ntw; ++tile) {
            int dbase = t - 31 - 512 * tile - 64 * hi;
            asm volatile("" : "+v"(dbase));
            const float b0 = -slope2 * (float)dbase;
            f32x16 s;
#pragma unroll
            for (int i = 0; i < 16; ++i) s[i] = fmaf(slope16, (float)((i & 3) + 8 * (i >> 2)), b0);
#pragma unroll
            for (int st = 0; st < 4; ++st) {
                const bf16x8 a = *(LAS const bf16x8*)(lds + NSA_KC + (32 * tile + c) * 144 + st * 32 + hi * 16);
                s = MFMA32(a, qf[st], s);
            }
            if (512 * tile + 496 + 31 > tw0) {
#pragma unroll
                for (int i = 0; i < 16; ++i) if ((dbase - 16 * ((i & 3) + 8 * (i >> 2))) < 0) s[i] = -1e30f;
            }
            const float mn = fmaxf(m1, max16(s));
            float ps = 0.f;
#pragma unroll
            for (int i = 0; i < 16; ++i) ps += fexp2(s[i] - mn);
            l1 = l1 * fexp2(m1 - mn) + ps; m1 = mn;
        }
        const float mo = xhalf_partner(m1, hi), lo = xhalf_partner(l1, hi);
        const float M = fmaxf(m1, mo), L = l1 * fexp2(m1 - M) + lo * fexp2(mo - M);
        const float Moff = (L > 0.f) ? (M + __log2f(L)) : 1e30f;
#pragma unroll
        for (int i = 0; i < 8; ++i) IMPw[lane + 64 * i] = 0.f;
        LDS_WAIT();
        f32x16 oc[2];
#pragma unroll
        for (int db = 0; db < 2; ++db)
#pragma unroll
            for (int i = 0; i < 16; ++i) oc[db][i] = 0.f;
        float prev3 = 0.f;
        for (int tile = 0; tile < ntw; ++tile) {
            int dbase = t - 31 - 512 * tile - 64 * hi;
            asm volatile("" : "+v"(dbase));
            const float b0 = -slope2 * (float)dbase;
            f32x16 s;
#pragma unroll
            for (int i = 0; i < 16; ++i) s[i] = fmaf(slope16, (float)((i & 3) + 8 * (i >> 2)), b0);
#pragma unroll
            for (int st = 0; st < 4; ++st) {
                const bf16x8 a = *(LAS const bf16x8*)(lds + NSA_KC + (32 * tile + c) * 144 + st * 32 + hi * 16);
                s = MFMA32(a, qf[st], s);
            }
            if (512 * tile + 496 + 31 > tw0) {
#pragma unroll
                for (int i = 0; i < 16; ++i) if ((dbase - 16 * ((i & 3) + 8 * (i >> 2))) < 0) s[i] = -1e30f;
            }
#pragma unroll
            for (int i = 0; i < 16; ++i) s[i] = fexp2(s[i] - Moff);
            float pp[4];
#pragma unroll
            for (int r = 0; r < 4; ++r) pp[r] = xhalf_partner(s[4 * r + 3], hi);
#pragma unroll
            for (int r = 0; r < 4; ++r) {
                const float a = 2.f * (s[4 * r] + s[4 * r + 1] + s[4 * r + 2]) + s[4 * r + 3];
                const float cin = hi ? pp[r] : (r > 0 ? pp[r > 0 ? r - 1 : 0] : prev3);
                float v = a + cin;
                v = sum8(v);
                if (head == 0) IMPw[qi * 128 + 8 * tile + 2 * r + hi] = v;
            }
            prev3 = pp[3];
            const bf16x8 pb0 = packp(s, 0), pb1 = packp(s, 1);
#pragma unroll
            for (int db = 0; db < 2; ++db)
#pragma unroll
                for (int tt = 0; tt < 2; ++tt) {
                    LAS const unsigned char* ap = lds + NSA_VCT + (32 * db + c) * 1032 + (32 * tile + 16 * tt + 4 * hi) * 2;
                    const bf16x8 a = cat4(*(LAS const bf16x4*)ap, *(LAS const bf16x4*)(ap + 16));
                    oc[db] = MFMA32(a, tt == 0 ? pb0 : pb1, oc[db]);
                }
        }
        out[0] = oc[0] * gate_c; out[1] = oc[1] * gate_c;
        LDS_WAIT();
        for (int qi2 = 0; qi2 < 4; ++qi2) {
            const int t2 = tw0 + qi2, blk = t2 >> 6;
            LAS unsigned* kp = (LAS unsigned*)(IMPw + qi2 * 128);
            const int n0 = lane, n1 = lane + 64;
            const unsigned b0 = kp[n0], b1 = kp[n1];
            const bool f0 = (n0 == 0) || (n0 == blk) || (n0 == blk - 1), f1 = (n1 == blk) || (n1 == blk - 1);
            const unsigned k0 = (n0 <= blk) ? ((((f0 ? 0x461C4000u : b0)) & 0xFFFFFF80u) | (unsigned)(127 - n0)) : 0u;
            const unsigned k1 = (n1 <= blk) ? ((((f1 ? 0x461C4000u : b1)) & 0xFFFFFF80u) | (unsigned)(127 - n1)) : 0u;
            unsigned T = 0u;
#pragma unroll 1
            for (int bit = 30; bit >= 0; --bit) {
                const unsigned cand = T | (1u << bit);
                const int cnt = __popcll(__ballot(k0 >= cand)) + __popcll(__ballot(k1 >= cand));
                if (cnt >= 16) T = cand;
            }
            const bool s0 = (k0 != 0u) && (k0 >= T), s1 = (k1 != 0u) && (k1 >= T);
            const unsigned long long m0 = __ballot(s0), m1b = __ballot(s1);
            if (lane == 0) {
                const unsigned w0 = (unsigned)m0, w1 = (unsigned)(m0 >> 32), w2 = (unsigned)m1b, w3 = (unsigned)(m1b >> 32);
                LAS unsigned* sp = SEL + (4 * w + qi2) * 4;
                sp[0] = w0; sp[1] = w1; sp[2] = w2; sp[3] = w3;
                unsigned* ug = (unsigned*)(ldsg + NSA_UNI);
                atomicOr(ug + 0, w0); atomicOr(ug + 1, w1); atomicOr(ug + 2, w2); atomicOr(ug + 3, w3);
            }
        }
    }
    __syncthreads();
    if (tid == 0) {
        int cnt = 0;
        for (int wd = 0; wd < 4; ++wd) { unsigned bits = UNI[wd]; while (bits) { const int nb = 32 * wd + __builtin_ctz(bits); bits &= bits - 1; LIST[cnt++] = nb; } }
        NL[0] = cnt;
    }
    __syncthreads();
    const int kq = tid >> 3, kch = tid & 7;
    const int toff = kq * 144 + kch * 16, voff = 9216 + kq * 136 + kch * 16;
#define ST_V(base, v) do { LAS unsigned char* vp_ = (base) + voff; *(LAS u32x2*)vp_ = (u32x2){(v).x, (v).y}; *(LAS u32x2*)(vp_ + 8) = (u32x2){(v).z, (v).w}; } while (0)
    {
        const int nl = NL[0];
        const bf16_t* Ksrc = PROJ + (tokb + kq) * NPROJ + 2112 + g * 64 + 8 * kch;
        const bf16_t* Vsrc = VST + ((size_t)(bg * 64 + kq)) * S_ + 8 * kch;
        f32x16 o[2];
#pragma unroll
        for (int db = 0; db < 2; ++db)
#pragma unroll
            for (int i = 0; i < 16; ++i) o[db][i] = 0.f;
        float m = -1e20f, l = 0.f;
        u32x4 rk1, rv1, rk2, rv2;
        { const int nb = LIST[0]; rk1 = *(const u32x4*)(Ksrc + (size_t)(64 * nb) * NPROJ); rv1 = *(const u32x4*)(Vsrc + 64 * nb); }
        *(LAS u32x4*)(lds + toff) = rk1; ST_V(lds, rv1);
        if (nl > 1) { const int nb = LIST[1]; rk1 = *(const u32x4*)(Ksrc + (size_t)(64 * nb) * NPROJ); rv1 = *(const u32x4*)(Vsrc + 64 * nb); }
        __syncthreads();
        int cb = 0;
        for (int i = 0; i < nl; ++i) {
            const int nb = LIST[i];
            if (i + 2 < nl) { const int nb2 = LIST[i + 2]; rk2 = *(const u32x4*)(Ksrc + (size_t)(64 * nb2) * NPROJ); rv2 = *(const u32x4*)(Vsrc + 64 * nb2); }
            const bool lanesel = (SEL[(4 * w + qi) * 4 + (nb >> 5)] >> (nb & 31)) & 1u;
            if (__any(lanesel))
                nsa_tile<0>(lds + cb * NSA_TBUF, qf, o, m, l, 64 * nb, t, lanesel, slope2, c, hi);
            const int nbuf = (cb == 2) ? 0 : cb + 1;
            if (i + 1 < nl) { *(LAS u32x4*)(lds + nbuf * NSA_TBUF + toff) = rk1; ST_V(lds + nbuf * NSA_TBUF, rv1); }
            rk1 = rk2; rv1 = rv2; cb = nbuf;
            __syncthreads();
        }
        const float lt = xhalf_sum(l), sc = gate_s * frcp(lt);
        out[0] = out[0] + o[0] * sc; out[1] = out[1] + o[1] * sc;
    }
    {
        const int lo_key = (q0 - 511 > 0) ? (q0 - 511) : 0;
        const int kt_lo = lo_key >> 6, kt_hi = (q0 + 31) >> 6;
        const bf16_t* Ksrc = PROJ + (tokb + kq) * NPROJ + 2368 + g * 64 + 8 * kch;
        const bf16_t* Vsrc = VWT + ((size_t)(bg * 64 + kq)) * S_ + 8 * kch;
        f32x16 o[2];
#pragma unroll
        for (int db = 0; db < 2; ++db)
#pragma unroll
            for (int i = 0; i < 16; ++i) o[db][i] = 0.f;
        float m = -1e20f, l = 0.f;
        u32x4 rk1, rv1, rk2, rv2;
        rk1 = *(const u32x4*)(Ksrc + (size_t)(64 * kt_lo) * NPROJ); rv1 = *(const u32x4*)(Vsrc + 64 * kt_lo);
        *(LAS u32x4*)(lds + toff) = rk1; ST_V(lds, rv1);
        if (kt_lo < kt_hi) { rk1 = *(const u32x4*)(Ksrc + (size_t)(64 * (kt_lo + 1)) * NPROJ); rv1 = *(const u32x4*)(Vsrc + 64 * (kt_lo + 1)); }
        __syncthreads();
        int cb = 0;
        for (int kt = kt_lo; kt <= kt_hi; ++kt) {
            if (kt + 2 <= kt_hi) { rk2 = *(const u32x4*)(Ksrc + (size_t)(64 * (kt + 2)) * NPROJ); rv2 = *(const u32x4*)(Vsrc + 64 * (kt + 2)); }
            if (!(64 * kt + 63 < tw0 - 511 || 64 * kt > tw0 + 3))
                nsa_tile<1>(lds + cb * NSA_TBUF, qf, o, m, l, 64 * kt, t, true, slope2, c, hi);
            const int nbuf = (cb == 2) ? 0 : cb + 1;
            if (kt < kt_hi) { *(LAS u32x4*)(lds + nbuf * NSA_TBUF + toff) = rk1; ST_V(lds + nbuf * NSA_TBUF, rv1); }
            rk1 = rk2; rv1 = rv2; cb = nbuf;
            __syncthreads();
        }
        const float lt = xhalf_sum(l), sc = gate_w * frcp(lt);
        out[0] = out[0] + o[0] * sc; out[1] = out[1] + o[1] * sc;
    }
    bf16_t* op = MIX + tok * 2048 + 1024 + hh * 64 + 4 * hi;
#pragma unroll
    for (int db = 0; db < 2; ++db)
#pragma unroll
        for (int g4 = 0; g4 < 4; ++g4) {
            u32x2 wv; wv.x = pk2(out[db][4 * g4], out[db][4 * g4 + 1]); wv.y = pk2(out[db][4 * g4 + 2], out[db][4 * g4 + 3]);
            *(u32x2*)(op + 32 * db + 8 * g4) = wv;
        }
}

#define XB_TMO      128
#define XB_XCNT(j)  (256  + 64 * (j))
#define XB_XSUB(j)  (1280 + 64 * (j))
#define XB_XGEN(j)  (2304 + 64 * (j))
#define XB_TOP      3328
#define XB_TOPGEN   3392
#define XB_SPIN_CAP (1u << 18)
DI unsigned xb_ld(unsigned* p)              { return __hip_atomic_load(p, __ATOMIC_RELAXED, __HIP_MEMORY_SCOPE_AGENT); }
DI unsigned xb_add(unsigned* p, unsigned v) { return __hip_atomic_fetch_add(p, v, __ATOMIC_RELAXED, __HIP_MEMORY_SCOPE_AGENT); }
DI unsigned xb_xcc_id() { return (unsigned)__builtin_amdgcn_s_getreg((3 << 11) | 20) & 0xFu; }
#define XB_SPIN(cond, bar) do { unsigned _sp = 0; while (cond) { __builtin_amdgcn_s_sleep(1); \
    if ((++_sp & 255u) == 0u) { if (xb_ld(&(bar)[XB_TMO])) break; if (_sp > XB_SPIN_CAP) { atomicAdd(&(bar)[XB_TMO], 1u); break; } } } } while (0)
DI void xcd_barrier_complete(unsigned* bar, unsigned x, unsigned& nloc, unsigned& nx) {
    const unsigned G = gridDim.x * gridDim.y * gridDim.z;
    unsigned sum, cnt, mine, sp = 0u;
    for (;;) {
        sum = 0u; cnt = 0u; mine = 0u;
#pragma unroll
        for (unsigned j = 0; j < 16; ++j) { const unsigned c = xb_ld(&bar[XB_XCNT(j)]); sum += c; cnt += (c > 0u) ? 1u : 0u; mine = (j == x) ? c : mine; }
        if (sum == G) break;
        __builtin_amdgcn_s_sleep(1);
        if ((++sp & 255u) == 0u) { if (xb_ld(&bar[XB_TMO])) break; if (sp > XB_SPIN_CAP) { atomicAdd(&bar[XB_TMO], 1u); break; } }
    }
    nloc = mine > 0u ? mine : 1u; nx = cnt > 0u ? cnt : 1u;
}
DI void xcd_barrier(unsigned* bar, unsigned x, volatile LAS unsigned* st) {
    asm volatile("s_waitcnt vmcnt(0)" ::: "memory");
    __syncthreads();
    if (threadIdx.x == 0) {
        __builtin_amdgcn_s_waitcnt(0);
        unsigned nloc = st[0], nx = st[1];
        if (nloc == 0u) { xcd_barrier_complete(bar, x, nloc, nx); st[0] = nloc; st[1] = nx; }
        const unsigned old = xb_add(&bar[XB_XSUB(x)], 1u);
        const unsigned gen = old / nloc;
        if (old + 1u == (gen + 1u) * nloc) {
            __builtin_amdgcn_fence(__ATOMIC_RELEASE, "agent");
            asm volatile("s_waitcnt vmcnt(0)" ::: "memory");
            const unsigned og = xb_add(&bar[XB_TOP], 1u);
            const unsigned tg = og / nx;
            if (og + 1u == (tg + 1u) * nx) xb_add(&bar[XB_TOPGEN], 1u);
            else XB_SPIN(xb_ld(&bar[XB_TOPGEN]) == tg, bar);
            __builtin_amdgcn_fence(__ATOMIC_ACQUIRE, "agent");
            xb_add(&bar[XB_XGEN(x)], 1u);
            asm volatile("s_waitcnt vmcnt(0)" ::: "memory");
        } else {
            XB_SPIN(xb_ld(&bar[XB_XGEN(x)]) == gen, bar);
            __builtin_amdgcn_fence(__ATOMIC_ACQUIRE, "agent");
            asm volatile("s_waitcnt vmcnt(0)" ::: "memory");
        }
    }
    __syncthreads();
}
__global__ void __launch_bounds__(NTHREADS, 2) fwd_megakernel(Params p) {
    extern __shared__ __attribute__((aligned(16))) unsigned char dyn_lds[];
    cg::grid_group grid = cg::this_grid();
    LAS unsigned char* lds = (LAS unsigned char*)dyn_lds;
    const int G = gridDim.x, bid = blockIdx.x;
    volatile LAS unsigned* xst = (volatile LAS unsigned*)(lds + 158688);
    if (threadIdx.x < 2) xst[threadIdx.x] = 0u;
    __syncthreads();
    unsigned* xbar = (unsigned*)(p.ws + OFF_XBAR);
    const unsigned xcc = xb_xcc_id();
#define PHASE_IDS const int tid = fresh_tid(), lane = tid & 63, wave = __builtin_amdgcn_readfirstlane(tid >> 6); (void)lane; (void)wave
    unsigned char* ws = p.ws;
    bf16_t* HN = (bf16_t*)(ws + OFF_HN); bf16_t* PROJ = (bf16_t*)(ws + OFF_PROJ);
    const float* RSQ = (const float*)(ws + OFF_RSQ); const float* RSKV = (const float*)(ws + OFF_RSKV);
    const float* BIAS = (const float*)(ws + OFF_BIAS);
    using pg8::Gemm; using pg8::Epi; using pg8::StaticOrder;

    for (int rep = 0; rep < REP_P0; ++rep) { PHASE_IDS; prologue(p, lds, tid, lane, wave); }
    grid.sync();
    if (threadIdx.x == 0) (void)xb_add(&xbar[XB_XCNT(xcc)], 1u);
    {
        Gemm g{HN, (const bf16_t*)(ws + OFF_WIN), T_, NPROJ, DM, DM, DM}; StaticOrder S; S.init(T_, NPROJ, G, bid);
        Epi E{pg8::EPI_STORE, PROJ, NPROJ, NPROJ, nullptr, 1.f, nullptr, nullptr, nullptr, nullptr, nullptr, nullptr};
        for (int rep = 0; rep < REP_P1; ++rep) pg8::gemm_phase(lds, g, S, E);
    }
    xcd_barrier(xbar, xcc, xst);
    { PHASE_IDS; for (int tile = bid; tile < T_ / 64; tile += G) postproj_tile(p, lds, tile, tid, lane, wave); }
    xcd_barrier(xbar, xcc, xst);
    {
        { Gemm g{PROJ, (const bf16_t*)(ws + OFF_WUQ), T_, 1536, 512, NPROJ, 512}; StaticOrder S; S.init(T_, 1536, G, bid);
          Epi E{pg8::EPI_Q, (bf16_t*)(ws + OFF_QMLA), 1536, 1536, RSQ, 0.07216878364870322f * LOG2E, (const float*)(ws + OFF_COS), (const float*)(ws + OFF_SIN), nullptr, nullptr, nullptr, nullptr};
          pg8::gemm_phase(lds, g, S, E); }
        { Gemm g{PROJ + 512, (const bf16_t*)(ws + OFF_WK), T_, 1024, 256, NPROJ, 256}; StaticOrder S; S.init(T_, 1024, G, bid);
          Epi E{pg8::EPI_STORE, (bf16_t*)(ws + OFF_KNOPE), 1024, 1024, RSKV, 1.f, nullptr, nullptr, nullptr, nullptr, nullptr, nullptr};
          pg8::gemm_phase(lds, g, S, E); }
        { Gemm g{(const bf16_t*)(ws + OFF_WV), PROJ + 512, 1024, T_, 256, 256, NPROJ}; StaticOrder S; S.init(1024, T_, G, bid);
          Epi E{pg8::EPI_VT, (bf16_t*)(ws + OFF_VT), T_, T_, RSKV, 1.f, nullptr, nullptr, nullptr, nullptr, nullptr, nullptr};
          pg8::gemm_phase(lds, g, S, E); }
    }
    xcd_barrier(xbar, xcc, xst);
    if (bid < 16) {
        StaticOrder S; S.init(4096, 256, 16, bid);
        { Gemm g{(const bf16_t*)(ws + OFF_KCG), (const bf16_t*)(ws + OFF_WC1K), 4096, 256, 2048, 1024, 2048};
          Epi E{pg8::EPI_SILU, (bf16_t*)(ws + OFF_HIDK), 256, 256, nullptr, 1.f, nullptr, nullptr, BIAS, nullptr, nullptr, nullptr};
          pg8::gemm_phase(lds, g, S, E); }
        __threadfence(); __syncthreads();
        { Gemm g{(const bf16_t*)(ws + OFF_HIDK), (const bf16_t*)(ws + OFF_WC2K), 4096, 256, 256, 256, 256};
          Epi E{pg8::EPI_STORE, (bf16_t*)(ws + OFF_KC), 64, 64, nullptr, 1.f, nullptr, nullptr, nullptr, nullptr, nullptr, nullptr};
          pg8::gemm_phase(lds, g, S, E); }
    } else if (bid < 32) {
        { StaticOrder S; S.init(4096, 256, 16, bid - 16);
          Gemm g{(const bf16_t*)(ws + OFF_VCG), (const bf16_t*)(ws + OFF_WC1V), 4096, 256, 2048, 1024, 2048};
          Epi E{pg8::EPI_SILU, (bf16_t*)(ws + OFF_HIDV), 256, 256, nullptr, 1.f, nullptr, nullptr, BIAS + 256, nullptr, nullptr, nullptr};
          pg8::gemm_phase(lds, g, S, E); }
        __threadfence(); __syncthreads();
        { StaticOrder S; S.init(256, 4096, 16, bid - 16);
          Gemm g{(const bf16_t*)(ws + OFF_WC2V), (const bf16_t*)(ws + OFF_HIDV), 256, 4096, 256, 256, 256};
          Epi E{pg8::EPI_VCT, (bf16_t*)(ws + OFF_VCT), 512, 4096, nullptr, 1.f, nullptr, nullptr, nullptr, nullptr, nullptr, nullptr};
          pg8::gemm_phase(lds, g, S, E); }
    }
    for (int rep = 0; rep < REP_MLA; ++rep) {
        unsigned* ctl = (unsigned*)(ws + OFF_CTL) + rep * 256;
        LAS int* QU = (LAS int*)(lds + 158208);
        for (int k = 0; k < 8; ++k) {
            const int qq = (bid + k) & 7;
            for (;;) {
                PHASE_IDS;
                __syncthreads();
                if (tid == 0) QU[0] = (int)atomicAdd(ctl + qq * 16, 1u);
                __syncthreads();
                const int qi_ = QU[0];
                if (qi_ >= 128) break;
                const int pr_ = qi_ >> 6, r_ = qi_ & 63;
                const int qb = 31 - (r_ >> 1), bh = qq + 8 * (2 * pr_ + (r_ & 1));
                mla_unit(p, lds, bh >> 3, bh & 7, qb, tid);
            }
        }
    }
    xcd_barrier(xbar, xcc, xst);
    for (int rep = 0; rep < REP_NSA; ++rep)
    for (int u = bid, rnd = 0; u < 2048; u += G, ++rnd) {
        PHASE_IDS;
        const int bg = (u + rnd) & 7, qt = 255 - (u >> 3);
        nsa_unit(p, lds, dyn_lds, bg, qt, tid);
    }
    xcd_barrier(xbar, xcc, xst);
    {
        Gemm g{(const bf16_t*)(ws + OFF_MIX), (const bf16_t*)(ws + OFF_WO), T_, DM, DM, DM, DM}; StaticOrder S; S.init(T_, DM, G, bid);
        Epi E{pg8::EPI_RESID_NORM, HN, DM, DM, nullptr, 1.f, nullptr, nullptr, nullptr, p.in[0], nullptr, (float*)(ws + OFF_ROWSQ)};
        pg8::gemm_phase(lds, g, S, E);
    }
    xcd_barrier(xbar, xcc, xst);
    {
        Gemm g{HN, (const bf16_t*)(ws + OFF_WGU), T_, 2 * FF, DM, DM, DM}; StaticOrder S; S.init(T_, 2 * FF, G, bid);
        Epi E{pg8::EPI_SWIGLU, (bf16_t*)(ws + OFF_ACT), FF, 2 * FF, nullptr, 1.f, nullptr, nullptr, nullptr, nullptr, nullptr, (float*)(ws + OFF_ROWSQ)};
        for (int rep = 0; rep < REP_P8; ++rep) pg8::gemm_phase(lds, g, S, E);
    }
    xcd_barrier(xbar, xcc, xst);
    {
        Gemm g{(const bf16_t*)(ws + OFF_ACT), (const bf16_t*)(ws + OFF_WD), T_, DM, FF, FF, FF}; StaticOrder S; S.init(T_, DM, G, bid);
        Epi E{pg8::EPI_RESID_BF, HN, DM, DM, nullptr, 1.f, nullptr, nullptr, nullptr, nullptr, p.out, nullptr};
        pg8::gemm_phase(lds, g, S, E);
    }
    xcd_barrier(xbar, xcc, xst);
    {
        PHASE_IDS;
        const int gw = bid * 8 + wave, NGW = G * 8;
        for (int m = gw; m < T_; m += NGW) norm_row_bf16_to_f32(HN + (size_t)m * DM, p.in[19], p.out + (size_t)m * DM, lane);
    }
}

extern "C" void kernel_launch(void* const* d_in, const int* in_sizes, int n_in, void* d_out, int out_size, void* d_ws, size_t ws_size, hipStream_t stream) {
    static int grid_blocks = 0;
    if (grid_blocks == 0) {
        if (n_in != 20 || ws_size < WS_END) { fprintf(stderr, "kernel_launch: unexpected n_in %d or ws_size %zu (< %zu)\n", n_in, ws_size, (size_t)WS_END); grid_blocks = -1; return; }
        int dev = 0, cus = 0, per_cu = 0;
        hipGetDevice(&dev);
        hipDeviceGetAttribute(&cus, hipDeviceAttributeMultiprocessorCount, dev);
        if (hipFuncSetAttribute((const void*)fwd_megakernel, hipFuncAttributeMaxDynamicSharedMemorySize, LDS_BYTES) != hipSuccess) fprintf(stderr, "kernel_launch: hipFuncSetAttribute failed\n");
        if (hipOccupancyMaxActiveBlocksPerMultiprocessor(&per_cu, (const void*)fwd_megakernel, NTHREADS, LDS_BYTES) != hipSuccess || per_cu < 1) { fprintf(stderr, "kernel_launch: occupancy query gave %d\n", per_cu); per_cu = 1; }
        (void)hipGetLastError();
        grid_blocks = cus * per_cu;
    }
    if (grid_blocks < 0) return;
    unsigned char* ws = (unsigned char*)d_ws;
    Params p{};
    for (int i = 0; i < 20; ++i) p.in[i] = (const float*)d_in[i];
    p.out = (float*)d_out; p.ws = ws;
    void* args[] = {&p};
    hipError_t e = hipLaunchCooperativeKernel((const void*)fwd_megakernel, dim3(grid_blocks), dim3(NTHREADS), args, LDS_BYTES, stream);
    if (e != hipSuccess) fprintf(stderr, "kernel_launch: cooperative launch failed: %s (grid %d)\n", hipGetErrorString(e), grid_blocks);
}
```

```cpp
#include <hip/hip_runtime.h>
#include <hip/hip_cooperative_groups.h>
#include <cstdio>
#include <cstdint>
namespace cg = cooperative_groups;

#define LAS __attribute__((address_space(3)))
#define DI __device__ __forceinline__
typedef unsigned short bf16_t;
typedef short bf16x8 __attribute__((ext_vector_type(8)));
typedef short bf16x4 __attribute__((ext_vector_type(4)));
typedef float f32x4 __attribute__((ext_vector_type(4)));
typedef float f32x16 __attribute__((ext_vector_type(16)));
typedef unsigned u32x4 __attribute__((ext_vector_type(4)));
typedef unsigned u32x2 __attribute__((ext_vector_type(2)));

constexpr int T_ = 32768, S_ = 8192, DM = 2048, NPROJ = 2816, FF = 5632;
constexpr float LOG2E = 1.4426950408889634f;
constexpr int NTHREADS = 512;
constexpr int LDS_BYTES = 158720;
constexpr int REP_P0 = 1, REP_P1 = 1, REP_MLA = 1, REP_NSA = 1, REP_P8 = 1;

constexpr size_t MiB = 1048576;
constexpr size_t OFF_HN = 0;
constexpr size_t OFF_PROJ = 128 * MiB;
constexpr size_t OFF_QMLA = 304 * MiB;
constexpr size_t OFF_KNOPE = 400 * MiB;
constexpr size_t OFF_VT = 464 * MiB;
constexpr size_t OFF_ACT = 128 * MiB;
constexpr size_t OFF_MIX = 528 * MiB;
constexpr size_t OFF_W = 656 * MiB;
constexpr size_t OFF_WIN = OFF_W;
constexpr size_t OFF_WUQ = OFF_WIN + 2816ull * 2048 * 2;
constexpr size_t OFF_WK = OFF_WUQ + 1536ull * 512 * 2;
constexpr size_t OFF_WV = OFF_WK + 1024ull * 256 * 2;
constexpr size_t OFF_WO = OFF_WV + 1024ull * 256 * 2;
constexpr size_t OFF_WGU = OFF_WO + 2048ull * 2048 * 2;
constexpr size_t OFF_WD = OFF_WGU + 11264ull * 2048 * 2;
constexpr size_t OFF_WC1K = OFF_WD + 2048ull * 5632 * 2;
constexpr size_t OFF_WC1V = OFF_WC1K + 256ull * 2048 * 2;
constexpr size_t OFF_WC2K = OFF_WC1V + 256ull * 2048 * 2;
constexpr size_t OFF_WC2V = OFF_WC2K + 256ull * 256 * 2;
constexpr size_t OFF_MISC = 752 * MiB;
constexpr size_t OFF_KROPE = OFF_MISC;
constexpr size_t OFF_KCG = OFF_KROPE + 4 * MiB;
constexpr size_t OFF_VCG = OFF_KCG + 8 * MiB + 65536;
constexpr size_t OFF_VST = OFF_VCG + 8 * MiB + 65536;
constexpr size_t OFF_VWT = OFF_VST + 8 * MiB;
constexpr size_t OFF_HIDK = OFF_VWT + 8 * MiB;
constexpr size_t OFF_HIDV = OFF_HIDK + 2 * MiB;
constexpr size_t OFF_KC = OFF_HIDV + 2 * MiB;
constexpr size_t OFF_VCT = OFF_KC + MiB / 2;
constexpr size_t OFF_RSQ = OFF_VCT + MiB / 2;
constexpr size_t OFF_RSKV = OFF_RSQ + 131072;
constexpr size_t OFF_COS = OFF_RSKV + 131072;
constexpr size_t OFF_SIN = OFF_COS + MiB;
constexpr size_t OFF_BIAS = OFF_SIN + MiB;
constexpr size_t OFF_CTL = OFF_BIAS + 4096;
constexpr size_t OFF_ROWSQ = OFF_CTL + 4096;
constexpr size_t OFF_XS = OFF_ROWSQ + 131072;
constexpr size_t OFF_INVG = OFF_XS + 131072;
constexpr size_t OFF_XBAR = OFF_INVG + 8192;
constexpr size_t WS_END = OFF_XBAR + 16384;

DI unsigned f2bf(float f) { unsigned u = __builtin_bit_cast(unsigned, f); return (u + 0x7fffu + ((u >> 16) & 1u)) >> 16; }
typedef __bf16 hwbf16x2 __attribute__((ext_vector_type(2)));
typedef float f32x2 __attribute__((ext_vector_type(2)));
DI unsigned pk2(float lo, float hi) { const f32x2 v = {lo, hi}; const hwbf16x2 b = __builtin_convertvector(v, hwbf16x2); return __builtin_bit_cast(unsigned, b); }
DI float bf2f(unsigned b) { return __builtin_bit_cast(float, b << 16); }
DI float bflo(unsigned w) { return __builtin_bit_cast(float, w << 16); }
DI float bfhi(unsigned w) { return __builtin_bit_cast(float, w & 0xffff0000u); }
DI float wave_sum(float v) {
#pragma unroll
    for (int o = 1; o < 64; o <<= 1) v += __shfl_xor(v, o);
    return v;
}
DI void swap32(unsigned& a, unsigned& b) { asm volatile("s_nop 1\n\tv_permlane32_swap_b32 %0, %1" : "+v"(a), "+v"(b)); }
DI float xhalf_max(float v) { unsigned a = __builtin_bit_cast(unsigned, v), b = a; swap32(a, b); return fmaxf(__builtin_bit_cast(float, a), __builtin_bit_cast(float, b)); }
DI float xhalf_sum(float v) { unsigned a = __builtin_bit_cast(unsigned, v), b = a; swap32(a, b); return __builtin_bit_cast(float, a) + __builtin_bit_cast(float, b); }
DI float xhalf_partner(float v, int hi) { unsigned a = __builtin_bit_cast(unsigned, v), b = a; swap32(a, b); return __builtin_bit_cast(float, hi ? a : b); }
DI float sum8(float v) {
    v += __builtin_bit_cast(float, __builtin_amdgcn_mov_dpp(__builtin_bit_cast(int, v), 0xB1, 0xF, 0xF, true));
    v += __builtin_bit_cast(float, __builtin_amdgcn_mov_dpp(__builtin_bit_cast(int, v), 0x4E, 0xF, 0xF, true));
    v += __builtin_bit_cast(float, __builtin_amdgcn_mov_dpp(__builtin_bit_cast(int, v), 0x141, 0xF, 0xF, true));
    return v;
}
DI float fexp2(float x) { return __builtin_amdgcn_exp2f(x); }
DI float frcp(float x) { return __builtin_amdgcn_rcpf(x); }
DI float frsq(float x) { return __builtin_amdgcn_rsqf(x); }
DI float fsilu(float v) { return v * frcp(1.f + __expf(-v)); }
DI float fsigmoid(float v) { return frcp(1.f + __expf(-v)); }
#define LDS_WAIT() asm volatile("s_waitcnt lgkmcnt(0)" ::: "memory")
#define MFMA32(a, b, c) __builtin_amdgcn_mfma_f32_32x32x16_bf16((a), (b), (c), 0, 0, 0)
DI int crow(int r, int hi) { return (r & 3) + 8 * (r >> 2) + 4 * hi; }
DI int fresh_tid() { int t = threadIdx.x; asm volatile("" : "+v"(t)); return t; }

struct Params { const float* in[20]; float* out; unsigned char* ws; };

namespace pg8 {
constexpr int BM = 256, BK = 64, HALF = 128, HTB = HALF * BK * 2, STAGE_BYTES = 8 * HTB, NXCD = 8, WGM = 4;
DI int lds_byte(int r, int c) { const int st = (r >> 4) * 2 + (c >> 5), rr = r & 15, cc = c & 31, ob = rr * 64 + cc * 2; return st * 1024 + (ob ^ (((ob >> 9) & 1) << 5)); }
DI void stage_rc(int b, int& R, int& C) { const int st = b / 1024, sb = b % 1024, swz = sb ^ (((sb >> 9) & 1) << 5); R = (st >> 1) * 16 + swz / 64; C = (st & 1) * 32 + (swz % 64) / 2; }
DI int perm32(int rho) { const int n = rho >> 4, i = rho & 15; return 8 * (i >> 2) + 4 * n + (i & 3); }
struct Unit { int pm, pn; };
struct Gemm { const bf16_t* A; const bf16_t* Bt; int M, N, K, lda, ldb; };
struct StaticOrder {
    int nM, nN, nwg, G, c;
    DI void init(int M, int N, int G_, int c_) { nM = M / BM; nN = N / BM; nwg = nM * nN; G = G_; c = c_; }
    DI bool next(int i, Unit& u) const {
        const long L = (long)i * G + c; if (L >= nwg) return false;
        int wgid = (int)L; { const int q = nwg / NXCD, r = nwg % NXCD, xcd = wgid % NXCD, off = wgid / NXCD; wgid = (xcd < r ? xcd * (q + 1) : r * (q + 1) + (xcd - r) * q) + off; }
        const int nig = WGM * nN, gid = wgid / nig, fm = gid * WGM, gsz = (nM - fm) < WGM ? (nM - fm) : WGM;
        u.pm = fm + ((wgid % nig) % gsz); u.pn = (wgid % nig) / gsz; return true;
    }
};

enum { EPI_STORE = 0, EPI_Q = 1, EPI_VT = 2, EPI_SILU = 3, EPI_VCT = 4, EPI_RESID = 5, EPI_SWIGLU = 6, EPI_RESID_NORM = 7, EPI_RESID_BF = 8 };
struct Epi {
    int mode; bf16_t* O; int ldc; int ncols; const float* rscale; float qscale; const float* cosT; const float* sinT; const float* bias; const float* resid; float* outf; float* rowsq;
    DI void operator()(const f32x4 (&acc)[2][2][4][2], const Unit& u, int wr, int wc, int fr, int fq) const {
        const int row0 = u.pm * BM + wr * 64 + fr, col0 = u.pn * BM + wc * 32 + 8 * fq;
#pragma unroll
        for (int ai = 0; ai < 2; ++ai)
#pragma unroll
            for (int m = 0; m < 4; ++m) {
                const int row = row0 + ai * HALF + m * 16;
                float rs = 1.f, rowacc = 0.f;
                if (mode == EPI_STORE || mode == EPI_Q) { if (rscale) rs = rscale[row]; }
                if (mode == EPI_SWIGLU) rs = frsq(rowsq[row] * (1.0f / DM) + 1e-6f);
#pragma unroll
                for (int bj = 0; bj < 2; ++bj) {
                    const int col = col0 + bj * HALF;
                    f32x4 v0 = acc[ai][bj][m][0], v1 = acc[ai][bj][m][1];
                    if (mode == EPI_STORE) {
                        if (col < ncols) { v0 = v0 * rs; v1 = v1 * rs; u32x4 w; w.x = pk2(v0[0], v0[1]); w.y = pk2(v0[2], v0[3]); w.z = pk2(v1[0], v1[1]); w.w = pk2(v1[2], v1[3]);
                            *(u32x4*)(O + (size_t)row * ldc + col) = w; }
                    } else if (mode == EPI_Q) {
                        const float sc = rs * qscale; v0 = v0 * sc; v1 = v1 * sc;
                        const int c192 = col % 192;
                        if (c192 >= 128) {
                            const int i0 = (c192 - 128) >> 1, pos = row & (S_ - 1);
                            const f32x4 cs = *(const f32x4*)(cosT + pos * 32 + i0), sn = *(const f32x4*)(sinT + pos * 32 + i0);
                            float a, b;
                            a = v0[0]; b = v0[1]; v0[0] = a * cs[0] - b * sn[0]; v0[1] = a * sn[0] + b * cs[0];
                            a = v0[2]; b = v0[3]; v0[2] = a * cs[1] - b * sn[1]; v0[3] = a * sn[1] + b * cs[1];
                            a = v1[0]; b = v1[1]; v1[0] = a * cs[2] - b * sn[2]; v1[1] = a * sn[2] + b * cs[2];
                            a = v1[2]; b = v1[3]; v1[2] = a * cs[3] - b * sn[3]; v1[3] = a * sn[3] + b * cs[3];
                        }
                        u32x4 w; w.x = pk2(v0[0], v0[1]); w.y = pk2(v0[2], v0[3]); w.z = pk2(v1[0], v1[1]); w.w = pk2(v1[2], v1[3]);
                        *(u32x4*)(O + (size_t)row * ldc + col) = w;
                    } else if (mode == EPI_VT) {
                        const f32x4 s0 = *(const f32x4*)(rscale + col), s1 = *(const f32x4*)(rscale + col + 4);
                        v0 = v0 * s0; v1 = v1 * s1;
                        u32x4 w; w.x = pk2(v0[0], v0[1]); w.y = pk2(v0[2], v0[3]); w.z = pk2(v1[0], v1[1]); w.w = pk2(v1[2], v1[3]);
                        *(u32x4*)(O + (size_t)row * ldc + col) = w;
                    } else if (mode == EPI_SILU) {
                        const f32x4 b0 = *(const f32x4*)(bias + col), b1 = *(const f32x4*)(bias + col + 4);
                        v0 = v0 + b0; v1 = v1 + b1;
                        u32x4 w; w.x = pk2(fsilu(v0[0]), fsilu(v0[1])); w.y = pk2(fsilu(v0[2]), fsilu(v0[3])); w.z = pk2(fsilu(v1[0]), fsilu(v1[1])); w.w = pk2(fsilu(v1[2]), fsilu(v1[3]));
                        *(u32x4*)(O + (size_t)row * ldc + col) = w;
                    } else if (mode == EPI_VCT) {
                        if (row < 64) { u32x4 w; w.x = pk2(v0[0], v0[1]); w.y = pk2(v0[2], v0[3]); w.z = pk2(v1[0], v1[1]); w.w = pk2(v1[2], v1[3]);
                            *(u32x4*)(O + ((size_t)((col >> 9) * 64 + row)) * 512 + (col & 511)) = w; }
                    } else if (mode == EPI_RESID) {
                        const size_t ix = (size_t)row * DM + col;
                        const f32x4 r0 = *(const f32x4*)(resid + ix), r1 = *(const f32x4*)(resid + ix + 4);
                        *(f32x4*)(outf + ix) = v0 + r0; *(f32x4*)(outf + ix + 4) = v1 + r1;
                    } else if (mode == EPI_RESID_BF) {
                        const size_t ix = (size_t)row * DM + col;
                        const u32x4 rb = *(const u32x4*)(O + ix);
                        v0[0] += bflo(rb.x); v0[1] += bfhi(rb.x); v0[2] += bflo(rb.y); v0[3] += bfhi(rb.y);
                        v1[0] += bflo(rb.z); v1[1] += bfhi(rb.z); v1[2] += bflo(rb.w); v1[3] += bfhi(rb.w);
                        u32x4 w; w.x = pk2(v0[0], v0[1]); w.y = pk2(v0[2], v0[3]); w.z = pk2(v1[0], v1[1]); w.w = pk2(v1[2], v1[3]);
                        *(u32x4*)(O + ix) = w;
                    } else if (mode == EPI_RESID_NORM) {
                        const size_t ix = (size_t)row * DM + col;
                        f32x4 r0, r1;
                        if (resid) { r0 = *(const f32x4*)(resid + ix); r1 = *(const f32x4*)(resid + ix + 4); }
                        else {
                            const u32x4 hb = *(const u32x4*)(O + ix); const float xr = rscale[row];
                            const f32x4 i0 = *(const f32x4*)(bias + col), i1 = *(const f32x4*)(bias + col + 4);
                            r0[0] = bflo(hb.x) * xr * i0[0]; r0[1] = bfhi(hb.x) * xr * i0[1]; r0[2] = bflo(hb.y) * xr * i0[2]; r0[3] = bfhi(hb.y) * xr * i0[3];
                            r1[0] = bflo(hb.z) * xr * i1[0]; r1[1] = bfhi(hb.z) * xr * i1[1]; r1[2] = bflo(hb.w) * xr * i1[2]; r1[3] = bfhi(hb.w) * xr * i1[3];
                        }
                        v0 = v0 + r0; v1 = v1 + r1;
                        if (outf) { *(f32x4*)(outf + ix) = v0; *(f32x4*)(outf + ix + 4) = v1; }
                        u32x4 w; w.x = pk2(v0[0], v0[1]); w.y = pk2(v0[2], v0[3]); w.z = pk2(v1[0], v1[1]); w.w = pk2(v1[2], v1[3]);
                        *(u32x4*)(O + ix) = w;
                        rowacc += (v0[0] * v0[0] + v0[1] * v0[1]) + (v0[2] * v0[2] + v0[3] * v0[3]) + (v1[0] * v1[0] + v1[1] * v1[1]) + (v1[2] * v1[2] + v1[3] * v1[3]);
                    } else {
                        v0 = v0 * rs; v1 = v1 * rs;
                        u32x2 w; w.x = pk2(fsilu(v0[0]) * v1[0], fsilu(v0[1]) * v1[1]); w.y = pk2(fsilu(v0[2]) * v1[2], fsilu(v0[3]) * v1[3]);
                        *(u32x2*)(O + (size_t)row * ldc + (col >> 1)) = w;
                    }
                }
                if (mode == EPI_RESID_NORM) {
                    rowacc += __shfl_xor(rowacc, 16); rowacc += __shfl_xor(rowacc, 32);
                    if (fq == 0) atomicAdd(rowsq + row, rowacc);
                }
            }
    }
};

DI void gemm_phase(LAS unsigned char* lds, const Gemm g, const StaticOrder& S, const Epi& E) {
    const int tid = fresh_tid(), wid = __builtin_amdgcn_readfirstlane(tid >> 6), lane = tid & 63, wr = wid >> 2, wc = wid & 3, fr = lane & 15, fq = lane >> 4;
    const int K = g.K, nt = K / BK;
    unsigned voffA[2], voffB[2];
#pragma unroll
    for (int i = 0; i < 2; ++i) { int R, C; stage_rc(tid * 16 + i * 8192, R, C); const int Rb = (R & ~31) + perm32(R & 31);
        voffA[i] = (unsigned)(R * g.lda + C) * 2u; voffB[i] = (unsigned)(Rb * g.ldb + C) * 2u; }
    const size_t kstep = (size_t)(BK * 2);
    const size_t hsA = (size_t)HALF * g.lda * 2, hsB = (size_t)HALF * g.ldb * 2;
    const size_t tsA = 2 * hsA, tsB = 2 * hsB;
    const unsigned ldsw = (unsigned)wid * 1024u;
    const int aoff = lds_byte(wr * 64 + fr, fq * 8), boff = lds_byte(wc * 32 + fr, fq * 8);
#define PG8_SA(b, h) (((b) * 2 + (h)) * HTB)
#define PG8_SB(b, h) ((4 + (b) * 2 + (h)) * HTB)
#define PG8_STAGE(bufoff, gbase, voff) do { _Pragma("unroll") for (int _i = 0; _i < 2; ++_i) \
        __builtin_amdgcn_global_load_lds((const unsigned*)((const char*)(gbase) + (voff)[_i]), (LAS unsigned*)(lds + (bufoff) + ldsw + _i * 8192), 16, 0, 0); } while (0)
#define PG8_LDA(dst, b, h) do { _Pragma("unroll") for (int m = 0; m < 4; ++m) _Pragma("unroll") for (int k = 0; k < 2; ++k) dst[m][k] = *(const LAS bf16x8*)(lds + PG8_SA(b, h) + aoff + m * 2048 + k * 1024); } while (0)
#define PG8_LDB(dst, b, h) do { _Pragma("unroll") for (int n = 0; n < 2; ++n) _Pragma("unroll") for (int k = 0; k < 2; ++k) dst[n][k] = *(const LAS bf16x8*)(lds + PG8_SB(b, h) + boff + n * 2048 + k * 1024); } while (0)
#define PG8_MMA(ai, bj, At, Bt) do { __builtin_amdgcn_s_setprio(1); _Pragma("unroll") for (int m = 0; m < 4; ++m) _Pragma("unroll") for (int n = 0; n < 2; ++n) _Pragma("unroll") for (int k = 0; k < 2; ++k) \
        acc[ai][bj][m][n] = __builtin_amdgcn_mfma_f32_16x16x32_bf16(Bt[n][k], At[m][k], acc[ai][bj][m][n], 0, 0, 0); __builtin_amdgcn_s_setprio(0); } while (0)
#define PG8_WAIT_V(n) asm volatile("s_waitcnt vmcnt(" #n ")" ::: "memory")
#define PG8_WAIT_L(n) asm volatile("s_waitcnt lgkmcnt(" #n ")" ::: "memory")
#define PG8_BAR __builtin_amdgcn_s_barrier()
#define PG8_SCHED __builtin_amdgcn_sched_barrier(0)
    Unit cur, nxt; int ui = 0;
    if (!S.next(0, cur)) return;
    f32x4 acc[2][2][4][2];
#pragma unroll
    for (int a = 0; a < 2; ++a)
#pragma unroll
        for (int b = 0; b < 2; ++b)
#pragma unroll
            for (int m = 0; m < 4; ++m)
#pragma unroll
                for (int n = 0; n < 2; ++n) acc[a][b][m][n] = (f32x4){0.f, 0.f, 0.f, 0.f};
    bf16x8 At[4][2], B0[2][2], B1[2][2];
    const char* cA = (const char*)g.A + (size_t)cur.pm * tsA; const char* cB = (const char*)g.Bt + (size_t)cur.pn * tsB;
    PG8_STAGE(PG8_SB(0, 0), cB, voffB); PG8_STAGE(PG8_SB(0, 1), cB + hsB, voffB); PG8_STAGE(PG8_SA(0, 0), cA, voffA); PG8_STAGE(PG8_SA(0, 1), cA + hsA, voffA);
    if (wr == 1) PG8_BAR;
    PG8_WAIT_V(2); PG8_BAR;
    PG8_STAGE(PG8_SB(1, 0), cB + kstep, voffB); PG8_STAGE(PG8_SA(1, 0), cA + kstep, voffA); PG8_STAGE(PG8_SB(1, 1), cB + hsB + kstep, voffB);
    PG8_WAIT_V(6); PG8_BAR;
    for (;;) {
        const bool has_next = S.next(ui + 1, nxt);
        const char* nA = has_next ? (const char*)g.A + (size_t)nxt.pm * tsA : cA; const char* nB = has_next ? (const char*)g.Bt + (size_t)nxt.pn * tsB : cB;
        for (int t = 0; t < nt; t += 2) {
            const bool last = (t == nt - 2);
            const char* a1 = cA + (size_t)(t + 1) * kstep;
            const char* a2 = last ? nA : cA + (size_t)(t + 2) * kstep; const char* b2 = last ? nB : cB + (size_t)(t + 2) * kstep;
            const char* a3 = a2 + kstep; const char* b3 = b2 + kstep;
            PG8_LDB(B0, 0, 0); PG8_LDB(B1, 0, 1); PG8_SCHED; PG8_LDA(At, 0, 0); PG8_STAGE(PG8_SA(1, 1), a1 + hsA, voffA);
            PG8_WAIT_V(8); PG8_WAIT_L(0); PG8_BAR; PG8_MMA(0, 0, At, B0); PG8_MMA(0, 1, At, B1); PG8_BAR; PG8_SCHED;
            PG8_LDA(At, 0, 1); PG8_STAGE(PG8_SB(0, 0), b2, voffB); PG8_STAGE(PG8_SB(0, 1), b2 + hsB, voffB); PG8_STAGE(PG8_SA(0, 0), a2, voffA);
            PG8_WAIT_V(8); PG8_WAIT_L(0); PG8_BAR; PG8_MMA(1, 0, At, B0); PG8_MMA(1, 1, At, B1); PG8_BAR; PG8_SCHED;
            PG8_LDB(B0, 1, 0); PG8_LDB(B1, 1, 1); PG8_SCHED; PG8_LDA(At, 1, 0); PG8_STAGE(PG8_SA(0, 1), a2 + hsA, voffA);
            PG8_WAIT_V(8); PG8_WAIT_L(0); PG8_BAR; PG8_MMA(0, 0, At, B0); PG8_MMA(0, 1, At, B1); PG8_BAR; PG8_SCHED;
            PG8_LDA(At, 1, 1); PG8_STAGE(PG8_SB(1, 0), b3, voffB); PG8_STAGE(PG8_SB(1, 1), b3 + hsB, voffB); PG8_STAGE(PG8_SA(1, 0), a3, voffA);
            PG8_WAIT_V(8); PG8_WAIT_L(0); PG8_BAR; PG8_MMA(1, 0, At, B0); PG8_MMA(1, 1, At, B1); PG8_BAR; PG8_SCHED;
        }
        if (wr == 0) PG8_BAR;
        E(acc, cur, wr, wc, fr, fq);
        if (!has_next) break;
#pragma unroll
        for (int a = 0; a < 2; ++a)
#pragma unroll
            for (int b = 0; b < 2; ++b)
#pragma unroll
                for (int m = 0; m < 4; ++m)
#pragma unroll
                    for (int n = 0; n < 2; ++n) acc[a][b][m][n] = (f32x4){0.f, 0.f, 0.f, 0.f};
        cur = nxt; cA = nA; cB = nB; ++ui;
        if (wr == 1) PG8_BAR;
    }
    PG8_WAIT_V(0);
    PG8_BAR;
#undef PG8_SA
#undef PG8_SB
#undef PG8_STAGE
#undef PG8_LDA
#undef PG8_LDB
#undef PG8_MMA
#undef PG8_WAIT_V
#undef PG8_WAIT_L
#undef PG8_BAR
#undef PG8_SCHED
}
}

DI int map_row(int map, int n) {
    if (map == 1) { const int hd = n / 192, c = n - hd * 192; if (c >= 160) return hd * 192 + 128 + 2 * (c - 160) + 1; if (c >= 128) return hd * 192 + 128 + 2 * (c - 128); return n; }
    if (map == 2) return (n >> 2) * 8 + (n & 3);
    if (map == 3) return (n >> 2) * 8 + 4 + (n & 3);
    return n;
}
DI void transpose_item(const float* dW, const float* dks, bf16_t* dWT, int dK, int dN, int dNpad, int dldt, int dmap, LAS float* scr, int item, int lane) {
    const int nblk = dNpad / 32, kb = item / nblk, nb = item - kb * nblk, k0 = 64 * kb, n0 = 32 * nb;
    f32x4 ld[8];
#pragma unroll
    for (int i = 0; i < 8; ++i) {
        const int kk = 8 * i + (lane >> 3), k = k0 + kk, n = n0 + 4 * (lane & 7);
        ld[i] = (f32x4){0.f, 0.f, 0.f, 0.f};
        if (k < dK && n < dN) { ld[i] = *(const f32x4*)(dW + (size_t)k * dN + n); if (dks) ld[i] = ld[i] * dks[k]; }
    }
#pragma unroll
    for (int i = 0; i < 8; ++i) {
        const int kk = 8 * i + (lane >> 3); LAS float* d = scr + kk * 33 + 4 * (lane & 7);
        d[0] = ld[i].x; d[1] = ld[i].y; d[2] = ld[i].z; d[3] = ld[i].w;
    }
    LDS_WAIT();
    const int c = lane & 7;
#pragma unroll
    for (int j = 0; j < 4; ++j) {
        const int n = (lane >> 3) + 8 * j; const LAS float* s = scr + (8 * c) * 33 + n;
        u32x4 o; o.x = pk2(s[0 * 33], s[1 * 33]); o.y = pk2(s[2 * 33], s[3 * 33]); o.z = pk2(s[4 * 33], s[5 * 33]); o.w = pk2(s[6 * 33], s[7 * 33]);
        *(u32x4*)(dWT + (size_t)map_row(dmap, n0 + n) * dldt + k0 + 8 * c) = o;
    }
    LDS_WAIT();
}
DI void norm_row_bf16(const float* xrow, const float* g, bf16_t* orow, int lane, float* xs_out = nullptr) {
    const f32x4* xr = (const f32x4*)xrow + lane; f32x4 v[8]; float s = 0.f;
#pragma unroll
    for (int j = 0; j < 8; ++j) { v[j] = xr[64 * j]; s += (v[j].x * v[j].x + v[j].y * v[j].y) + (v[j].z * v[j].z + v[j].w * v[j].w); }
    s = wave_sum(s);
    const float rs = frsq(s * (1.0f / DM) + 1e-6f);
    if (xs_out && lane == 0) *xs_out = frcp(rs);
    const f32x4* gr = (const f32x4*)g + lane;
    u32x2* o8 = (u32x2*)orow + lane;
#pragma unroll
    for (int j = 0; j < 8; ++j) { const f32x4 gg = gr[64 * j]; u32x2 o; o.x = pk2(v[j].x * rs * gg.x, v[j].y * rs * gg.y); o.y = pk2(v[j].z * rs * gg.z, v[j].w * rs * gg.w); o8[64 * j] = o; }
}
DI void norm_row_f32_inplace(float* xrow, const float* g, int lane) {
    f32x4* xr = (f32x4*)xrow + lane; f32x4 v[8]; float s = 0.f;
#pragma unroll
    for (int j = 0; j < 8; ++j) { v[j] = xr[64 * j]; s += (v[j].x * v[j].x + v[j].y * v[j].y) + (v[j].z * v[j].z + v[j].w * v[j].w); }
    s = wave_sum(s);
    const float rs = frsq(s * (1.0f / DM) + 1e-6f);
    const f32x4* gr = (const f32x4*)g + lane;
#pragma unroll
    for (int j = 0; j < 8; ++j) { const f32x4 gg = gr[64 * j]; xr[64 * j] = v[j] * rs * gg; }
}
DI void norm_row_bf16_to_f32(const bf16_t* xrow, const float* g, float* orow, int lane) {
    u32x4 v[4]; float s = 0.f;
#pragma unroll
    for (int j = 0; j < 4; ++j) {
        v[j] = *((const u32x4*)xrow + lane + 64 * j);
        float f;
        f = bflo(v[j].x); s += f * f; f = bfhi(v[j].x); s += f * f; f = bflo(v[j].y); s += f * f; f = bfhi(v[j].y); s += f * f;
        f = bflo(v[j].z); s += f * f; f = bfhi(v[j].z); s += f * f; f = bflo(v[j].w); s += f * f; f = bfhi(v[j].w); s += f * f;
    }
    s = wave_sum(s);
    const float rs = frsq(s * (1.0f / DM) + 1e-6f);
#pragma unroll
    for (int j = 0; j < 4; ++j) {
        const f32x4 g0 = *((const f32x4*)g + 2 * (lane + 64 * j)), g1 = *((const f32x4*)g + 2 * (lane + 64 * j) + 1);
        f32x4 o0, o1;
        o0.x = bflo(v[j].x) * rs * g0.x; o0.y = bfhi(v[j].x) * rs * g0.y; o0.z = bflo(v[j].y) * rs * g0.z; o0.w = bfhi(v[j].y) * rs * g0.w;
        o1.x = bflo(v[j].z) * rs * g1.x; o1.y = bfhi(v[j].z) * rs * g1.y; o1.z = bflo(v[j].w) * rs * g1.z; o1.w = bfhi(v[j].w) * rs * g1.w;
        *((f32x4*)orow + 2 * (lane + 64 * j)) = o0; *((f32x4*)orow + 2 * (lane + 64 * j) + 1) = o1;
    }
}
DI void sincos_acc(float angf, float& sn, float& cs) {
    const double x = (double)angf;
    const double n = rint(x * 0.15915494309189535);
    double r = fma(-n, 6.283185307179586, x); r = fma(-n, 2.4492935982947064e-16, r);
    const double r2 = r * r;
    double ts = r, ss = r, tc = 1.0, cc = 1.0;
    for (int k = 1; k <= 13; ++k) {
        ts *= -r2 / (double)((2 * k) * (2 * k + 1)); ss += ts;
        tc *= -r2 / (double)((2 * k - 1) * (2 * k)); cc += tc;
    }
    sn = (float)ss; cs = (float)cc;
}

DI void prologue(const Params& p, LAS unsigned char* lds, int tid, int lane, int wave) {
    unsigned char* ws = p.ws;
    const int gw = blockIdx.x * 8 + wave, NGW = gridDim.x * 8;
    LAS float* scr = (LAS float*)(lds + wave * 16384);
    constexpr int I0 = 32 * 88, I1 = I0 + 8 * 48, I2 = I1 + 4 * 32, I3 = I2 + 4 * 32, I4 = I3 + 32 * 64, I5 = I4 + 32 * 176, I6 = I5 + 32 * 176, I7 = I6 + 88 * 64,
                  I8 = I7 + 32 * 8, I9 = I8 + 32 * 8, I10 = I9 + 4 * 8, I11 = I10 + 4 * 8;
    typedef const float* cfp;
    LAS cfp* PTg = (LAS cfp*)(lds + 158208);
    if (tid == 0) { PTg[2] = p.in[2]; PTg[3] = p.in[3]; PTg[4] = p.in[4]; PTg[5] = p.in[5]; PTg[6] = p.in[6]; PTg[7] = p.in[7]; PTg[10] = p.in[10]; PTg[11] = p.in[11];
                    PTg[12] = p.in[12]; PTg[13] = p.in[13]; PTg[14] = p.in[14]; PTg[15] = p.in[15]; PTg[16] = p.in[16]; PTg[17] = p.in[17]; PTg[18] = p.in[18]; PTg[0] = nullptr; }
    __syncthreads();
    for (int it = gw; it < I11; it += NGW) {
        int ii, ksi, dK, dN, dNpad, dldt, dmap, i0; size_t off;
        if (it < I0)       { ii = 2;  ksi = 0;  off = OFF_WIN;  dK = 2048; dN = 2672; dNpad = 2816; dldt = 2048; dmap = 0; i0 = 0; }
        else if (it < I1)  { ii = 5;  ksi = 3;  off = OFF_WUQ;  dK = 512;  dN = 1536; dNpad = 1536; dldt = 512;  dmap = 1; i0 = I0; }
        else if (it < I2)  { ii = 6;  ksi = 4;  off = OFF_WK;   dK = 256;  dN = 1024; dNpad = 1024; dldt = 256;  dmap = 0; i0 = I1; }
        else if (it < I3)  { ii = 7;  ksi = 4;  off = OFF_WV;   dK = 256;  dN = 1024; dNpad = 1024; dldt = 256;  dmap = 0; i0 = I2; }
        else if (it < I4)  { ii = 14; ksi = 0;  off = OFF_WO;   dK = 2048; dN = 2048; dNpad = 2048; dldt = 2048; dmap = 0; i0 = I3; }
        else if (it < I5)  { ii = 16; ksi = 15; off = OFF_WGU;  dK = 2048; dN = 5632; dNpad = 5632; dldt = 2048; dmap = 2; i0 = I4; }
        else if (it < I6)  { ii = 17; ksi = 15; off = OFF_WGU;  dK = 2048; dN = 5632; dNpad = 5632; dldt = 2048; dmap = 3; i0 = I5; }
        else if (it < I7)  { ii = 18; ksi = 0;  off = OFF_WD;   dK = 5632; dN = 2048; dNpad = 2048; dldt = 5632; dmap = 0; i0 = I6; }
        else if (it < I8)  { ii = 10; ksi = 0;  off = OFF_WC1K; dK = 2048; dN = 128;  dNpad = 256;  dldt = 2048; dmap = 0; i0 = I7; }
        else if (it < I9)  { ii = 12; ksi = 0;  off = OFF_WC1V; dK = 2048; dN = 128;  dNpad = 256;  dldt = 2048; dmap = 0; i0 = I8; }
        else if (it < I10) { ii = 11; ksi = 0;  off = OFF_WC2K; dK = 128;  dN = 64;   dNpad = 256;  dldt = 256;  dmap = 0; i0 = I9; }
        else               { ii = 13; ksi = 0;  off = OFF_WC2V; dK = 128;  dN = 64;   dNpad = 256;  dldt = 256;  dmap = 0; i0 = I10; }
        transpose_item(PTg[ii], PTg[ksi], (bf16_t*)(ws + off), dK, dN, dNpad, dldt, dmap, scr, it - i0, lane);
    }
    bf16_t* HN = (bf16_t*)(ws + OFF_HN);
    float* XS = (float*)(ws + OFF_XS);
    for (int m = gw; m < T_; m += NGW) norm_row_bf16(p.in[0] + (size_t)m * DM, p.in[1], HN + (size_t)m * DM, lane, XS + m);
    { float* INVG = (float*)(ws + OFF_INVG); for (int i = blockIdx.x * NTHREADS + tid; i < DM; i += gridDim.x * NTHREADS) INVG[i] = frcp(p.in[1][i]); }
    float* COS = (float*)(ws + OFF_COS); float* SIN = (float*)(ws + OFF_SIN);
    for (int idx = blockIdx.x * NTHREADS + tid; idx < S_ * 32; idx += gridDim.x * NTHREADS) {
        const int pos = idx >> 5, i = idx & 31;
        const float inv = exp2f(-(float)i * (13.287712379549449f / 32.0f));
        const float ang = (float)pos * inv;
        float sn, cs; sincos_acc(ang, sn, cs);
        COS[idx] = cs; SIN[idx] = sn;
    }
    float* BIAS = (float*)(ws + OFF_BIAS);
    if (gw < 256) {
        const int which = gw >> 7, j = gw & 127;
        const float* W = which ? p.in[12] : p.in[10]; const float* pe = which ? p.in[9] : p.in[8];
        float s = 0.f;
        for (int k = lane; k < 2048; k += 64) s += pe[k] * W[(size_t)k * 128 + j];
        s = wave_sum(s);
        if (lane == 0) { BIAS[which * 256 + j] = s; BIAS[which * 256 + 128 + j] = 0.f; }
    }
    { unsigned* ctl = (unsigned*)(ws + OFF_CTL); float* rowsq = (float*)(ws + OFF_ROWSQ);
      for (int i = blockIdx.x * NTHREADS + tid; i < T_; i += gridDim.x * NTHREADS) { rowsq[i] = 0.f; if (i < 1024) ctl[i] = 0u; } }
    if (blockIdx.x == 1 % gridDim.x) { unsigned* xb = (unsigned*)(ws + OFF_XBAR); for (int i = tid; i < 4096; i += NTHREADS) xb[i] = 0u; }
    if (blockIdx.x == 0) {
        bf16_t* KCg = (bf16_t*)(ws + OFF_KCG) + (size_t)8 * S_ * 64; bf16_t* VCg = (bf16_t*)(ws + OFF_VCG) + (size_t)8 * S_ * 64;
        for (int i = tid; i < 4096; i += NTHREADS) { KCg[i] = 0; VCg[i] = 0; }
    }
}

DI void postproj_tile(const Params& p, LAS unsigned char* lds, int tile, int tid, int lane, int wave) {
    unsigned char* ws = p.ws;
    const bf16_t* PROJ = (const bf16_t*)(ws + OFF_PROJ);
    const int tok0 = tile * 64, b = tok0 >> 13, s0 = tok0 & (S_ - 1);
    LAS bf16_t* tl = (LAS bf16_t*)lds;
#pragma unroll
    for (int i = 0; i < 4; ++i) {
        const int q = tid + 512 * i, mat = q >> 10, r = (q >> 4) & 63, ch = q & 15;
        const u32x4 v = *(const u32x4*)(PROJ + (size_t)(tok0 + r) * NPROJ + (mat ? 2496 : 2240) + 8 * ch);
        *(LAS u32x4*)(tl + (mat * 64 + r) * 136 + 8 * ch) = v;
    }
    __syncthreads();
    bf16_t* VST = (bf16_t*)(ws + OFF_VST); bf16_t* VWT = (bf16_t*)(ws + OFF_VWT);
#pragma unroll
    for (int i = 0; i < 4; ++i) {
        const int q = tid + 512 * i, mat = q >> 10, c = (q >> 3) & 127, j8 = q & 7;
        unsigned e[8];
#pragma unroll
        for (int k = 0; k < 8; ++k) e[k] = tl[(mat * 64 + 8 * j8 + k) * 136 + c];
        u32x4 o; o.x = e[0] | (e[1] << 16); o.y = e[2] | (e[3] << 16); o.z = e[4] | (e[5] << 16); o.w = e[6] | (e[7] << 16);
        const int g = c >> 6, d = c & 63;
        bf16_t* dst = (mat ? VWT : VST) + ((size_t)((b * 2 + g) * 64 + d)) * S_ + s0 + 8 * j8;
        *(u32x4*)dst = o;
    }
    float* RSQ = (float*)(ws + OFF_RSQ); float* RSKV = (float*)(ws + OFF_RSKV);
    const float* COS = (const float*)(ws + OFF_COS); const float* SIN = (const float*)(ws + OFF_SIN);
    bf16_t* KROPE = (bf16_t*)(ws + OFF_KROPE); bf16_t* KCg = (bf16_t*)(ws + OFF_KCG); bf16_t* VCg = (bf16_t*)(ws + OFF_VCG);
    for (int rr = 0; rr < 8; ++rr) {
        const int r = wave * 8 + rr, tok = tok0 + r, s = s0 + r;
        const bf16_t* pr = PROJ + (size_t)tok * NPROJ;
        const u32x4 a = *(const u32x4*)(pr + 8 * lane);
        float sq = 0.f;
        { float f; f = bflo(a.x); sq += f * f; f = bfhi(a.x); sq += f * f; f = bflo(a.y); sq += f * f; f = bfhi(a.y); sq += f * f;
          f = bflo(a.z); sq += f * f; f = bfhi(a.z); sq += f * f; f = bflo(a.w); sq += f * f; f = bfhi(a.w); sq += f * f; }
        sq = wave_sum(sq);
        const u32x2 c2 = *(const u32x2*)(pr + 512 + 4 * lane);
        float sk = 0.f;
        { float f; f = bflo(c2.x); sk += f * f; f = bfhi(c2.x); sk += f * f; f = bflo(c2.y); sk += f * f; f = bfhi(c2.y); sk += f * f; }
        sk = wave_sum(sk);
        if (lane == 0) { RSQ[tok] = frsq(sq * (1.0f / 512.0f) + 1e-6f); RSKV[tok] = frsq(sk * (1.0f / 256.0f) + 1e-6f); }
        if (lane < 32) {
            const float x1 = bf2f(pr[768 + lane]), x2 = bf2f(pr[800 + lane]);
            const float cs = COS[s * 32 + lane], sn = SIN[s * 32 + lane];
            *(unsigned*)(KROPE + (size_t)tok * 64 + 2 * lane) = pk2(x1 * cs - x2 * sn, x1 * sn + x2 * cs);
        }
        const int g = lane >> 5, d = (2 * lane) & 63;
        const unsigned kc2 = *(const unsigned*)(pr + 1856 + 2 * lane);
        *(unsigned*)(KCg + ((size_t)((b * 2 + g) * S_ + s)) * 64 + d) = kc2;
        const unsigned vc2 = *(const unsigned*)(pr + 1984 + 2 * lane);
        *(unsigned*)(VCg + ((size_t)((b * 2 + g) * S_ + s)) * 64 + d) = vc2;
    }
    __syncthreads();
}

constexpr int MLA_BUF = 43008;
DI void mla_load(const bf16_t* KNOPE, const bf16_t* KROPE, const bf16_t* VT, int h, size_t tokb, int kt, u32x4 (&r)[5], int tid) {
#pragma unroll
    for (int i = 0; i < 2; ++i) { const int q = tid + 512 * i, key = q >> 4, ch = q & 15;
        r[i] = *(const u32x4*)(KNOPE + (tokb + kt * 64 + key) * 1024 + h * 128 + 8 * ch); }
    { const int key = tid >> 3, ch = tid & 7; r[2] = *(const u32x4*)(KROPE + (tokb + kt * 64 + key) * 64 + 8 * ch); }
#pragma unroll
    for (int i = 0; i < 2; ++i) { const int q = tid + 512 * i, d = q >> 3, ch = q & 7;
        r[3 + i] = *(const u32x4*)(VT + (size_t)(h * 128 + d) * T_ + tokb + kt * 64 + 8 * ch); }
}
DI void mla_store(LAS unsigned char* buf, const u32x4 (&r)[5], int tid) {
#pragma unroll
    for (int i = 0; i < 2; ++i) { const int q = tid + 512 * i, key = q >> 4, ch = q & 15; *(LAS u32x4*)(buf + key * 400 + ch * 16) = r[i]; }
    { const int key = tid >> 3, ch = tid & 7; *(LAS u32x4*)(buf + key * 400 + 256 + ch * 16) = r[2]; }
#pragma unroll
    for (int i = 0; i < 2; ++i) { const int q = tid + 512 * i, d = q >> 3, ch = q & 7; LAS unsigned char* vp = buf + 25600 + d * 136 + ch * 16;
        *(LAS u32x2*)vp = (u32x2){r[3 + i].x, r[3 + i].y}; *(LAS u32x2*)(vp + 8) = (u32x2){r[3 + i].z, r[3 + i].w}; }
}
DI bf16x8 cat4(bf16x4 lo, bf16x4 hi) { bf16x8 r; r[0] = lo[0]; r[1] = lo[1]; r[2] = lo[2]; r[3] = lo[3]; r[4] = hi[0]; r[5] = hi[1]; r[6] = hi[2]; r[7] = hi[3]; return r; }
DI bf16x8 packp(const f32x16& s, int t) {
    u32x4 w;
    if (t == 0) { w.x = pk2(s[0], s[1]); w.y = pk2(s[2], s[3]); w.z = pk2(s[4], s[5]); w.w = pk2(s[6], s[7]); }
    else { w.x = pk2(s[8], s[9]); w.y = pk2(s[10], s[11]); w.z = pk2(s[12], s[13]); w.w = pk2(s[14], s[15]); }
    return __builtin_bit_cast(bf16x8, w);
}

DI float vmax3(float a, float b, float c) { float r; asm("v_max3_f32 %0, %1, %2, %3" : "=v"(r) : "v"(a), "v"(b), "v"(c)); return r; }
DI float max16(const f32x16& s) {
    float a = vmax3(s[0], s[1], s[2]), b = vmax3(s[3], s[4], s[5]), c = vmax3(s[6], s[7], s[8]), d = vmax3(s[9], s[10], s[11]);
    a = vmax3(a, s[12], s[13]); b = vmax3(b, s[14], s[15]);
    return vmax3(vmax3(a, b, c), d, d);
}
DI void mla_unit(const Params& p, LAS unsigned char* lds, int b, int h, int qb, int tid) {
    unsigned char* ws = p.ws;
    const bf16_t* QMLA = (const bf16_t*)(ws + OFF_QMLA); const bf16_t* KNOPE = (const bf16_t*)(ws + OFF_KNOPE);
    const bf16_t* KROPE = (const bf16_t*)(ws + OFF_KROPE); const bf16_t* VT = (const bf16_t*)(ws + OFF_VT);
    bf16_t* MIX = (bf16_t*)(ws + OFF_MIX);
    const int lane = tid & 63, w = __builtin_amdgcn_readfirstlane(tid >> 6), c = lane & 31, hi = lane >> 5;
    const int q0 = qb * 256, qw0 = q0 + 32 * w, qpos = qw0 + c;
    const size_t tokb = (size_t)b * S_;
    bf16x8 qf[12];
    { const bf16_t* qp = QMLA + (tokb + qpos) * 1536 + h * 192 + 8 * hi;
#pragma unroll
      for (int st = 0; st < 12; ++st) qf[st] = *(const bf16x8*)(qp + 16 * st); }
    f32x16 o[4];
#pragma unroll
    for (int db = 0; db < 4; ++db)
#pragma unroll
        for (int i = 0; i < 16; ++i) o[db][i] = 0.f;
    float m = -1e20f, l = 0.f;
    const int nkt = 4 * qb + 4;
    u32x4 r[5];
    __syncthreads();
    mla_load(KNOPE, KROPE, VT, h, tokb, 0, r, tid); mla_store(lds, r, tid);
    __syncthreads();
    for (int kt = 0; kt < nkt; ++kt) {
        const bool more = kt + 1 < nkt;
        if (more) mla_load(KNOPE, KROPE, VT, h, tokb, kt + 1, r, tid);
        LAS const unsigned char* buf = lds + (kt & 1) * MLA_BUF;
        if (kt * 64 <= qw0 + 31) {
#pragma unroll
            for (int sub = 0; sub < 2; ++sub) {
                const int kbase = kt * 64 + 32 * sub;
                f32x16 s;
#pragma unroll
                for (int i = 0; i < 16; ++i) s[i] = 0.f;
#pragma unroll
                for (int st = 0; st < 12; ++st) {
                    const bf16x8 a = *(LAS const bf16x8*)(buf + (32 * sub + c) * 400 + st * 32 + hi * 16);
                    s = MFMA32(a, qf[st], s);
                }
                if (kbase + 31 > qw0) {
                    int dbase = qpos - kbase - 4 * hi;
                    asm volatile("" : "+v"(dbase));
#pragma unroll
                    for (int i = 0; i < 16; ++i) if ((dbase - ((i & 3) + 8 * (i >> 2))) < 0) s[i] = -1e30f;
                }
                float mx = max16(s);
                mx = xhalf_max(mx);
                const float mn = (mx > m + 8.f) ? mx : m, alpha = fexp2(m - mn); m = mn; l *= alpha;
                if (__any(alpha != 1.f)) {
#pragma unroll
                    for (int db = 0; db < 4; ++db) o[db] = o[db] * alpha;
                }
                float ps = 0.f;
#pragma unroll
                for (int i = 0; i < 16; ++i) { const float pv = fexp2(s[i] - m); s[i] = pv; ps += pv; }
                l += ps;
                const bf16x8 pb0 = packp(s, 0), pb1 = packp(s, 1);
#pragma unroll
                for (int db = 0; db < 4; ++db) {
                    LAS const unsigned char* ap = buf + 25600 + (32 * db + c) * 136 + (32 * sub + 4 * hi) * 2;
                    const bf16x8 v0 = cat4(*(LAS const bf16x4*)(ap), *(LAS const bf16x4*)(ap + 16));
                    const bf16x8 v1 = cat4(*(LAS const bf16x4*)(ap + 32), *(LAS const bf16x4*)(ap + 48));
                    o[db] = MFMA32(v0, pb0, o[db]); o[db] = MFMA32(v1, pb1, o[db]);
                }
            }
        }
        if (more) mla_store(lds + ((kt + 1) & 1) * MLA_BUF, r, tid);
        __syncthreads();
    }
    const float lt = xhalf_sum(l), inv = frcp(lt);
    bf16_t* op = MIX + (tokb + qpos) * 2048 + h * 128 + 4 * hi;
#pragma unroll
    for (int db = 0; db < 4; ++db)
#pragma unroll
        for (int g4 = 0; g4 < 4; ++g4) {
            u32x2 wv; wv.x = pk2(o[db][4 * g4] * inv, o[db][4 * g4 + 1] * inv); wv.y = pk2(o[db][4 * g4 + 2] * inv, o[db][4 * g4 + 3] * inv);
            *(u32x2*)(op + 32 * db + 8 * g4) = wv;
        }
}

constexpr int NSA_KC = 0, NSA_VCT = 73728, NSA_IMP = 140288, NSA_SEL = 156672, NSA_UNI = 157184, NSA_NL = 157200, NSA_LIST = 157216;
constexpr int NSA_TBUF = 17920;

template <int MODE>
DI void nsa_tile(LAS const unsigned char* buf, const bf16x8 (&qf)[4], f32x16 (&o)[2], float& m, float& l, int kbase0, int t, bool lanesel, float slope2, int c, int hi) {
#pragma unroll
    for (int sub = 0; sub < 2; ++sub) {
        const int klo = kbase0 + 32 * sub;
        bool full, none;
        if (MODE == 0) { full = lanesel && (klo + 31 <= t); none = !lanesel || (klo > t); }
        else { full = (klo + 31 <= t) && (klo >= t - 511); none = (klo > t) || (klo + 31 < t - 511); }
        if (__all(none)) continue;
        int dbase = t - klo - 4 * hi;
        asm volatile("" : "+v"(dbase));
        const float b0 = none ? -1e30f : -slope2 * (float)dbase;
        f32x16 s;
#pragma unroll
        for (int i = 0; i < 16; ++i) s[i] = fmaf(slope2, (float)((i & 3) + 8 * (i >> 2)), b0);
#pragma unroll
        for (int st = 0; st < 4; ++st) {
            const bf16x8 a = *(LAS const bf16x8*)(buf + (32 * sub + c) * 144 + st * 32 + hi * 16);
            s = MFMA32(a, qf[st], s);
        }
        if (__any(!full && !none)) {
#pragma unroll
            for (int i = 0; i < 16; ++i) {
                const int dist = dbase - ((i & 3) + 8 * (i >> 2));
                const bool valid = (MODE == 0) ? (lanesel && dist >= 0) : ((unsigned)dist < 512u);
                if (!valid) s[i] = -1e30f;
            }
        }
        float mx = max16(s);
        mx = xhalf_max(mx);
        if (__any(mx > m + 8.f)) {
            const float mn = fmaxf(m, mx), alpha = fexp2(m - mn); m = mn; l *= alpha;
            o[0] = o[0] * alpha; o[1] = o[1] * alpha;
        }
        float ps = 0.f;
#pragma unroll
        for (int i = 0; i < 16; ++i) { const float pv = fexp2(s[i] - m); s[i] = pv; ps += pv; }
        l += ps;
        const bf16x8 pb0 = packp(s, 0), pb1 = packp(s, 1);
#pragma unroll
        for (int db = 0; db < 2; ++db)
#pragma unroll
            for (int tt = 0; tt < 2; ++tt) {
                LAS const unsigned char* ap = buf + 9216 + (32 * db + c) * 136 + (32 * sub + 16 * tt + 4 * hi) * 2;
                const bf16x8 a = cat4(*(LAS const bf16x4*)ap, *(LAS const bf16x4*)(ap + 16));
                o[db] = MFMA32(a, tt == 0 ? pb0 : pb1, o[db]);
            }
    }
}

DI void nsa_unit(const Params& p, LAS unsigned char* lds, unsigned char* ldsg, int bg, int qt, int tid) {
    unsigned char* ws = p.ws;
    const bf16_t* PROJ = (const bf16_t*)(ws + OFF_PROJ);
    const bf16_t* KC = (const bf16_t*)(ws + OFF_KC); const bf16_t* VCT = (const bf16_t*)(ws + OFF_VCT);
    const bf16_t* VST = (const bf16_t*)(ws + OFF_VST); const bf16_t* VWT = (const bf16_t*)(ws + OFF_VWT);
    bf16_t* MIX = (bf16_t*)(ws + OFF_MIX);
    const int lane = tid & 63, w = __builtin_amdgcn_readfirstlane(tid >> 6), c = lane & 31, hi = lane >> 5;
    const int b = bg >> 1, g = bg & 1, q0 = qt * 32;
    const int head = c & 7, qi = c >> 3, tw0 = q0 + 4 * w, t = tw0 + qi, hh = g * 8 + head;
    const size_t tokb = (size_t)b * S_, tok = tokb + t;
    const float sc2 = 0.125f * LOG2E, slope2 = exp2f(-0.5f * (float)(hh + 1)) * LOG2E;

    LAS unsigned* SEL = (LAS unsigned*)(lds + NSA_SEL);
    LAS unsigned* UNI = (LAS unsigned*)(lds + NSA_UNI);
    LAS int* NL = (LAS int*)(lds + NSA_NL);
    LAS int* LIST = (LAS int*)(lds + NSA_LIST);
    LAS float* IMPw = (LAS float*)(lds + NSA_IMP + w * 2048);

    __syncthreads();
    const int nct = (q0 / 16 + 1 + 31) >> 5;
    for (int q0_ = tid; q0_ < nct * 256; q0_ += 4 * NTHREADS) {
        u32x4 v[4];
#pragma unroll
        for (int j = 0; j < 4; ++j) { const int q = q0_ + j * NTHREADS; if (q < nct * 256) v[j] = *(const u32x4*)(KC + ((size_t)(bg * 512 + (q >> 3))) * 64 + 8 * (q & 7)); }
#pragma unroll
        for (int j = 0; j < 4; ++j) { const int q = q0_ + j * NTHREADS; if (q < nct * 256) *(LAS u32x4*)(lds + NSA_KC + (q >> 3) * 144 + (q & 7) * 16) = v[j]; }
    }
    { const int cpr = nct * 4;
      for (int q0_ = tid; q0_ < 64 * cpr; q0_ += 4 * NTHREADS) {
          u32x4 v[4];
#pragma unroll
          for (int j = 0; j < 4; ++j) { const int q = q0_ + j * NTHREADS; if (q < 64 * cpr) { const int d = q / cpr, ch = q - d * cpr; v[j] = *(const u32x4*)(VCT + ((size_t)(bg * 64 + d)) * 512 + 8 * ch); } }
#pragma unroll
          for (int j = 0; j < 4; ++j) { const int q = q0_ + j * NTHREADS; if (q < 64 * cpr) { const int d = q / cpr, ch = q - d * cpr; LAS unsigned char* vp_ = lds + NSA_VCT + d * 1032 + ch * 16; *(LAS u32x2*)vp_ = (u32x2){v[j].x, v[j].y}; *(LAS u32x2*)(vp_ + 8) = (u32x2){v[j].z, v[j].w}; } }
      } }
    if (tid < 4) UNI[tid] = 0u;

    bf16x8 qf[4];
    { const bf16_t* qp = PROJ + tok * NPROJ + 832 + hh * 64 + 8 * hi;
#pragma unroll
      for (int st = 0; st < 4; ++st) {
          const u32x4 raw = *(const u32x4*)(qp + 16 * st); u32x4 sc;
          sc.x = pk2(bflo(raw.x) * sc2, bfhi(raw.x) * sc2); sc.y = pk2(bflo(raw.y) * sc2, bfhi(raw.y) * sc2);
          sc.z = pk2(bflo(raw.z) * sc2, bfhi(raw.z) * sc2); sc.w = pk2(bflo(raw.w) * sc2, bfhi(raw.w) * sc2);
          qf[st] = __builtin_bit_cast(bf16x8, sc); } }
    const bf16_t* gp = PROJ + tok * NPROJ + 2624 + hh * 3;
    const float gate_c = fsigmoid(bf2f(gp[0])), gate_s = fsigmoid(bf2f(gp[1])), gate_w = fsigmoid(bf2f(gp[2]));
    __syncthreads();

    f32x16 out[2];
    {
        const int cwm = (tw0 + 3 >= 31) ? ((tw0 + 3 - 31) >> 4) : -1;
        const int ntw = (cwm >= 0) ? (cwm >> 5) + 1 : 0;
        const float slope16 = 16.f * slope2;
        float m1 = -1e20f, l1 = 0.f;
        for (int tile = 0; tile < ntw; ++tile) {
            int dbase = t - 31 - 512 * tile - 64 * hi;
            asm volatile("" : "+v"(dbase));
            const float b0 = -slope2 * (float)dbase;
            f32x16 s;
#pragma unroll
            for (int i = 0; i < 16; ++i) s[i] = fmaf(slope16, (float)((i & 3) + 8 * (i >> 2)), b0);
#pragma unroll
            for (int st = 0; st < 4; ++st) {
                const bf16x8 a = *(LAS const bf16x8*)(lds + NSA_KC + (32 * tile + c) * 144 + st * 32 + hi * 16);
                s = MFMA32(a, qf[st], s);
            }
            if (512 * tile + 496 + 31 > tw0) {
#pragma unroll
                for (int i = 0; i < 16; ++i) if ((dbase - 16 * ((i & 3) + 8 * (i >> 2))) < 0) s[i] = -1e30f;
            }
            const float mn = fmaxf(m1, max16(s));
            float ps = 0.f;
#pragma unroll
            for (int i = 0; i < 16; ++i) ps += fexp2(s[i] - mn);
            l1 = l1 * fexp2(m1 - mn) + ps; m1 = mn;
        }
        const float mo = xhalf_partner(m1, hi), lo = xhalf_partner(l1, hi);
        const float M = fmaxf(m1, mo), L = l1 * fexp2(m1 - M) + lo * fexp2(mo - M);
        const float Moff = (L > 0.f) ? (M + __log2f(L)) : 1e30f;
#pragma unroll
        for (int i = 0; i < 8; ++i) IMPw[lane + 64 * i] = 0.f;
        LDS_WAIT();
        f32x16 oc[2];
#pragma unroll
        for (int db = 0; db < 2; ++db)
#pragma unroll
            for (int i = 0; i < 16; ++i) oc[db][i] = 0.f;
        float prev3 = 0.f;
        for (int tile = 0; tile < ntw; ++tile) {
            int dbase = t - 31 - 512 * tile - 64 * hi;
            asm volatile("" : "+v"(dbase));
            const float b0 = -slope2 * (float)dbase;
            f32x16 s;
#pragma unroll
            for (int i = 0; i < 16; ++i) s[i] = fmaf(slope16, (float)((i & 3) + 8 * (i >> 2)), b0);
#pragma unroll
            for (int st = 0; st < 4; ++st) {
                const bf16x8 a = *(LAS const bf16x8*)(lds + NSA_KC + (32 * tile + c) * 144 + st * 32 + hi * 16);
                s = MFMA32(a, qf[st], s);
            }
            if (512 * tile + 496 + 31 > tw0) {
#pragma unroll
                for (int i = 0; i < 16; ++i) if ((dbase - 16 * ((i & 3) + 8 * (i >> 2))) < 0) s[i] = -1e30f;
            }
#pragma unroll
            for (int i = 0; i < 16; ++i) s[i] = fexp2(s[i] - Moff);
            float pp[4];
#pragma unroll
            for (int r = 0; r < 4; ++r) pp[r] = xhalf_partner(s[4 * r + 3], hi);
#pragma unroll
            for (int r = 0; r < 4; ++r) {
                const float a = 2.f * (s[4 * r] + s[4 * r + 1] + s[4 * r + 2]) + s[4 * r + 3];
                const float cin = hi ? pp[r] : (r > 0 ? pp[r > 0 ? r - 1 : 0] : prev3);
                float v = a + cin;
                v = sum8(v);
                if (head == 0) IMPw[qi * 128 + 8 * tile + 2 * r + hi] = v;
            }
            prev3 = pp[3];
            const bf16x8 pb0 = packp(s, 0), pb1 = packp(s, 1);
#pragma unroll
            for (int db = 0; db < 2; ++db)
#pragma unroll
                for (int tt = 0; tt < 2; ++tt) {
                    LAS const unsigned char* ap = lds + NSA_VCT + (32 * db + c) * 1032 + (32 * tile + 16 * tt + 4 * hi) * 2;
                    const bf16x8 a = cat4(*(LAS const bf16x4*)ap, *(LAS const bf16x4*)(ap + 16));
                    oc[db] = MFMA32(a, tt == 0 ? pb0 : pb1, oc[db]);
                }
        }
        out[0] = oc[0] * gate_c; out[1] = oc[1] * gate_c;
        LDS_WAIT();
        for (int qi2 = 0; qi2 < 4; ++qi2) {
            const int t2 = tw0 + qi2, blk = t2 >> 6;
            LAS unsigned* kp = (LAS unsigned*)(IMPw + qi2 * 128);
            const int n0 = lane, n1 = lane + 64;
            const unsigned b0 = kp[n0], b1 = kp[n1];
            const bool f0 = (n0 == 0) || (n0 == blk) || (n0 == blk - 1), f1 = (n1 == blk) || (n1 == blk - 1);
            const unsigned k0 = (n0 <= blk) ? ((((f0 ? 0x461C4000u : b0)) & 0xFFFFFF80u) | (unsigned)(127 - n0)) : 0u;
            const unsigned k1 = (n1 <= blk) ? ((((f1 ? 0x461C4000u : b1)) & 0xFFFFFF80u) | (unsigned)(127 - n1)) : 0u;
            unsigned T = 0u;
#pragma unroll 1
            for (int bit = 30; bit >= 0; --bit) {
                const unsigned cand = T | (1u << bit);
                const int cnt = __popcll(__ballot(k0 >= cand)) + __popcll(__ballot(k1 >= cand));
                if (cnt >= 16) T = cand;
            }
            const bool s0 = (k0 != 0u) && (k0 >= T), s1 = (k1 != 0u) && (k1 >= T);
            const unsigned long long m0 = __ballot(s0), m1b = __ballot(s1);
            if (lane == 0) {
                const unsigned w0 = (unsigned)m0, w1 = (unsigned)(m0 >> 32), w2 = (unsigned)m1b, w3 = (unsigned)(m1b >> 32);
                LAS unsigned* sp = SEL + (4 * w + qi2) * 4;
                sp[0] = w0; sp[1] = w1; sp[2] = w2; sp[3] = w3;
                unsigned* ug = (unsigned*)(ldsg + NSA_UNI);
                atomicOr(ug + 0, w0); atomicOr(ug + 1, w1); atomicOr(ug + 2, w2); atomicOr(ug + 3, w3);
            }
        }
    }
    __syncthreads();
    if (tid == 0) {
        int cnt = 0;
        for (int wd = 0; wd < 4; ++wd) { unsigned bits = UNI[wd]; while (bits) { const int nb = 32 * wd + __builtin_ctz(bits); bits &= bits - 1; LIST[cnt++] = nb; } }
        NL[0] = cnt;
    }
    __syncthreads();
    const int kq = tid >> 3, kch = tid & 7;
    const int toff = kq * 144 + kch * 16, voff = 9216 + kq * 136 + kch * 16;
#define ST_V(base, v) do { LAS unsigned char* vp_ = (base) + voff; *(LAS u32x2*)vp_ = (u32x2){(v).x, (v).y}; *(LAS u32x2*)(vp_ + 8) = (u32x2){(v).z, (v).w}; } while (0)
    {
        const int nl = NL[0];
        const bf16_t* Ksrc = PROJ + (tokb + kq) * NPROJ + 2112 + g * 64 + 8 * kch;
        const bf16_t* Vsrc = VST + ((size_t)(bg * 64 + kq)) * S_ + 8 * kch;
        f32x16 o[2];
#pragma unroll
        for (int db = 0; db < 2; ++db)
#pragma unroll
            for (int i = 0; i < 16; ++i) o[db][i] = 0.f;
        float m = -1e20f, l = 0.f;
        u32x4 rk1, rv1, rk2, rv2;
        { const int nb = LIST[0]; rk1 = *(const u32x4*)(Ksrc + (size_t)(64 * nb) * NPROJ); rv1 = *(const u32x4*)(Vsrc + 64 * nb); }
        *(LAS u32x4*)(lds + toff) = rk1; ST_V(lds, rv1);
        if (nl > 1) { const int nb = LIST[1]; rk1 = *(const u32x4*)(Ksrc + (size_t)(64 * nb) * NPROJ); rv1 = *(const u32x4*)(Vsrc + 64 * nb); }
        __syncthreads();
        int cb = 0;
        for (int i = 0; i < nl; ++i) {
            const int nb = LIST[i];
            if (i + 2 < nl) { const int nb2 = LIST[i + 2]; rk2 = *(const u32x4*)(Ksrc + (size_t)(64 * nb2) * NPROJ); rv2 = *(const u32x4*)(Vsrc + 64 * nb2); }
            const bool lanesel = (SEL[(4 * w + qi) * 4 + (nb >> 5)] >> (nb & 31)) & 1u;
            if (__any(lanesel))
                nsa_tile<0>(lds + cb * NSA_TBUF, qf, o, m, l, 64 * nb, t, lanesel, slope2, c, hi);
            const int nbuf = (cb == 2) ? 0 : cb + 1;
            if (i + 1 < nl) { *(LAS u32x4*)(lds + nbuf * NSA_TBUF + toff) = rk1; ST_V(lds + nbuf * NSA_TBUF, rv1); }
            rk1 = rk2; rv1 = rv2; cb = nbuf;
            __syncthreads();
        }
        const float lt = xhalf_sum(l), sc = gate_s * frcp(lt);
        out[0] = out[0] + o[0] * sc; out[1] = out[1] + o[1] * sc;
    }
    {
        const int lo_key = (q0 - 511 > 0) ? (q0 - 511) : 0;
        const int kt_lo = lo_key >> 6, kt_hi = (q0 + 31) >> 6;
        const bf16_t* Ksrc = PROJ + (tokb + kq) * NPROJ + 2368 + g * 64 + 8 * kch;
        const bf16_t* Vsrc = VWT + ((size_t)(bg * 64 + kq)) * S_ + 8 * kch;
        f32x16 o[2];
#pragma unroll
        for (int db = 0; db < 2; ++db)
#pragma unroll
            for (int i = 0; i < 16; ++i) o[db][i] = 0.f;
        float m = -1e20f, l = 0.f;
        u32x4 rk1, rv1, rk2, rv2;
        rk1 = *(const u32x4*)(Ksrc + (size_t)(64 * kt_lo) * NPROJ); rv1 = *(const u32x4*)(Vsrc + 64 * kt_lo);
        *(LAS u32x4*)(lds + toff) = rk1; ST_V(lds, rv1);
        if (kt_lo < kt_hi) { rk1 = *(const u32x4*)(Ksrc + (size_t)(64 * (kt_lo + 1)) * NPROJ); rv1 = *(const u32x4*)(Vsrc + 64 * (kt_lo + 1)); }
        __syncthreads();
        int cb = 0;
        for (int kt = kt_lo; kt <= kt_hi; ++kt) {
            if (kt + 2 <= kt_hi) { rk2 = *(const u32x4*)(Ksrc + (size_t)(64 * (kt + 2)) * NPROJ); rv2 = *(const u32x4*)(Vsrc + 64 * (kt + 2)); }
            if (!(64 * kt + 63 < tw0 - 511 || 64 * kt > tw0 + 3))
                nsa_tile<1>(lds + cb * NSA_TBUF, qf, o, m, l, 64 * kt, t, true, slope2, c, hi);
            const int nbuf = (cb == 2) ? 0 : cb + 1;
            if (kt < kt_hi) { *(LAS u32x4*)(lds + nbuf * NSA_TBUF + toff) = rk1; ST_V(lds + nbuf * NSA_TBUF, rv1); }
            rk1 = rk2; rv1 = rv2; cb = nbuf;
            __syncthreads();
        }
        const float lt = xhalf_sum(l), sc = gate_w * frcp(lt);
        out[0] = out[0] + o[0] * sc; out[1] = out[1] + o[1] * sc;
    }
    bf16_t* op = MIX + tok * 2048 + 1024 + hh * 64 + 4 * hi;
#pragma unroll
    for (int db = 0; db < 2; ++db)
#pragma unroll
        for (int g4 = 0; g4 < 4; ++g4) {
            u32x2 wv; wv.x = pk2(out[db][4 * g4], out[db][4 * g4 + 1]); wv.y = pk2(out[db][4 * g4 + 2], out[db][4 * g4 + 3]);
            *(u32x2*)(op + 32 * db + 8 * g4) = wv;
        }
}

#define XB_TMO      128
#define XB_XCNT(j)  (256  + 64 * (j))
#define XB_XSUB(j)  (1280 + 64 * (j))
#define XB_XGEN(j)  (2304 + 64 * (j))
#define XB_TOP      3328
#define XB_TOPGEN   3392
#define XB_SPIN_CAP (1u << 18)
DI unsigned xb_ld(unsigned* p)              { return __hip_atomic_load(p, __ATOMIC_RELAXED, __HIP_MEMORY_SCOPE_AGENT); }
DI unsigned xb_add(unsigned* p, unsigned v) { return __hip_atomic_fetch_add(p, v, __ATOMIC_RELAXED, __HIP_MEMORY_SCOPE_AGENT); }
DI unsigned xb_xcc_id() { return (unsigned)__builtin_amdgcn_s_getreg((3 << 11) | 20) & 0xFu; }
#define XB_SPIN(cond, bar) do { unsigned _sp = 0; while (cond) { __builtin_amdgcn_s_sleep(1); \
    if ((++_sp & 255u) == 0u) { if (xb_ld(&(bar)[XB_TMO])) break; if (_sp > XB_SPIN_CAP) { atomicAdd(&(bar)[XB_TMO], 1u); break; } } } } while (0)
DI void xcd_barrier_complete(unsigned* bar, unsigned x, unsigned& nloc, unsigned& nx) {
    const unsigned G = gridDim.x * gridDim.y * gridDim.z;
    unsigned sum, cnt, mine, sp = 0u;
    for (;;) {
        sum = 0u; cnt = 0u; mine = 0u;
#pragma unroll
        for (unsigned j = 0; j < 16; ++j) { const unsigned c = xb_ld(&bar[XB_XCNT(j)]); sum += c; cnt += (c > 0u) ? 1u : 0u; mine = (j == x) ? c : mine; }
        if (sum == G) break;
        __builtin_amdgcn_s_sleep(1);
        if ((++sp & 255u) == 0u) { if (xb_ld(&bar[XB_TMO])) break; if (sp > XB_SPIN_CAP) { atomicAdd(&bar[XB_TMO], 1u); break; } }
    }
    nloc = mine > 0u ? mine : 1u; nx = cnt > 0u ? cnt : 1u;
}
DI void xcd_barrier(unsigned* bar, unsigned x, volatile LAS unsigned* st) {
    asm volatile("s_waitcnt vmcnt(0)" ::: "memory");
    __syncthreads();
    if (threadIdx.x == 0) {
        __builtin_amdgcn_s_waitcnt(0);
        unsigned nloc = st[0], nx = st[1];
        if (nloc == 0u) { xcd_barrier_complete(bar, x, nloc, nx); st[0] = nloc; st[1] = nx; }
        const unsigned old = xb_add(&bar[XB_XSUB(x)], 1u);
        const unsigned gen = old / nloc;
        if (old + 1u == (gen + 1u) * nloc) {
            __builtin_amdgcn_fence(__ATOMIC_RELEASE, "agent");
            asm volatile("s_waitcnt vmcnt(0)" ::: "memory");
            const unsigned og = xb_add(&bar[XB_TOP], 1u);
            const unsigned tg = og / nx;
            if (og + 1u == (tg + 1u) * nx) xb_add(&bar[XB_TOPGEN], 1u);
            else XB_SPIN(xb_ld(&bar[XB_TOPGEN]) == tg, bar);
            __builtin_amdgcn_fence(__ATOMIC_ACQUIRE, "agent");
            xb_add(&bar[XB_XGEN(x)], 1u);
            asm volatile("s_waitcnt vmcnt(0)" ::: "memory");
        } else {
            XB_SPIN(xb_ld(&bar[XB_XGEN(x)]) == gen, bar);
            __builtin_amdgcn_fence(__ATOMIC_ACQUIRE, "agent");
            asm volatile("s_waitcnt vmcnt(0)" ::: "memory");
        }
    }
    __syncthreads();
}
__global__ void __launch_bounds__(NTHREADS, 2) fwd_megakernel(Params p) {
    extern __shared__ __attribute__((aligned(16))) unsigned char dyn_lds[];
    cg::grid_group grid = cg::this_grid();
    LAS unsigned char* lds = (LAS unsigned char*)dyn_lds;
    const int G = gridDim.x, bid = blockIdx.x;
    volatile LAS unsigned* xst = (volatile LAS unsigned*)(lds + 158688);
    if (threadIdx.x < 2) xst[threadIdx.x] = 0u;
    __syncthreads();
    unsigned* xbar = (unsigned*)(p.ws + OFF_XBAR);
    const unsigned xcc = xb_xcc_id();
#define PHASE_IDS const int tid = fresh_tid(), lane = tid & 63, wave = __builtin_amdgcn_readfirstlane(tid >> 6); (void)lane; (void)wave
    unsigned char* ws = p.ws;
    bf16_t* HN = (bf16_t*)(ws + OFF_HN); bf16_t* PROJ = (bf16_t*)(ws + OFF_PROJ);
    const float* RSQ = (const float*)(ws + OFF_RSQ); const float* RSKV = (const float*)(ws + OFF_RSKV);
    const float* BIAS = (const float*)(ws + OFF_BIAS);
    using pg8::Gemm; using pg8::Epi; using pg8::StaticOrder;

    for (int rep = 0; rep < REP_P0; ++rep) { PHASE_IDS; prologue(p, lds, tid, lane, wave); }
    grid.sync();
    if (threadIdx.x == 0) (void)xb_add(&xbar[XB_XCNT(xcc)], 1u);
    {
        Gemm g{HN, (const bf16_t*)(ws + OFF_WIN), T_, NPROJ, DM, DM, DM}; StaticOrder S; S.init(T_, NPROJ, G, bid);
        Epi E{pg8::EPI_STORE, PROJ, NPROJ, NPROJ, nullptr, 1.f, nullptr, nullptr, nullptr, nullptr, nullptr, nullptr};
        for (int rep = 0; rep < REP_P1; ++rep) pg8::gemm_phase(lds, g, S, E);
    }
    xcd_barrier(xbar, xcc, xst);
    { PHASE_IDS; for (int tile = bid; tile < T_ / 64; tile += G) postproj_tile(p, lds, tile, tid, lane, wave); }
    xcd_barrier(xbar, xcc, xst);
    {
        { Gemm g{PROJ, (const bf16_t*)(ws + OFF_WUQ), T_, 1536, 512, NPROJ, 512}; StaticOrder S; S.init(T_, 1536, G, bid);
          Epi E{pg8::EPI_Q, (bf16_t*)(ws + OFF_QMLA), 1536, 1536, RSQ, 0.07216878364870322f * LOG2E, (const float*)(ws + OFF_COS), (const float*)(ws + OFF_SIN), nullptr, nullptr, nullptr, nullptr};
          pg8::gemm_phase(lds, g, S, E); }
        { Gemm g{PROJ + 512, (const bf16_t*)(ws + OFF_WK), T_, 1024, 256, NPROJ, 256}; StaticOrder S; S.init(T_, 1024, G, bid);
          Epi E{pg8::EPI_STORE, (bf16_t*)(ws + OFF_KNOPE), 1024, 1024, RSKV, 1.f, nullptr, nullptr, nullptr, nullptr, nullptr, nullptr};
          pg8::gemm_phase(lds, g, S, E); }
        { Gemm g{(const bf16_t*)(ws + OFF_WV), PROJ + 512, 1024, T_, 256, 256, NPROJ}; StaticOrder S; S.init(1024, T_, G, bid);
          Epi E{pg8::EPI_VT, (bf16_t*)(ws + OFF_VT), T_, T_, RSKV, 1.f, nullptr, nullptr, nullptr, nullptr, nullptr, nullptr};
          pg8::gemm_phase(lds, g, S, E); }
    }
    xcd_barrier(xbar, xcc, xst);
    if (bid < 16) {
        StaticOrder S; S.init(4096, 256, 16, bid);
        { Gemm g{(const bf16_t*)(ws + OFF_KCG), (const bf16_t*)(ws + OFF_WC1K), 4096, 256, 2048, 1024, 2048};
          Epi E{pg8::EPI_SILU, (bf16_t*)(ws + OFF_HIDK), 256, 256, nullptr, 1.f, nullptr, nullptr, BIAS, nullptr, nullptr, nullptr};
          pg8::gemm_phase(lds, g, S, E); }
        __threadfence(); __syncthreads();
        { Gemm g{(const bf16_t*)(ws + OFF_HIDK), (const bf16_t*)(ws + OFF_WC2K), 4096, 256, 256, 256, 256};
          Epi E{pg8::EPI_STORE, (bf16_t*)(ws + OFF_KC), 64, 64, nullptr, 1.f, nullptr, nullptr, nullptr, nullptr, nullptr, nullptr};
          pg8::gemm_phase(lds, g, S, E); }
    } else if (bid < 32) {
        { StaticOrder S; S.init(4096, 256, 16, bid - 16);
          Gemm g{(const bf16_t*)(ws + OFF_VCG), (const bf16_t*)(ws + OFF_WC1V), 4096, 256, 2048, 1024, 2048};
          Epi E{pg8::EPI_SILU, (bf16_t*)(ws + OFF_HIDV), 256, 256, nullptr, 1.f, nullptr, nullptr, BIAS + 256, nullptr, nullptr, nullptr};
          pg8::gemm_phase(lds, g, S, E); }
        __threadfence(); __syncthreads();
        { StaticOrder S; S.init(256, 4096, 16, bid - 16);
          Gemm g{(const bf16_t*)(ws + OFF_WC2V), (const bf16_t*)(ws + OFF_HIDV), 256, 4096, 256, 256, 256};
          Epi E{pg8::EPI_VCT, (bf16_t*)(ws + OFF_VCT), 512, 4096, nullptr, 1.f, nullptr, nullptr, nullptr, nullptr, nullptr, nullptr};
          pg8::gemm_phase(lds, g, S, E); }
    }
    for (int rep = 0; rep < REP_MLA; ++rep) {
        unsigned* ctl = (unsigned*)(ws + OFF_CTL) + rep * 256;
        LAS int* QU = (LAS int*)(lds + 158208);
        for (int k = 0; k < 8; ++k) {
            const int qq = (bid + k) & 7;
            for (;;) {
                PHASE_IDS;
                __syncthreads();
                if (tid == 0) QU[0] = (int)atomicAdd(ctl + qq * 16, 1u);
                __syncthreads();
                const int qi_ = QU[0];
                if (qi_ >= 128) break;
                const int pr_ = qi_ >> 6, r_ = qi_ & 63;
                const int qb = 31 - (r_ >> 1), bh = qq + 8 * (2 * pr_ + (r_ & 1));
                mla_unit(p, lds, bh >> 3, bh & 7, qb, tid);
            }
        }
    }
    xcd_barrier(xbar, xcc, xst);
    for (int rep = 0; rep < REP_NSA; ++rep)
    for (int u = bid, rnd = 0; u < 2048; u += G, ++rnd) {
        PHASE_IDS;
        const int bg = (u + rnd) & 7, qt = 255 - (u >> 3);
        nsa_unit(p, lds, dyn_lds, bg, qt, tid);
    }
    xcd_barrier(xbar, xcc, xst);
    {
        Gemm g{(const bf16_t*)(ws + OFF_MIX), (const bf16_t*)(ws + OFF_WO), T_, DM, DM, DM, DM}; StaticOrder S; S.init(T_, DM, G, bid);
        Epi E{pg8::EPI_RESID_NORM, HN, DM, DM, (const float*)(ws + OFF_XS), 1.f, nullptr, nullptr, (const float*)(ws + OFF_INVG), nullptr, nullptr, (float*)(ws + OFF_ROWSQ)};
        pg8::gemm_phase(lds, g, S, E);
    }
    xcd_barrier(xbar, xcc, xst);
    {
        Gemm g{HN, (const bf16_t*)(ws + OFF_WGU), T_, 2 * FF, DM, DM, DM}; StaticOrder S; S.init(T_, 2 * FF, G, bid);
        Epi E{pg8::EPI_SWIGLU, (bf16_t*)(ws + OFF_ACT), FF, 2 * FF, nullptr, 1.f, nullptr, nullptr, nullptr, nullptr, nullptr, (float*)(ws + OFF_ROWSQ)};
        for (int rep = 0; rep < REP_P8; ++rep) pg8::gemm_phase(lds, g, S, E);
    }
    xcd_barrier(xbar, xcc, xst);
    {
        Gemm g{(const bf16_t*)(ws + OFF_ACT), (const bf16_t*)(ws + OFF_WD), T_, DM, FF, FF, FF}; StaticOrder S; S.init(T_, DM, G, bid);
        Epi E{pg8::EPI_RESID_BF, HN, DM, DM, nullptr, 1.f, nullptr, nullptr, nullptr, nullptr, p.out, nullptr};
        pg8::gemm_phase(lds, g, S, E);
    }
    xcd_barrier(xbar, xcc, xst);
    {
        PHASE_IDS;
        const int gw = bid * 8 + wave, NGW = G * 8;
        for (int m = gw; m < T_; m += NGW) norm_row_bf16_to_f32(HN + (size_t)m * DM, p.in[19], p.out + (size_t)m * DM, lane);
    }
}

extern "C" void kernel_launch(void* const* d_in, const int* in_sizes, int n_in, void* d_out, int out_size, void* d_ws, size_t ws_size, hipStream_t stream) {
    static int grid_blocks = 0;
    if (grid_blocks == 0) {
        if (n_in != 20 || ws_size < WS_END) { fprintf(stderr, "kernel_launch: unexpected n_in %d or ws_size %zu (< %zu)\n", n_in, ws_size, (size_t)WS_END); grid_blocks = -1; return; }
        int dev = 0, cus = 0, per_cu = 0;
        hipGetDevice(&dev);
        hipDeviceGetAttribute(&cus, hipDeviceAttributeMultiprocessorCount, dev);
        if (hipFuncSetAttribute((const void*)fwd_megakernel, hipFuncAttributeMaxDynamicSharedMemorySize, LDS_BYTES) != hipSuccess) fprintf(stderr, "kernel_launch: hipFuncSetAttribute failed\n");
        if (hipOccupancyMaxActiveBlocksPerMultiprocessor(&per_cu, (const void*)fwd_megakernel, NTHREADS, LDS_BYTES) != hipSuccess || per_cu < 1) { fprintf(stderr, "kernel_launch: occupancy query gave %d\n", per_cu); per_cu = 1; }
        (void)hipGetLastError();
        grid_blocks = cus * per_cu;
    }
    if (grid_blocks < 0) return;
    unsigned char* ws = (unsigned char*)d_ws;
    Params p{};
    for (int i = 0; i < 20; ++i) p.in[i] = (const float*)d_in[i];
    p.out = (float*)d_out; p.ws = ws;
    void* args[] = {&p};
    hipError_t e = hipLaunchCooperativeKernel((const void*)fwd_megakernel, dim3(grid_blocks), dim3(NTHREADS), args, LDS_BYTES, stream);
    if (e != hipSuccess) fprintf(stderr, "kernel_launch: cooperative launch failed: %s (grid %d)\n", hipGetErrorString(e), grid_blocks);
}
```
